# Optimizing an MI355X kernel written in HIP

```python
import math
import jax, jax.numpy as jnp
from jax import lax
import numpy as np

D_MODEL = 1024
BATCH = 4
SEQ = 4096
DEPTH = 2
DEC_BATCH = 8
DEC_SEQ = 64
PAST_LEN = 1024

CHUNK = 64
Q_BLOCK = 128
N_EVEN = (DEPTH + 1) // 2
N_ODD = DEPTH // 2
HEAD_DIM = 64
H_A = 4
DK_A = HEAD_DIM
DV_A = 2 * HEAD_DIM
H_B = 8
DK_B = HEAD_DIM
H_C = D_MODEL // HEAD_DIM
C_PAST_CHUNKS = 8
C_BAND_PAST = C_PAST_CHUNKS * CHUNK
REL_CLIP = 256
D_FF = 4 * D_MODEL
NORM_EPS = 1e-6
A_QK = H_A * 2 * DK_A
A_V = H_A * DV_A
B_QK = H_B * DK_B
D_IN_EVEN = 2 * A_QK + A_V + 3 * B_QK + H_B
D_MIX = A_V + B_QK
NEG_INF = -1e30

kernel_name = 'hybrid_streaming_encoder_step'


def rmsnorm(x, g):
    xf = x.astype(jnp.float32)
    y = xf * lax.rsqrt(jnp.mean(xf * xf, axis=-1, keepdims=True) + NORM_EPS)
    return (y * g.astype(jnp.float32)).astype(x.dtype)


def alibi_slopes():
    return 2.0 ** (-8.0 * jnp.arange(1, H_A + 1, dtype=jnp.float32) / H_A)


def diff_attention(q, k, v, q_pos, k_pos, lam):
    s = jnp.einsum('bqhmd,bkhmd->bmhqk', q, k).astype(jnp.float32) * (DK_A ** -0.5)
    dist = jnp.abs(q_pos[:, None] - k_pos[None, :]).astype(jnp.float32)
    bias = -alibi_slopes()[:, None, None] * dist
    visible = (k_pos[None, :] // CHUNK) <= (q_pos[:, None] // CHUNK)
    p = jax.nn.softmax(jnp.where(visible, s + bias, NEG_INF), axis=-1)
    w = p[:, 0] - lam * p[:, 1]
    return jnp.einsum('bhqk,bkhd->bqhd', w.astype(v.dtype), v)


def forgetting_attention(q, k, v, cum_q, cum_k, q_pos, k_pos):
    s = jnp.einsum('bqhd,bkhd->bhqk', q, k).astype(jnp.float32) * (DK_B ** -0.5)
    decay = jnp.swapaxes(cum_q, 1, 2)[..., :, None] - jnp.swapaxes(cum_k, 1, 2)[..., None, :]
    visible = k_pos[None, :] <= q_pos[:, None]
    p = jax.nn.softmax(jnp.where(visible, s + decay, NEG_INF), axis=-1)
    return jnp.einsum('bhqk,bkhd->bqhd', p.astype(v.dtype), v)


def chunk_band_attention(q, k, v, q_pos, k_pos, table):
    s = jnp.einsum('bqhd,bkhd->bhqk', q, k).astype(jnp.float32) * (HEAD_DIM ** -0.5)
    rel = jnp.clip(q_pos[:, None] - k_pos[None, :], -REL_CLIP, REL_CLIP) + REL_CLIP
    bias = table.astype(jnp.float32)[:, rel]
    qc = q_pos[:, None] // CHUNK
    kc = k_pos[None, :] // CHUNK
    visible = (k_pos[None, :] >= 0) & (kc <= qc) & (kc >= qc - C_PAST_CHUNKS)
    p = jax.nn.softmax(jnp.where(visible, s + bias, NEG_INF), axis=-1)
    return jnp.einsum('bhqk,bkhd->bqhd', p.astype(v.dtype), v)


def diff_lambda(lq1, lk1, lq2, lk2, lam_init):
    f = jnp.float32
    return (jnp.exp(jnp.sum(lq1.astype(f) * lk1.astype(f)))
            - jnp.exp(jnp.sum(lq2.astype(f) * lk2.astype(f))) + lam_init)


def even_project(h, w_in, b_f):
    B, T, _ = h.shape
    z = h @ w_in
    cuts = np.cumsum([A_QK, A_QK, A_V, B_QK, B_QK, B_QK]).tolist()
    qa, ka, va, qb, kb, vb, fz = jnp.split(z, cuts, axis=-1)
    qa = qa.reshape(B, T, H_A, 2, DK_A)
    ka = ka.reshape(B, T, H_A, 2 * DK_A)
    va = va.reshape(B, T, H_A, DV_A)
    qb = qb.reshape(B, T, H_B, DK_B)
    kb = kb.reshape(B, T, H_B, DK_B)
    vb = vb.reshape(B, T, H_B, DK_B)
    logf = jax.nn.log_sigmoid(fz.astype(jnp.float32) + b_f.astype(jnp.float32))
    return qa, ka, va, qb, kb, vb, logf


def even_merge(oa, ob, subln_g, lam_init, w_out):
    B, T = oa.shape[:2]
    oa = rmsnorm(oa, subln_g) * (1.0 - lam_init)
    o = jnp.concatenate([oa.reshape(B, T, A_V), ob.reshape(B, T, B_QK)], axis=-1)
    return o @ w_out


def even_mixer_prompt(h, w_in, b_f, lam, subln_g, lam_init, w_out):
    B, T, _ = h.shape
    qa, ka, va, qb, kb, vb, logf = even_project(h, w_in, b_f)
    cum = jnp.cumsum(logf, axis=1)
    pos = jnp.arange(T, dtype=jnp.int32)
    ka5 = ka.reshape(B, T, H_A, 2, DK_A)

    def block(i):
        start = i * Q_BLOCK
        q_pos = start + jnp.arange(Q_BLOCK, dtype=jnp.int32)
        oa = diff_attention(lax.dynamic_slice_in_dim(qa, start, Q_BLOCK, axis=1), ka5, va, q_pos, pos, lam)
        ob = forgetting_attention(lax.dynamic_slice_in_dim(qb, start, Q_BLOCK, axis=1), kb, vb,
                                  lax.dynamic_slice_in_dim(cum, start, Q_BLOCK, axis=1), cum, q_pos, pos)
        return oa, ob

    oa, ob = lax.map(block, jnp.arange(T // Q_BLOCK, dtype=jnp.int32))
    oa = jnp.moveaxis(oa, 0, 1).reshape(B, T, H_A, DV_A)
    ob = jnp.moveaxis(ob, 0, 1).reshape(B, T, H_B, DK_B)
    return even_merge(oa, ob, subln_g, lam_init, w_out), (ka, va, kb, vb, logf)


def even_mixer_sample(h, c_ka, c_va, c_kb, c_vb, c_logf, w_in, b_f, lam, subln_g, lam_init, w_out):
    B, T, _ = h.shape
    P = c_ka.shape[1]
    qa, ka, va, qb, kb, vb, logf = even_project(h, w_in, b_f)
    ka_all = jnp.concatenate([c_ka, ka], axis=1).reshape(B, P + T, H_A, 2, DK_A)
    va_all = jnp.concatenate([c_va, va], axis=1)
    kb_all = jnp.concatenate([c_kb, kb], axis=1)
    vb_all = jnp.concatenate([c_vb, vb], axis=1)
    cum = jnp.cumsum(jnp.concatenate([c_logf.astype(jnp.float32), logf], axis=1), axis=1)
    q_pos = P + jnp.arange(T, dtype=jnp.int32)
    k_pos = jnp.arange(P + T, dtype=jnp.int32)
    oa = diff_attention(qa, ka_all, va_all, q_pos, k_pos, lam)
    ob = forgetting_attention(qb, kb_all, vb_all, cum[:, P:], cum, q_pos, k_pos)
    return even_merge(oa, ob, subln_g, lam_init, w_out), (ka, va, kb, vb, logf)


def odd_project(h, w_in):
    B, T, _ = h.shape
    q, k, v = jnp.split(h @ w_in, 3, axis=-1)
    return (q.reshape(B, T, H_C, HEAD_DIM), k.reshape(B, T, H_C, HEAD_DIM), v.reshape(B, T, H_C, HEAD_DIM))


def odd_mixer_prompt(h, w_in, table, w_out):
    B, T, _ = h.shape
    q, k, v = odd_project(h, w_in)
    pad = ((0, 0), (C_BAND_PAST, 0), (0, 0), (0, 0))
    kp = jnp.pad(k, pad)
    vp = jnp.pad(v, pad)
    band = C_BAND_PAST + CHUNK

    def chunk_fn(c):
        start = c * CHUNK
        q_pos = start + jnp.arange(CHUNK, dtype=jnp.int32)
        k_pos = start - C_BAND_PAST + jnp.arange(band, dtype=jnp.int32)
        return chunk_band_attention(lax.dynamic_slice_in_dim(q, start, CHUNK, axis=1),
                                    lax.dynamic_slice_in_dim(kp, start, band, axis=1),
                                    lax.dynamic_slice_in_dim(vp, start, band, axis=1),
                                    q_pos, k_pos, table)

    o = lax.map(chunk_fn, jnp.arange(T // CHUNK, dtype=jnp.int32))
    o = jnp.moveaxis(o, 0, 1).reshape(B, T, D_MODEL)
    W = min(C_BAND_PAST, T)
    return o @ w_out, (k[:, T - W:], v[:, T - W:])


def odd_mixer_sample(h, c_k, c_v, past_len, w_in, table, w_out):
    B, T, _ = h.shape
    W = c_k.shape[1]
    q, k, v = odd_project(h, w_in)
    k_all = jnp.concatenate([c_k, k], axis=1)
    v_all = jnp.concatenate([c_v, v], axis=1)
    q_pos = past_len + jnp.arange(T, dtype=jnp.int32)
    k_pos = past_len - W + jnp.arange(W + T, dtype=jnp.int32)
    o = chunk_band_attention(q, k_all, v_all, q_pos, k_pos, table).reshape(B, T, D_MODEL)
    return o @ w_out, (k_all[:, T:], v_all[:, T:])


def squared_relu_mlp(h, w_up, w_down):
    u = jax.nn.relu(h @ w_up)
    return (u * u) @ w_down


def setup_inputs(seed: int = 0) -> dict:
    key = jax.random.key(seed)
    ks = jax.random.split(key, 32)

    def nrm(k, shape, scale=1.0):
        return scale * jax.random.normal(k, shape, jnp.float32)

    w_c = min(C_BAND_PAST, PAST_LEN)
    return {
        'x_prompt': nrm(ks[0], (BATCH, SEQ, D_MODEL)),
        'x_sample': nrm(ks[1], (DEC_BATCH, DEC_SEQ, D_MODEL)),
        'cache_a_k': nrm(ks[2], (N_EVEN, DEC_BATCH, PAST_LEN, H_A, 2 * DK_A)),
        'cache_a_v': nrm(ks[3], (N_EVEN, DEC_BATCH, PAST_LEN, H_A, DV_A)),
        'cache_b_k': nrm(ks[4], (N_EVEN, DEC_BATCH, PAST_LEN, H_B, DK_B)),
        'cache_b_v': nrm(ks[5], (N_EVEN, DEC_BATCH, PAST_LEN, H_B, DK_B)),
        'cache_b_logf': jax.nn.log_sigmoid(2.0 + nrm(ks[6], (N_EVEN, DEC_BATCH, PAST_LEN, H_B), 0.5)),
        'cache_c_k': nrm(ks[7], (N_ODD, DEC_BATCH, w_c, H_C, HEAD_DIM)),
        'cache_c_v': nrm(ks[8], (N_ODD, DEC_BATCH, w_c, H_C, HEAD_DIM)),
        'w_in_even': nrm(ks[9], (N_EVEN, D_MODEL, D_IN_EVEN), D_MODEL ** -0.5),
        'b_forget': 2.0 + nrm(ks[10], (N_EVEN, H_B), 0.1),
        'lam_q1': nrm(ks[11], (N_EVEN, DK_A), 0.1),
        'lam_k1': nrm(ks[12], (N_EVEN, DK_A), 0.1),
        'lam_q2': nrm(ks[13], (N_EVEN, DK_A), 0.1),
        'lam_k2': nrm(ks[14], (N_EVEN, DK_A), 0.1),
        'subln_g': 1.0 + nrm(ks[15], (N_EVEN, DV_A), 0.05),
        'w_out_even': nrm(ks[16], (N_EVEN, D_MIX, D_MODEL), D_MIX ** -0.5),
        'w_in_odd': nrm(ks[17], (N_ODD, D_MODEL, 3 * D_MODEL), D_MODEL ** -0.5),
        'rel_bias': nrm(ks[18], (N_ODD, H_C, 2 * REL_CLIP + 1), 0.5),
        'w_out_odd': nrm(ks[19], (N_ODD, D_MODEL, D_MODEL), D_MODEL ** -0.5),
        'g_pre_mix': 1.0 + nrm(ks[20], (DEPTH, D_MODEL), 0.05),
        'g_post_mix': 1.0 + nrm(ks[21], (DEPTH, D_MODEL), 0.05),
        'g_pre_ffn': 1.0 + nrm(ks[22], (DEPTH, D_MODEL), 0.05),
        'g_post_ffn': 1.0 + nrm(ks[23], (DEPTH, D_MODEL), 0.05),
        'w_ffn_up': nrm(ks[24], (DEPTH, D_MODEL, D_FF), D_MODEL ** -0.5),
        'w_ffn_down': nrm(ks[25], (DEPTH, D_FF, D_MODEL), D_FF ** -0.5),
    }


def reference(x_prompt, x_sample, cache_a_k, cache_a_v, cache_b_k, cache_b_v, cache_b_logf,
              cache_c_k, cache_c_v, w_in_even, b_forget, lam_q1, lam_k1, lam_q2, lam_k2,
              subln_g, w_out_even, w_in_odd, rel_bias, w_out_odd, g_pre_mix, g_post_mix,
              g_pre_ffn, g_post_ffn, w_ffn_up, w_ffn_down):
    past_len = cache_b_logf.shape[2]
    xp, xs = x_prompt, x_sample
    even_p, even_s, odd_p, odd_s = [], [], [], []
    for l in range(DEPTH):
        hp = rmsnorm(xp, g_pre_mix[l])
        hs = rmsnorm(xs, g_pre_mix[l])
        if l % 2 == 0:
            e = l // 2
            lam_init = 0.8 - 0.6 * math.exp(-0.3 * l)
            lam = diff_lambda(lam_q1[e], lam_k1[e], lam_q2[e], lam_k2[e], lam_init)
            mp, rp = even_mixer_prompt(hp, w_in_even[e], b_forget[e], lam, subln_g[e], lam_init, w_out_even[e])
            ms, rs = even_mixer_sample(hs, cache_a_k[e], cache_a_v[e], cache_b_k[e], cache_b_v[e], cache_b_logf[e],
                                       w_in_even[e], b_forget[e], lam, subln_g[e], lam_init, w_out_even[e])
            even_p.append(rp)
            even_s.append(rs)
        else:
            o = l // 2
            mp, rp = odd_mixer_prompt(hp, w_in_odd[o], rel_bias[o], w_out_odd[o])
            ms, rs = odd_mixer_sample(hs, cache_c_k[o], cache_c_v[o], past_len, w_in_odd[o], rel_bias[o], w_out_odd[o])
            odd_p.append(rp)
            odd_s.append(rs)
        xp = xp + rmsnorm(mp, g_post_mix[l])
        xs = xs + rmsnorm(ms, g_post_mix[l])
        xp = xp + rmsnorm(squared_relu_mlp(rmsnorm(xp, g_pre_ffn[l]), w_ffn_up[l], w_ffn_down[l]), g_post_ffn[l])
        xs = xs + rmsnorm(squared_relu_mlp(rmsnorm(xs, g_pre_ffn[l]), w_ffn_up[l], w_ffn_down[l]), g_post_ffn[l])

    new_pa_k = jnp.stack([r[0] for r in even_p])
    new_pa_v = jnp.stack([r[1] for r in even_p])
    new_pb_k = jnp.stack([r[2] for r in even_p])
    new_pb_v = jnp.stack([r[3] for r in even_p])
    new_pb_logf = jnp.stack([r[4] for r in even_p])
    new_pc_k = jnp.stack([r[0] for r in odd_p])
    new_pc_v = jnp.stack([r[1] for r in odd_p])
    new_sa_k = jnp.stack([r[0] for r in even_s])
    new_sa_v = jnp.stack([r[1] for r in even_s])
    new_sb_k = jnp.stack([r[2] for r in even_s])
    new_sb_v = jnp.stack([r[3] for r in even_s])
    new_sb_logf = jnp.stack([r[4] for r in even_s])
    new_sc_k = jnp.stack([r[0] for r in odd_s])
    new_sc_v = jnp.stack([r[1] for r in odd_s])
    return (xp, xs, new_pa_k, new_pa_v, new_pb_k, new_pb_v, new_pb_logf, new_pc_k, new_pc_v,
            new_sa_k, new_sa_v, new_sb_k, new_sb_v, new_sb_logf, new_sc_k, new_sc_v)
```

```cpp
#include <hip/hip_runtime.h>
#include <hip/hip_cooperative_groups.h>
#include <cstdio>
#include <cstdint>
namespace cg = cooperative_groups;
#ifndef MK_ONE_LAUNCH
#define MK_ONE_LAUNCH 1
#endif
namespace pg8 {
#define PG8_LAS __attribute__((address_space(3)))
typedef unsigned short bf16_t;
typedef short bf16x8 __attribute__((ext_vector_type(8)));
typedef float f32x4 __attribute__((ext_vector_type(4)));
typedef unsigned u32x4 __attribute__((ext_vector_type(4)));
constexpr int BM = 256, BK = 64, HALF = 128, HTB = HALF * BK * 2  , STAGE_BYTES = 8 * HTB, NXCD = 8, WGM = 8;

__host__ __device__ __forceinline__ int lds_byte(int r, int c) { const int st = (r >> 4) * 2 + (c >> 5), rr = r & 15, cc = c & 31, ob = rr * 64 + cc * 2; return st * 1024 + (ob ^ (((ob >> 9) & 1) << 5)); }
__host__ __device__ __forceinline__ void stage_rc(int b, int& R, int& C) { const int st = b / 1024, sb = b % 1024, swz = sb ^ (((sb >> 9) & 1) << 5); R = (st >> 1) * 16 + swz / 64; C = (st & 1) * 32 + (swz % 64) / 2; }
__host__ __device__ __forceinline__ int perm32(int rho) { const int n = rho >> 4, i = rho & 15; return 8 * (i >> 2) + 4 * n + (i & 3); }

struct Unit { int pm, pn; };
struct Gemm { const bf16_t* A; const bf16_t* Bt; int M, N, K; };

struct StaticOrder {
    int nM, nN, nwg, G, c;
    __host__ __device__ void init(int M, int N, int G_, int c_) { nM = M / BM; nN = N / BM; nwg = nM * nN; G = G_; c = c_; }
    __host__ __device__ bool next(int i, Unit& u) const {
        const long L = (long)i * G + c; if (L >= nwg) return false;
        int wgid = (int)L; { const int q = nwg / NXCD, r = nwg % NXCD, xcd = wgid % NXCD, off = wgid / NXCD; wgid = (xcd < r ? xcd * (q + 1) : r * (q + 1) + (xcd - r) * q) + off; }
        const int nig = WGM * nN, gid = wgid / nig, fm = gid * WGM, gsz = (nM - fm) < WGM ? (nM - fm) : WGM;
        u.pm = fm + ((wgid % nig) % gsz); u.pn = (wgid % nig) / gsz; return true;
    }
    __device__ __forceinline__ void a_ready(const Unit&) const {}
    __device__ __forceinline__ void done(const Unit&) const {}
};

__device__ __forceinline__ unsigned cvt_pk_bf16(float lo, float hi) { unsigned r; asm volatile("v_cvt_pk_bf16_f32 %0, %1, %2" : "=v"(r) : "v"(lo), "v"(hi)); return r; }
typedef float f32x2 __attribute__((ext_vector_type(2)));
template <class Epi, class Sched, bool ALIGN_EPI = false, bool SP2 = false>
__device__ __forceinline__ void gemm_phase(PG8_LAS unsigned char* lds, const Gemm g, const Sched& S, const Epi& E) {
    int tid_l = threadIdx.x; asm volatile("" : "+v"(tid_l));
    const int tid = tid_l, wid = __builtin_amdgcn_readfirstlane(tid >> 6), lane = tid & 63, wr = wid >> 2, wc = wid & 3, fr = lane & 15, fq = lane >> 4;
    const int K = g.K, nt = K / BK;
    unsigned voffA[2], voffB[2];
#pragma unroll
    for (int i = 0; i < 2; ++i) { int R, C; stage_rc(tid * 16 + i * 8192, R, C); const int Rb = Epi::PERM ? ((R & ~31) + perm32(R & 31)) : R;
        voffA[i] = (unsigned)(R * K + C) * 2u; voffB[i] = (unsigned)(Rb * K + C) * 2u; }
    const size_t kstep = (size_t)(BK * 2);
    const size_t hstep = (size_t)HALF * K * 2;
    const size_t tstep = 2 * hstep;
    const unsigned ldsw = (unsigned)wid * 1024u;
    const int aoff = lds_byte(wr * 64 + fr, fq * 8), boff = lds_byte(wc * 32 + fr, fq * 8);
#define PG8_SA(b, h) (((b) * 2 + (h)) * HTB)
#define PG8_SB(b, h) ((4 + (b) * 2 + (h)) * HTB)
#define PG8_STAGE(bufoff, gbase, voff) do { _Pragma("unroll") for (int _i = 0; _i < 2; ++_i) \
        __builtin_amdgcn_global_load_lds((const unsigned*)((const char*)(gbase) + (voff)[_i]), (PG8_LAS unsigned*)(lds + (bufoff) + ldsw + _i * 8192), 16, 0, 0); } while (0)
#define PG8_LDA(dst, b, h) do { _Pragma("unroll") for (int m = 0; m < 4; ++m) _Pragma("unroll") for (int k = 0; k < 2; ++k) dst[m][k] = *(const PG8_LAS bf16x8*)(lds + PG8_SA(b, h) + aoff + m * 2048 + k * 1024); } while (0)
#define PG8_LDB(dst, b, h) do { _Pragma("unroll") for (int n = 0; n < 2; ++n) _Pragma("unroll") for (int k = 0; k < 2; ++k) dst[n][k] = *(const PG8_LAS bf16x8*)(lds + PG8_SB(b, h) + boff + n * 2048 + k * 1024); } while (0)
#define PG8_MMA(ai, bj, At, Bt) do { __builtin_amdgcn_s_setprio(1); _Pragma("unroll") for (int m = 0; m < 4; ++m) _Pragma("unroll") for (int n = 0; n < 2; ++n) _Pragma("unroll") for (int k = 0; k < 2; ++k) \
        acc[ai][bj][m][n] = __builtin_amdgcn_mfma_f32_16x16x32_bf16(Bt[n][k], At[m][k], acc[ai][bj][m][n], 0, 0, 0); __builtin_amdgcn_s_setprio(0); } while (0)
#define PG8_WAIT_V(n) asm volatile("s_waitcnt vmcnt(" #n ")" ::: "memory")
#define PG8_WAIT_L(n) asm volatile("s_waitcnt lgkmcnt(" #n ")" ::: "memory")
#define PG8_BAR __builtin_amdgcn_s_barrier()
#define PG8_SCHED __builtin_amdgcn_sched_barrier(0)
    Unit cur, nxt; int ui = 0;
    if (!S.next(0, cur)) return;
    f32x4 acc[2][2][4][2];
#pragma unroll
    for (int a = 0; a < 2; ++a)
#pragma unroll
        for (int b = 0; b < 2; ++b)
#pragma unroll
            for (int m = 0; m < 4; ++m)
#pragma unroll
                for (int n = 0; n < 2; ++n) acc[a][b][m][n] = (f32x4){0.f, 0.f, 0.f, 0.f};
    bf16x8 At[4][2], B0[2][2], B1[2][2];
    const char* cA = (const char*)g.A + (size_t)cur.pm * tstep; const char* cB = (const char*)g.Bt + (size_t)cur.pn * tstep;
    S.a_ready(cur);
    if constexpr (SP2) {
        PG8_STAGE(PG8_SB(0, 0), cB, voffB); PG8_STAGE(PG8_SB(0, 1), cB + hstep, voffB); PG8_STAGE(PG8_SA(0, 0), cA, voffA); PG8_STAGE(PG8_SA(0, 1), cA + hstep, voffA);
        if (wr == 1) PG8_BAR;
        PG8_WAIT_V(2); PG8_BAR;
        PG8_STAGE(PG8_SB(1, 0), cB + kstep, voffB); PG8_STAGE(PG8_SA(1, 0), cA + kstep, voffA); PG8_STAGE(PG8_SB(1, 1), cB + hstep + kstep, voffB);
        PG8_WAIT_V(6); PG8_BAR;
    } else {
        PG8_STAGE(PG8_SB(0, 0), cB, voffB); PG8_STAGE(PG8_SA(0, 0), cA, voffA); PG8_STAGE(PG8_SB(0, 1), cB + hstep, voffB); PG8_STAGE(PG8_SA(0, 1), cA + hstep, voffA);
        if (wr == 1) PG8_BAR;
        PG8_WAIT_V(4); PG8_BAR;
        PG8_STAGE(PG8_SB(1, 0), cB + kstep, voffB); PG8_STAGE(PG8_SA(1, 0), cA + kstep, voffA); PG8_STAGE(PG8_SB(1, 1), cB + hstep + kstep, voffB);
        PG8_WAIT_V(6); PG8_BAR;
    }
    for (;;) {
        const bool has_next = S.next(ui + 1, nxt);
        const char* nA = has_next ? (const char*)g.A + (size_t)nxt.pm * tstep : cA; const char* nB = has_next ? (const char*)g.Bt + (size_t)nxt.pn * tstep : cB;
        for (int t = 0; t < nt; t += 2) {
            const bool last = (t == nt - 2);
            const char* a1 = cA + (size_t)(t + 1) * kstep;
            const char* a2 = last ? nA : cA + (size_t)(t + 2) * kstep; const char* b2 = last ? nB : cB + (size_t)(t + 2) * kstep;
            const char* a3 = a2 + kstep; const char* b3 = b2 + kstep;
            if (last && has_next) S.a_ready(nxt);
            if constexpr (SP2) {
            PG8_LDB(B0, 0, 0); PG8_LDB(B1, 0, 1); PG8_SCHED; PG8_LDA(At, 0, 0); PG8_STAGE(PG8_SA(1, 1), a1 + hstep, voffA);
            PG8_WAIT_V(8); PG8_WAIT_L(0); PG8_BAR; PG8_MMA(0, 0, At, B0); PG8_MMA(0, 1, At, B1); PG8_BAR; PG8_SCHED;
            PG8_LDA(At, 0, 1); PG8_STAGE(PG8_SB(0, 0), b2, voffB); PG8_STAGE(PG8_SB(0, 1), b2 + hstep, voffB); PG8_STAGE(PG8_SA(0, 0), a2, voffA);
            PG8_WAIT_V(8); PG8_WAIT_L(0); PG8_BAR; PG8_MMA(1, 0, At, B0); PG8_MMA(1, 1, At, B1); PG8_BAR; PG8_SCHED;
            PG8_LDB(B0, 1, 0); PG8_LDB(B1, 1, 1); PG8_SCHED; PG8_LDA(At, 1, 0); PG8_STAGE(PG8_SA(0, 1), a2 + hstep, voffA);
            PG8_WAIT_V(8); PG8_WAIT_L(0); PG8_BAR; PG8_MMA(0, 0, At, B0); PG8_MMA(0, 1, At, B1); PG8_BAR; PG8_SCHED;
            PG8_LDA(At, 1, 1); PG8_STAGE(PG8_SB(1, 0), b3, voffB); PG8_STAGE(PG8_SB(1, 1), b3 + hstep, voffB); PG8_STAGE(PG8_SA(1, 0), a3, voffA);
            PG8_WAIT_V(8); PG8_WAIT_L(0); PG8_BAR; PG8_MMA(1, 0, At, B0); PG8_MMA(1, 1, At, B1); PG8_BAR; PG8_SCHED;
            } else {
            PG8_LDB(B0, 0, 0); PG8_SCHED; PG8_LDA(At, 0, 0); PG8_STAGE(PG8_SA(1, 1), a1 + hstep, voffA);
            PG8_WAIT_L(8); PG8_BAR; PG8_WAIT_L(0); PG8_MMA(0, 0, At, B0); PG8_BAR; PG8_SCHED;
            PG8_LDB(B1, 0, 1); PG8_STAGE(PG8_SB(0, 0), b2, voffB);
            PG8_BAR; PG8_WAIT_L(0); PG8_MMA(0, 1, At, B1); PG8_BAR;
            PG8_LDA(At, 0, 1); PG8_STAGE(PG8_SA(0, 0), a2, voffA);
            PG8_BAR; PG8_WAIT_L(0); PG8_MMA(1, 0, At, B0); PG8_BAR; PG8_SCHED;
            PG8_STAGE(PG8_SB(0, 1), b2 + hstep, voffB);
            PG8_WAIT_V(6); PG8_BAR; PG8_MMA(1, 1, At, B1); PG8_BAR;
            PG8_LDB(B0, 1, 0); PG8_SCHED; PG8_LDA(At, 1, 0); PG8_STAGE(PG8_SA(0, 1), a2 + hstep, voffA);
            PG8_WAIT_L(8); PG8_BAR; PG8_WAIT_L(0); PG8_MMA(0, 0, At, B0); PG8_BAR; PG8_SCHED;
            PG8_LDB(B1, 1, 1); PG8_STAGE(PG8_SB(1, 0), b3, voffB);
            PG8_BAR; PG8_WAIT_L(0); PG8_MMA(0, 1, At, B1); PG8_BAR;
            PG8_LDA(At, 1, 1); PG8_STAGE(PG8_SA(1, 0), a3, voffA);
            PG8_BAR; PG8_WAIT_L(0); PG8_MMA(1, 0, At, B0); PG8_BAR; PG8_SCHED;
            PG8_STAGE(PG8_SB(1, 1), b3 + hstep, voffB);
            PG8_WAIT_V(6); PG8_BAR; PG8_MMA(1, 1, At, B1); PG8_BAR;
            }
        }
        if constexpr (ALIGN_EPI) { if (wr == 0) PG8_BAR; }
        if constexpr (!Epi::AFTER_DRAIN) { E(acc, cur, wr, wc, fr, fq); S.done(cur); }
        if (!has_next) break;
#pragma unroll
        for (int a = 0; a < 2; ++a)
#pragma unroll
            for (int b = 0; b < 2; ++b)
#pragma unroll
                for (int m = 0; m < 4; ++m)
#pragma unroll
                    for (int n = 0; n < 2; ++n) acc[a][b][m][n] = (f32x4){0.f, 0.f, 0.f, 0.f};
        cur = nxt; cA = nA; cB = nB; ++ui;
        if constexpr (ALIGN_EPI) { if (wr == 1) PG8_BAR; }
    }
    PG8_WAIT_V(0);
    if constexpr (!ALIGN_EPI) { if (wr == 0) PG8_BAR; }
    PG8_BAR;
    if constexpr (Epi::AFTER_DRAIN) { E.fused(acc, cur, wr, wc, fr, fq, lds, wid, lane); S.done(cur); }
#undef PG8_SA
#undef PG8_SB
#undef PG8_STAGE
#undef PG8_LDA
#undef PG8_LDB
#undef PG8_MMA
#undef PG8_WAIT_V
#undef PG8_WAIT_L
#undef PG8_BAR
#undef PG8_SCHED
}
}

typedef unsigned short bf16_t;
typedef short bf16x8 __attribute__((ext_vector_type(8)));
typedef short s16x4 __attribute__((ext_vector_type(4)));
typedef float f32x4 __attribute__((ext_vector_type(4)));
typedef float f32x2 __attribute__((ext_vector_type(2)));
typedef float f32x16 __attribute__((ext_vector_type(16)));
typedef unsigned u32x4 __attribute__((ext_vector_type(4)));
typedef unsigned u32x2 __attribute__((ext_vector_type(2)));
#define LAS __attribute__((address_space(3)))
#define DI __device__ __forceinline__

constexpr int DM = 1024, FF = 4096, MP = 16384, MS = 512, MT = MP + MS, SEQ = 4096, PAST = 1024, DSEQ = 64;
constexpr int ZP = 3072;
constexpr float LOG2E = 1.4426950408889634f;
constexpr float C2 = 0.125f * LOG2E;
constexpr float EPS = 1e-6f;
constexpr size_t O_YP = 0, O_YS = O_YP + (size_t)MP * DM, O_PAK = O_YS + (size_t)MS * DM, O_PAV = O_PAK + (size_t)MP * 512, O_PBK = O_PAV + (size_t)MP * 512,
                 O_PBV = O_PBK + (size_t)MP * 512, O_PBL = O_PBV + (size_t)MP * 512, O_PCK = O_PBL + (size_t)MP * 8, O_PCV = O_PCK + (size_t)4 * 512 * 1024,
                 O_SAK = O_PCV + (size_t)4 * 512 * 1024, O_SAV = O_SAK + (size_t)MS * 512, O_SBK = O_SAV + (size_t)MS * 512, O_SBV = O_SBK + (size_t)MS * 512,
                 O_SBL = O_SBV + (size_t)MS * 512, O_SCK = O_SBL + (size_t)MS * 8, O_SCV = O_SCK + (size_t)8 * 512 * 1024, O_END = O_SCV + (size_t)8 * 512 * 1024;
static_assert(O_END == 64622592, "output size");
constexpr size_t MiB = 1u << 20;
constexpr size_t WS_WINE = 1 * MiB, WS_WOUTE = 7 * MiB, WS_WINO = 9 * MiB, WS_WOUTO = 15 * MiB, WS_WUP = 17 * MiB  , WS_WDN = 33 * MiB  ;
constexpr size_t WS_XN = 49 * MiB, WS_Y = 82 * MiB, WS_CUMP = 115 * MiB, WS_CUMS = WS_CUMP + 524288, WS_Z = 116 * MiB, WS_ATT = 215 * MiB, WS_H = 116 * MiB, WS_END = 248 * MiB;
enum { I_XP = 0, I_XS, I_CAK, I_CAV, I_CBK, I_CBV, I_CBL, I_CCK, I_CCV, I_WINE, I_BF, I_LQ1, I_LK1, I_LQ2, I_LK2, I_SUBG, I_WOUTE, I_WINO, I_REL, I_WOUTO,
       I_GPM, I_GQM, I_GPF, I_GQF, I_WUP, I_WDN, N_IN };
constexpr int NWAVES = 8, NTHR = 512;
constexpr int LDS_BYTES = 147456;

struct Args { const float* in[N_IN]; float* out; unsigned char* ws; int ph_lo, ph_hi; };
typedef const __attribute__((address_space(4))) Args* ArgsP;
DI int launder(int v) { asm volatile("" : "+s"(v)); return v; }
DI ArgsP fresh_args() { ArgsP p = (ArgsP)__builtin_amdgcn_kernarg_segment_ptr(); asm volatile("" : "+s"(p)); return p; }

DI float wave_sum(float v) {
#pragma unroll
    for (int o = 1; o < 64; o <<= 1) v += __shfl_xor(v, o);
    return v;
}
DI unsigned pk2(float lo, float hi) { typedef __bf16 b2 __attribute__((ext_vector_type(2))); f32x2 v = {lo, hi}; b2 b = __builtin_convertvector(v, b2); return __builtin_bit_cast(unsigned, b); }
DI float bf2f(unsigned short h) { return __uint_as_float(((unsigned)h) << 16); }

template <int MODE> struct EpiX {
    static constexpr bool PERM = true, AFTER_DRAIN = false;
    bf16_t* O; int ldc; float* out;
    __device__ __forceinline__ void operator()(const pg8::f32x4 (&acc)[2][2][4][2], const pg8::Unit& u, int wr, int wc, int fr, int fq) const {
        const unsigned loff = (unsigned)(fr * ldc + 8 * fq) * 2u;
        char* ub = (char*)O + ((size_t)(u.pm * 256 + wr * 64) * ldc + u.pn * 256 + wc * 32) * 2;
        float sc = 1.f; char* fb = nullptr; unsigned floff = 0; int fpitch = 0; bool smp3 = false;
        if (MODE == 2) {
            const int seg = u.pn >> 1; fpitch = 512; floff = (unsigned)(fr * 512 + 8 * fq) * 4u;
            if (seg == 0 || seg == 3) sc = C2;
            else {
                const bool smp = u.pm >= 64;
                const size_t off = seg == 1 ? (smp ? O_SAK : O_PAK) : seg == 2 ? (smp ? O_SAV : O_PAV) : seg == 4 ? (smp ? O_SBK : O_PBK) : (smp ? O_SBV : O_PBV);
                fb = (char*)(out + off + (size_t)((smp ? u.pm - 64 : u.pm) * 256 + wr * 64) * 512 + (u.pn & 1) * 256 + wc * 32);
            }
        } else if (MODE == 3) {
            const int seg = u.pn >> 2; fpitch = 1024; floff = (unsigned)(fr * 1024 + 8 * fq) * 4u;
            if (seg == 0) sc = C2;
            else if (u.pm >= 64) { smp3 = true; fb = (char*)(out + (seg == 1 ? O_SCK : O_SCV) + (size_t)(((u.pm - 64) * 4 + wr) * 512 + 448) * 1024 + (u.pn & 3) * 256 + wc * 32); }
            else if ((u.pm & 15) >= 14) fb = (char*)(out + (seg == 1 ? O_PCK : O_PCV) + (size_t)((u.pm >> 4) * 512 + ((u.pm & 15) - 14) * 256 + wr * 64) * 1024 + (u.pn & 3) * 256 + wc * 32);
        }
#pragma unroll
        for (int ai = 0; ai < 2; ++ai)
#pragma unroll
            for (int m = 0; m < 4; ++m) {
                char* rb = ub + (size_t)(ai * 128 + m * 16) * ldc * 2;
                char* frb = nullptr;
                if (MODE >= 2 && fb) frb = fb + (size_t)((MODE == 3 && smp3) ? (ai * 1024 + m * 16) : (ai * 128 + m * 16)) * fpitch * 4;
#pragma unroll
                for (int bj = 0; bj < 2; ++bj) {
                    pg8::f32x4 v0 = acc[ai][bj][m][0], v1 = acc[ai][bj][m][1];
                    if (MODE >= 2 && frb) { *(pg8::f32x4*)(frb + bj * 512 + floff) = v0; *(pg8::f32x4*)(frb + bj * 512 + 16 + floff) = v1; }
                    if (MODE == 1) {
#pragma unroll
                        for (int e = 0; e < 4; ++e) { float a = fmaxf(v0[e], 0.f), b = fmaxf(v1[e], 0.f); v0[e] = a * a; v1[e] = b * b; }
                    }
                    if (MODE >= 2) { v0 = v0 * sc; v1 = v1 * sc; }
                    pg8::u32x4 w; w.x = pg8::cvt_pk_bf16(v0[0], v0[1]); w.y = pg8::cvt_pk_bf16(v0[2], v0[3]); w.z = pg8::cvt_pk_bf16(v1[0], v1[1]); w.w = pg8::cvt_pk_bf16(v1[2], v1[3]);
                    *(pg8::u32x4*)(rb + bj * 256 + loff) = w;
                }
                asm volatile("" ::: "memory");
            }
    }
};

namespace att {
constexpr int KP = 272, VP = 320;
constexpr int KT_B = 64 * KP, VT_B = 64 * VP;
constexpr int OFF_K = 0, OFF_V = 2 * KT_B, OFF_CUM = 2 * KT_B + 2 * VT_B  , OFF_TBL = OFF_CUM + 1024, OFF_END = OFF_TBL + 2 * 640 * 4;
static_assert(OFF_END <= 131072 && 65536 <= OFF_CUM, "attention LDS map");
struct Job {
    const bf16_t* q;
    const float* kc; const float* vc; int cpitch; int nc;
    const bf16_t* kz; const bf16_t* vz;
    int kt_lo, kt_hi, qpos0, kpos0, nq_sub;
    const float* cum; int cum_hs;
    const float* tbl;
    bf16_t* o;
    float slope2; const float* subg;
};
#define MFMA32(a, b, c) __builtin_amdgcn_mfma_f32_32x32x16_bf16((a), (b), (c), 0, 0, 0)
DI u32x4 pack8(const f32x4 a, const f32x4 b) { u32x4 r; r.x = pk2(a[0], a[1]); r.y = pk2(a[2], a[3]); r.z = pk2(b[0], b[1]); r.w = pk2(b[2], b[3]); return r; }
DI s16x4 vtr(const LAS unsigned char* p) { typedef short v4 __attribute__((ext_vector_type(4))); return __builtin_bit_cast(s16x4, __builtin_amdgcn_ds_read_tr16_b64_v4i16((LAS v4*)p)); }

DI void load_tile(const Job& J, int kt, int srow, int sch, u32x4& r0, u32x4& r1, u32x4& r2, u32x4& r3) {
    if (kt >= J.nc) {
        const size_t o0 = (size_t)((kt - J.nc) * 64 + srow) * ZP + sch * 8, o1 = o0 + (size_t)32 * ZP;
        r0 = *(const u32x4*)(J.kz + o0); r1 = *(const u32x4*)(J.kz + o1); r2 = *(const u32x4*)(J.vz + o0); r3 = *(const u32x4*)(J.vz + o1);
    }
}
DI void store_tile(const Job& J, int kt, int buf, int srow, int sch, u32x4& r0, u32x4& r1, u32x4& r2, u32x4& r3, LAS unsigned char* lds) {
    if (kt < J.nc) {
        const size_t o0 = (size_t)(kt * 64 + srow) * J.cpitch + sch * 8, o1 = o0 + (size_t)32 * J.cpitch;
        r0 = pack8(*(const f32x4*)(J.kc + o0), *(const f32x4*)(J.kc + o0 + 4)); r1 = pack8(*(const f32x4*)(J.kc + o1), *(const f32x4*)(J.kc + o1 + 4));
        r2 = pack8(*(const f32x4*)(J.vc + o0), *(const f32x4*)(J.vc + o0 + 4)); r3 = pack8(*(const f32x4*)(J.vc + o1), *(const f32x4*)(J.vc + o1 + 4));
    }
    LAS unsigned char* kb = lds + OFF_K + buf * KT_B + srow * KP + sch * 16; LAS unsigned char* vb = lds + OFF_V + buf * VT_B + srow * VP + sch * 16;
    *(LAS u32x4*)kb = r0; *(LAS u32x4*)(kb + 32 * KP) = r1; *(LAS u32x4*)vb = r2; *(LAS u32x4*)(vb + 32 * VP) = r3;
}

template <int MODE> DI Job make_job(int s_) {
    const int s = launder(s_);
    ArgsP a = fresh_args(); Job J{};
    const bf16_t* z = (const bf16_t*)(a->ws + WS_Z); bf16_t* attb = (bf16_t*)(a->ws + WS_ATT);
    if (MODE < 2) {
        const int qcol = MODE == 0 ? 0 : 1536, kcol = MODE == 0 ? 512 : 2048, vcol = MODE == 0 ? 1024 : 2560, ocol = MODE == 0 ? 0 : 512;
        if (s < 512) {
            const int j = s & 255, u = (s >> 8) ? (j >> 4) : 31 - (j >> 4), bh = j & 15, b = bh >> 2, hh = bh & 3;
            const size_t row0 = (size_t)b * SEQ + 128 * u, rb = (size_t)b * SEQ;
            J.nc = 0; J.kt_lo = 0; J.kt_hi = 2 * u + 1; J.qpos0 = 128 * u; J.kpos0 = 0; J.nq_sub = 4;
            J.q = z + row0 * ZP + qcol + hh * 128; J.kz = z + rb * ZP + kcol + hh * 128; J.vz = z + rb * ZP + vcol + hh * 128; J.o = attb + row0 * DM + ocol + hh * 128;
            J.slope2 = exp2f(-2.f * (float)(hh + 1)) * LOG2E;
            J.cum = (const float*)(a->ws + WS_CUMP) + (size_t)(b * 8 + 2 * hh) * 4096; J.cum_hs = 4096;
        } else {
            const int jj = s - 512, b = jj >> 2, hh = jj & 3; const size_t row0 = (size_t)MP + b * DSEQ;
            J.nc = 16; J.cpitch = 512; J.kt_lo = 0; J.kt_hi = 16; J.qpos0 = PAST; J.kpos0 = 0; J.nq_sub = 2;
            J.q = z + row0 * ZP + qcol + hh * 128; J.kz = z + row0 * ZP + kcol + hh * 128; J.vz = z + row0 * ZP + vcol + hh * 128; J.o = attb + row0 * DM + ocol + hh * 128;
            J.kc = a->in[MODE == 0 ? I_CAK : I_CBK] + (size_t)b * PAST * 512 + hh * 128; J.vc = a->in[MODE == 0 ? I_CAV : I_CBV] + (size_t)b * PAST * 512 + hh * 128;
            J.slope2 = exp2f(-2.f * (float)(hh + 1)) * LOG2E;
            J.cum = (const float*)(a->ws + WS_CUMS) + (size_t)(b * 8 + 2 * hh) * 1088; J.cum_hs = 1088;
        }
        J.subg = a->in[I_SUBG];
    } else {
        if (s < 1024) {
            const int bh = s & 31, b = bh >> 3, hp = bh & 7, u = s >> 5; const size_t row0 = (size_t)b * SEQ + 128 * u, rb = (size_t)b * SEQ;
            J.q = z + row0 * ZP + hp * 128; J.kz = z + rb * ZP + 1024 + hp * 128; J.vz = z + rb * ZP + 2048 + hp * 128; J.o = attb + row0 * DM + hp * 128;
            J.nc = 0; J.kt_lo = 2 * u - 8 > 0 ? 2 * u - 8 : 0; J.kt_hi = 2 * u + 1; J.qpos0 = 128 * u; J.kpos0 = 0; J.nq_sub = 4; J.tbl = a->in[I_REL] + (size_t)(2 * hp) * 513;
        } else {
            const int id = s - 1024, b = id >> 3, hp = id & 7; const size_t row0 = (size_t)MP + b * DSEQ;
            J.q = z + row0 * ZP + hp * 128; J.kz = z + row0 * ZP + 1024 + hp * 128; J.vz = z + row0 * ZP + 2048 + hp * 128; J.o = attb + row0 * DM + hp * 128;
            J.kc = a->in[I_CCK] + (size_t)b * 512 * 1024 + hp * 128; J.vc = a->in[I_CCV] + (size_t)b * 512 * 1024 + hp * 128; J.cpitch = 1024; J.nc = 8;
            J.kt_lo = 0; J.kt_hi = 8; J.qpos0 = PAST; J.kpos0 = 512; J.nq_sub = 2; J.tbl = a->in[I_REL] + (size_t)(2 * hp) * 513;
        }
    }
    return J;
}

template <int MODE>
DI void attn_unit(LAS unsigned char* lds, const int slot) {
    constexpr int NDB = (MODE == 0) ? 4 : 2;
    int tid_l = threadIdx.x; asm volatile("" : "+v"(tid_l));
    const int tid = tid_l, lane = tid & 63, wid = __builtin_amdgcn_readfirstlane(tid >> 6);
    const int qs = wid >> 1, half = wid & 1, r32 = lane & 31, hi = lane >> 5;
    const int srow = tid >> 4, sch = tid & 15;
    const int qin = (32 * qs + r32) & 63;
    bool active; int qc_w, kc0, kt, nt, qk0;
    bf16x8 qr[4];
    u32x4 r0 = {0u, 0u, 0u, 0u}, r1 = r0, r2 = r0, r3 = r0; float cumv = 0.f;
    __syncthreads();
    {
        const Job J = make_job<MODE>(slot);
        active = qs < J.nq_sub; qc_w = (J.qpos0 + 32 * qs) >> 6; kc0 = J.kpos0 >> 6; kt = J.kt_lo; nt = J.kt_hi - J.kt_lo + 1; qk0 = J.qpos0 - J.kpos0;
        if (MODE == 2) {
            for (int e = tid; e < 1280; e += NTHR) { const int hs = e >= 640 ? 1 : 0, idx = e - hs * 640, rel = idx - 63, c = (rel > 256 ? 256 : rel) + 256;
                ((LAS float*)(lds + OFF_TBL))[e] = J.tbl[hs * 513 + c] * LOG2E; }
        }
        const bf16_t* qp = J.q + (size_t)((active ? 32 * qs : 0) + r32) * ZP + half * 64 + 8 * hi;
#pragma unroll
        for (int d0 = 0; d0 < 4; ++d0) qr[d0] = *(const bf16x8*)(qp + 16 * d0);
        load_tile(J, kt, srow, sch, r0, r1, r2, r3);
        if (MODE == 1 && tid < 128) cumv = J.cum[(size_t)(tid >> 6) * J.cum_hs + kt * 64 + (tid & 63)];
        store_tile(J, kt, 0, srow, sch, r0, r1, r2, r3, lds);
        if (MODE == 1 && tid < 128) ((LAS float*)(lds + OFF_CUM))[tid] = cumv;
    }
    f32x16 o[NDB];
#pragma unroll
    for (int d = 0; d < NDB; ++d)
#pragma unroll
        for (int i = 0; i < 16; ++i) o[d][i] = 0.f;
    float m_run = -INFINITY, l_run = 0.f;
    __syncthreads();
    const int b16 = (lane >> 4) & 1, q4 = (lane & 15) >> 2, p4 = lane & 3;
    const int vcol0 = (MODE == 0) ? 0 : 64 * half;
    for (int it = 0; it < nt; ++it, ++kt) {
        const int buf = it & 1; const bool more = it + 1 < nt;
        float slope2 = 0.f;
        {
            const Job J = make_job<MODE>(slot);
            if (more) { load_tile(J, kt + 1, srow, sch, r0, r1, r2, r3); if (MODE == 1 && tid < 128) cumv = J.cum[(size_t)(tid >> 6) * J.cum_hs + (kt + 1) * 64 + (tid & 63)]; }
            if (MODE == 0) slope2 = J.slope2;
        }
        const int kc = kc0 + kt;
        const bool vis = active && kc <= qc_w && (MODE != 2 || kc >= qc_w - 8);
        if (vis) {
            const LAS unsigned char* Kb = lds + OFF_K + buf * KT_B + r32 * KP + half * 128 + hi * 16;
            f32x16 p0, p1;
#pragma unroll
            for (int i = 0; i < 16; ++i) { p0[i] = 0.f; p1[i] = 0.f; }
#pragma unroll
            for (int d0 = 0; d0 < 4; ++d0) {
                const bf16x8 kf0 = *(const LAS bf16x8*)(Kb + d0 * 32), kf1 = *(const LAS bf16x8*)(Kb + 32 * KP + d0 * 32);
                p0 = MFMA32(kf0, qr[d0], p0); p1 = MFMA32(kf1, qr[d0], p1);
            }
            const int qk = qk0 + 32 * qs + r32 - kt * 64 - 4 * hi;
            if (MODE == 0) {
                const float qrel = (float)qk;
#pragma unroll
                for (int i = 0; i < 16; ++i) { const float ci = (float)((i & 3) + 8 * (i >> 2));
                    p0[i] = fmaf(-slope2, fabsf(qrel - ci), p0[i]); p1[i] = fmaf(-slope2, fabsf(qrel - 32.f - ci), p1[i]); }
            } else if (MODE == 1) {
                const LAS float* ct = (const LAS float*)(lds + OFF_CUM) + buf * 128 + half * 64 + 4 * hi;
#pragma unroll
                for (int g = 0; g < 4; ++g) { const f32x4 c0 = *(const LAS f32x4*)(ct + 8 * g), c1 = *(const LAS f32x4*)(ct + 32 + 8 * g);
#pragma unroll
                    for (int e = 0; e < 4; ++e) { p0[4 * g + e] -= c0[e]; p1[4 * g + e] -= c1[e]; } }
                if (kc == qc_w) {
#pragma unroll
                    for (int i = 0; i < 16; ++i) { const int kin = (i & 3) + 8 * (i >> 2) + 4 * hi; if (kin > qin) p0[i] = -INFINITY; if (kin + 32 > qin) p1[i] = -INFINITY; }
                }
            } else {
                const LAS float* tb = (const LAS float*)(lds + OFF_TBL) + half * 640 + (qk + 63 - 59);
#pragma unroll
                for (int i = 0; i < 16; ++i) { const int ci = (i & 3) + 8 * (i >> 2); p0[i] += tb[59 - ci]; p1[i] += tb[59 - 32 - ci]; }
            }
            float mx = fmaxf(p0[0], p1[0]);
#pragma unroll
            for (int i = 1; i < 16; ++i) mx = fmaxf(mx, fmaxf(p0[i], p1[i]));
            mx = fmaxf(mx, __shfl_xor(mx, 32));
            const float m_new = fmaxf(m_run, mx), alpha = __builtin_amdgcn_exp2f(m_run - m_new);
            m_run = m_new; l_run *= alpha;
#pragma unroll
            for (int d = 0; d < NDB; ++d)
#pragma unroll
                for (int i = 0; i < 16; ++i) o[d][i] *= alpha;
            float ls = 0.f;
#pragma unroll
            for (int i = 0; i < 16; ++i) { p0[i] = __builtin_amdgcn_exp2f(p0[i] - m_new); p1[i] = __builtin_amdgcn_exp2f(p1[i] - m_new); ls += p0[i] + p1[i]; }
            l_run += ls;
            bf16x8 pf[4];
            { u32x4 t;
              t.x = pk2(p0[0], p0[1]); t.y = pk2(p0[2], p0[3]); t.z = pk2(p0[4], p0[5]); t.w = pk2(p0[6], p0[7]); pf[0] = __builtin_bit_cast(bf16x8, t);
              t.x = pk2(p0[8], p0[9]); t.y = pk2(p0[10], p0[11]); t.z = pk2(p0[12], p0[13]); t.w = pk2(p0[14], p0[15]); pf[1] = __builtin_bit_cast(bf16x8, t);
              t.x = pk2(p1[0], p1[1]); t.y = pk2(p1[2], p1[3]); t.z = pk2(p1[4], p1[5]); t.w = pk2(p1[6], p1[7]); pf[2] = __builtin_bit_cast(bf16x8, t);
              t.x = pk2(p1[8], p1[9]); t.y = pk2(p1[10], p1[11]); t.z = pk2(p1[12], p1[13]); t.w = pk2(p1[14], p1[15]); pf[3] = __builtin_bit_cast(bf16x8, t); }
            const LAS unsigned char* Vb = lds + OFF_V + buf * VT_B + (4 * hi + q4) * VP + (vcol0 + 16 * b16 + 4 * p4) * 2;
#pragma unroll
            for (int ks = 0; ks < 4; ++ks) {
#pragma unroll
                for (int d = 0; d < NDB; ++d) {
                    const LAS unsigned char* a = Vb + (16 * ks) * VP + d * 64;
                    const s16x4 lo = vtr(a), hv = vtr(a + 8 * VP);
                    const bf16x8 vf = __builtin_shufflevector(lo, hv, 0, 1, 2, 3, 4, 5, 6, 7);
                    o[d] = MFMA32(vf, pf[ks], o[d]);
                }
                __builtin_amdgcn_sched_barrier(0);
            }
        }
        if (more) {
            const Job J = make_job<MODE>(slot);
            store_tile(J, kt + 1, buf ^ 1, srow, sch, r0, r1, r2, r3, lds); if (MODE == 1 && tid < 128) ((LAS float*)(lds + OFF_CUM))[(buf ^ 1) * 128 + tid] = cumv;
        }
        __syncthreads();
    }
    const float l_tot = l_run + __shfl_xor(l_run, 32);
    const float inv = active ? 1.f / l_tot : 0.f;
    if (MODE != 0) {
        if (active) {
            const Job J = make_job<MODE>(slot);
            bf16_t* op = J.o + (size_t)(32 * qs + r32) * DM + half * 64 + 4 * hi;
#pragma unroll
            for (int d = 0; d < NDB; ++d)
#pragma unroll
                for (int g = 0; g < 4; ++g) { u32x2 w; w.x = pk2(o[d][4 * g] * inv, o[d][4 * g + 1] * inv); w.y = pk2(o[d][4 * g + 2] * inv, o[d][4 * g + 3] * inv);
                    *(u32x2*)(op + 32 * d + 8 * g) = w; }
        }
    } else {
        LAS float* ex = (LAS float*)lds + qs * 4096 + lane;
        if (active && half == 1) {
#pragma unroll
            for (int d = 0; d < NDB; ++d)
#pragma unroll
                for (int i = 0; i < 16; ++i) ex[(d * 16 + i) * 64] = o[d][i] * inv;
        }
        __syncthreads();
        if (active && half == 0) {
            const Job J = make_job<MODE>(slot);
            ArgsP a = fresh_args();
            const float lam = expf(wave_sum(a->in[I_LQ1][lane] * a->in[I_LK1][lane])) - expf(wave_sum(a->in[I_LQ2][lane] * a->in[I_LK2][lane])) + 0.2f;
            float ss = 0.f;
#pragma unroll
            for (int d = 0; d < NDB; ++d)
#pragma unroll
                for (int i = 0; i < 16; ++i) { const float v = o[d][i] * inv - lam * ex[(d * 16 + i) * 64]; o[d][i] = v; ss += v * v; }
            ss += __shfl_xor(ss, 32);
            const float rs = rsqrtf(ss * (1.f / 128.f) + EPS) * 0.8f;
            bf16_t* op = J.o + (size_t)(32 * qs + r32) * DM + 4 * hi;
#pragma unroll
            for (int d = 0; d < NDB; ++d)
#pragma unroll
                for (int g = 0; g < 4; ++g) { const f32x4 gg = *(const f32x4*)(J.subg + 32 * d + 8 * g + 4 * hi);
                    u32x2 w; w.x = pk2(o[d][4 * g] * rs * gg[0], o[d][4 * g + 1] * rs * gg[1]); w.y = pk2(o[d][4 * g + 2] * rs * gg[2], o[d][4 * g + 3] * rs * gg[3]);
                    *(u32x2*)(op + 32 * d + 8 * g) = w; }
        }
    }
}
}

#define LDS_WAIT() asm volatile("s_waitcnt lgkmcnt(0)" ::: "memory")
DI void transpose_item(const float* W, int ldw, int K, int nblk, bf16_t* WT, LAS float* scr, int item, int lane) {
    const int kb = item / nblk, nb = item - kb * nblk, k0 = 64 * kb, n0 = 32 * nb;
#pragma unroll 8
    for (int i = 0; i < 32; ++i) { const int kk = 2 * i + (lane >> 5); scr[kk * 33 + (lane & 31)] = W[(size_t)(k0 + kk) * ldw + n0 + (lane & 31)]; }
    LDS_WAIT();
    const int c = lane & 7;
#pragma unroll
    for (int j = 0; j < 4; ++j) { const int n = (lane >> 3) + 8 * j; const LAS float* s = scr + (8 * c) * 33 + n;
        u32x4 o; o.x = pk2(s[0 * 33], s[1 * 33]); o.y = pk2(s[2 * 33], s[3 * 33]); o.z = pk2(s[4 * 33], s[5 * 33]); o.w = pk2(s[6 * 33], s[7 * 33]);
        *(u32x4*)(WT + (size_t)(n0 + n) * K + k0 + 8 * c) = o; }
    LDS_WAIT();
}
DI float log_sigmoid(float x) { return fminf(x, 0.f) - log1pf(expf(-fabsf(x))); }

DI void prologue_phase(LAS unsigned char* lds, ArgsP a, int tid, int lane, int wave) {
    unsigned char* ws = a->ws;
    const int gw = launder((int)blockIdx.x) * NWAVES + wave, NGW = launder((int)gridDim.x) * NWAVES;
    {
        LAS float* scr = (LAS float*)(lds + wave * 8448);
        constexpr int I_IN = 16 * 96, I_O = 16 * 32, I_UP = 16 * 128, I_DN = 64 * 32;
        constexpr int NITEMS = 2 * I_IN + 2 * I_O + 2 * I_UP + 2 * I_DN;
        for (int it = gw; it < NITEMS; it += NGW) {
            int r = it;
            if (r < I_IN) { transpose_item(a->in[I_WINE], 3080, 1024, 96, (bf16_t*)(ws + WS_WINE), scr, r, lane); continue; } r -= I_IN;
            if (r < I_IN) { transpose_item(a->in[I_WINO], 3072, 1024, 96, (bf16_t*)(ws + WS_WINO), scr, r, lane); continue; } r -= I_IN;
            if (r < I_O) { transpose_item(a->in[I_WOUTE], 1024, 1024, 32, (bf16_t*)(ws + WS_WOUTE), scr, r, lane); continue; } r -= I_O;
            if (r < I_O) { transpose_item(a->in[I_WOUTO], 1024, 1024, 32, (bf16_t*)(ws + WS_WOUTO), scr, r, lane); continue; } r -= I_O;
            if (r < 2 * I_UP) { const int l = r / I_UP; transpose_item(a->in[I_WUP] + (size_t)l * 1024 * 4096, 4096, 1024, 128, (bf16_t*)(ws + WS_WUP + l * 8 * MiB), scr, r - l * I_UP, lane); continue; } r -= 2 * I_UP;
            { const int l = r / I_DN; transpose_item(a->in[I_WDN] + (size_t)l * 4096 * 1024, 1024, 4096, 32, (bf16_t*)(ws + WS_WDN + l * 8 * MiB), scr, r - l * I_DN, lane); }
        }
    }
    {
        const size_t per_b = (size_t)448 * 1024 / 4, total = 2 * 8 * per_b;
        for (size_t i = (size_t)blockIdx.x * NTHR + tid; i < total; i += (size_t)gridDim.x * NTHR) {
            const int kv = (int)(i / (8 * per_b)); const size_t r = i - (size_t)kv * 8 * per_b; const int b = (int)(r / per_b); const size_t e = r - (size_t)b * per_b;
            const f32x4* src = (const f32x4*)(a->in[kv ? I_CCV : I_CCK] + (size_t)b * 512 * 1024 + 64 * 1024) + e;
            f32x4* dst = (f32x4*)(a->out + (kv ? O_SCV : O_SCK) + (size_t)b * 512 * 1024) + e;
            *dst = *src;
        }
    }
    LAS float* wf = (LAS float*)(lds + 98304);
    __syncthreads();
    for (int e = tid; e < 8192; e += NTHR) { const int k = e >> 3, o = e & 7; wf[o * 1024 + k] = a->in[I_WINE][(size_t)k * 3080 + 3072 + o]; }
    __syncthreads();
    const float* gp = a->in[I_GPM]; bf16_t* xn = (bf16_t*)(ws + WS_XN);
    f32x4 g[4];
#pragma unroll
    for (int j = 0; j < 4; ++j) g[j] = ((const f32x4*)gp)[lane + 64 * j];
    for (int m = gw; m < MT; m += NGW) {
        const float* xr = m < MP ? a->in[I_XP] + (size_t)m * DM : a->in[I_XS] + (size_t)(m - MP) * DM;
        f32x4 v[4]; float ss = 0.f;
#pragma unroll
        for (int j = 0; j < 4; ++j) { v[j] = ((const f32x4*)xr)[lane + 64 * j]; ss += (v[j].x * v[j].x + v[j].y * v[j].y) + (v[j].z * v[j].z + v[j].w * v[j].w); }
#pragma unroll
        for (int j = 0; j < 4; ++j) ((f32x4*)(a->out + (size_t)m * DM))[lane + 64 * j] = v[j];
        const float rstd = rsqrtf(wave_sum(ss) * (1.f / DM) + EPS);
#pragma unroll
        for (int j = 0; j < 4; ++j) { v[j] = v[j] * rstd * g[j]; u32x2 w; w.x = pk2(v[j].x, v[j].y); w.y = pk2(v[j].z, v[j].w); ((u32x2*)(xn + (size_t)m * DM))[lane + 64 * j] = w; }
        float mine = 0.f;
#pragma unroll
        for (int o = 0; o < 8; ++o) { float acc = 0.f;
#pragma unroll
            for (int j = 0; j < 4; ++j) { const f32x4 w = *(const LAS f32x4*)(wf + o * 1024 + 4 * (lane + 64 * j)); acc += (v[j].x * w.x + v[j].y * w.y) + (v[j].z * w.z + v[j].w * w.w); }
            acc = wave_sum(acc); if (lane == o) mine = acc; }
        if (lane < 8) { const float lf = log_sigmoid(mine + a->in[I_BF][lane]);
            if (m < MP) a->out[O_PBL + (size_t)m * 8 + lane] = lf; else a->out[O_SBL + (size_t)(m - MP) * 8 + lane] = lf; }
    }
}

DI void scan_seq(ArgsP a, int seq, int lane) {
    float* cump = (float*)(a->ws + WS_CUMP); float* cums = (float*)(a->ws + WS_CUMS);
    const bool smp = seq >= 32; const int s = smp ? seq - 32 : seq, b = s >> 3, h = s & 7, n = smp ? 17 : 64, i0 = lane * n;
    const float* src0 = smp ? a->in[I_CBL] + (size_t)b * 1024 * 8 + h : a->out + O_PBL + (size_t)b * 4096 * 8 + h;
    const float* src1 = a->out + O_SBL + (size_t)b * 64 * 8 + h;
    float* dst = smp ? cums + (size_t)(b * 8 + h) * 1088 : cump + (size_t)(b * 8 + h) * 4096;
    float tot = 0.f;
    for (int i = 0; i < n; ++i) { const int idx = i0 + i; tot += (smp && idx >= 1024) ? src1[(size_t)(idx - 1024) * 8] : src0[(size_t)idx * 8]; }
    float x = tot;
#pragma unroll
    for (int o = 1; o < 64; o <<= 1) { const float t = __shfl_up(x, o); if (lane >= o) x += t; }
    float run = x - tot;
    for (int i = 0; i < n; ++i) { const int idx = i0 + i; run += (smp && idx >= 1024) ? src1[(size_t)(idx - 1024) * 8] : src0[(size_t)idx * 8]; dst[idx] = run * LOG2E; }
}

DI void rows_phase(ArgsP a, const float* gpost, const float* gnext, int lane, int wave) {
    const bf16_t* Y = (const bf16_t*)(a->ws + WS_Y); bf16_t* xn = (bf16_t*)(a->ws + WS_XN);
    const int gw = launder((int)blockIdx.x) * NWAVES + wave, NGW = launder((int)gridDim.x) * NWAVES;
    for (int m = gw; m < MT; m += NGW) {
        f32x4 y[4], x[4]; float ss = 0.f;
#pragma unroll
        for (int j = 0; j < 4; ++j) { const u32x2 w = ((const u32x2*)(Y + (size_t)m * DM))[lane + 64 * j];
            y[j].x = __uint_as_float(w.x << 16); y[j].y = __uint_as_float(w.x & 0xffff0000u); y[j].z = __uint_as_float(w.y << 16); y[j].w = __uint_as_float(w.y & 0xffff0000u);
            ss += (y[j].x * y[j].x + y[j].y * y[j].y) + (y[j].z * y[j].z + y[j].w * y[j].w);
            x[j] = ((const f32x4*)(a->out + (size_t)m * DM))[lane + 64 * j]; }
        const float rstd = rsqrtf(wave_sum(ss) * (1.f / DM) + EPS);
        float s2 = 0.f;
#pragma unroll
        for (int j = 0; j < 4; ++j) { const f32x4 g = ((const f32x4*)gpost)[lane + 64 * j]; x[j] = x[j] + y[j] * rstd * g;
            ((f32x4*)(a->out + (size_t)m * DM))[lane + 64 * j] = x[j]; s2 += (x[j].x * x[j].x + x[j].y * x[j].y) + (x[j].z * x[j].z + x[j].w * x[j].w); }
        if (gnext) {
            const float r2 = rsqrtf(wave_sum(s2) * (1.f / DM) + EPS);
#pragma unroll
            for (int j = 0; j < 4; ++j) { const f32x4 g = ((const f32x4*)gnext)[lane + 64 * j]; const f32x4 h = x[j] * r2 * g;
                u32x2 w; w.x = pk2(h.x, h.y); w.y = pk2(h.z, h.w); ((u32x2*)(xn + (size_t)m * DM))[lane + 64 * j] = w; }
        }
    }
}

DI void attn_even_phase(LAS unsigned char* lds) {
    const int bx = launder((int)blockIdx.x), G = launder((int)gridDim.x);
#ifndef T_NO_M0
    for (int s = bx; s < 544; s += G) att::attn_unit<0>(lds, s);
#endif
    for (int i = 0;; ++i) {
        int s = i * G + bx;
        if (G == 256 && i == 2) s = (bx >= 32 && bx < 64) ? 512 + bx - 32 : 544;
        if (s >= 544) break;
#ifndef T_NO_M1
        att::attn_unit<1>(lds, s);
#endif
    }
}
DI void attn_odd_phase(LAS unsigned char* lds) {
    const int bx = launder((int)blockIdx.x), G = launder((int)gridDim.x);
    for (int s = bx; s < 1088; s += G) att::attn_unit<2>(lds, s);
}

template <int PH_LO, int PH_HI>
__global__ void __launch_bounds__(NTHR, 2) fwd_kernel(Args a_unused) {
    extern __shared__ __attribute__((aligned(16))) unsigned char lds_raw[];
    LAS unsigned char* lds = (LAS unsigned char*)lds_raw;
    cg::grid_group grid = cg::this_grid();
#define IN(k) (PH_LO <= (k) && (k) < PH_HI)
#define SEAM(k) do { if (IN(k) && IN((k) + 1)) grid.sync(); } while (0)
#define PHASE_ARGS int tid = threadIdx.x; asm volatile("" : "+v"(tid)); const int lane = tid & 63, wave = __builtin_amdgcn_readfirstlane(tid >> 6); (void)lane; (void)wave; ArgsP a = fresh_args(); unsigned char* ws = a->ws; (void)ws; const int bx_ = launder((int)blockIdx.x), G_ = launder((int)gridDim.x); (void)bx_; (void)G_
    if (IN(0)) { PHASE_ARGS; prologue_phase(lds, a, tid, lane, wave); __syncthreads(); }
    SEAM(0);
#pragma unroll
    for (int l = 0; l < 2; ++l) {
        const int p = l * 7;
        if (IN(p + 1)) {
            PHASE_ARGS;
            if (l == 0) {
                if (bx_ >= 64 && bx_ < 76) scan_seq(a, (bx_ - 64) * 8 + wave, lane);
                else if (G_ < 76 && bx_ == 0) { for (int q = wave; q < 96; q += NWAVES) scan_seq(a, q, lane); }
                __syncthreads();
                pg8::Gemm g{(const bf16_t*)(ws + WS_XN), (const bf16_t*)(ws + WS_WINE), MT, 3072, DM}; pg8::StaticOrder S; S.init(MT, 3072, G_, bx_);
                EpiX<2> E{(bf16_t*)(ws + WS_Z), ZP, a->out};
                pg8::gemm_phase<EpiX<2>, pg8::StaticOrder, true, true>(lds, g, S, E);
            } else {
                pg8::Gemm g{(const bf16_t*)(ws + WS_XN), (const bf16_t*)(ws + WS_WINO), MT, 3072, DM}; pg8::StaticOrder S; S.init(MT, 3072, G_, bx_);
                EpiX<3> E{(bf16_t*)(ws + WS_Z), ZP, a->out};
                pg8::gemm_phase<EpiX<3>, pg8::StaticOrder, true, true>(lds, g, S, E);
            }
        }
        SEAM(p + 1);
        if (IN(p + 2)) {
#ifndef T_NO_EVEN
            if (l == 0) attn_even_phase(lds);
#endif
#ifndef T_NO_ODD
            if (l == 1) attn_odd_phase(lds);
#endif
            __syncthreads(); }
        SEAM(p + 2);
        if (IN(p + 3)) {
            PHASE_ARGS;
            pg8::Gemm g{(const bf16_t*)(ws + WS_ATT), (const bf16_t*)(ws + (l == 0 ? WS_WOUTE : WS_WOUTO)), MT, DM, DM}; pg8::StaticOrder S; S.init(MT, DM, G_, bx_);
            EpiX<0> E{(bf16_t*)(ws + WS_Y), DM, nullptr};
            pg8::gemm_phase<EpiX<0>, pg8::StaticOrder, true, true>(lds, g, S, E);
        }
        SEAM(p + 3);
        if (IN(p + 4)) { PHASE_ARGS; rows_phase(a, a->in[I_GQM] + l * DM, a->in[I_GPF] + l * DM, lane, wave); }
        SEAM(p + 4);
        if (IN(p + 5)) {
            PHASE_ARGS;
            pg8::Gemm g{(const bf16_t*)(ws + WS_XN), (const bf16_t*)(ws + WS_WUP + l * 8 * MiB), MT, FF, DM}; pg8::StaticOrder S; S.init(MT, FF, G_, bx_);
            EpiX<1> E{(bf16_t*)(ws + WS_H), FF, nullptr};
            pg8::gemm_phase<EpiX<1>, pg8::StaticOrder, true, true>(lds, g, S, E);
        }
        SEAM(p + 5);
        if (IN(p + 6)) {
            PHASE_ARGS;
            pg8::Gemm g{(const bf16_t*)(ws + WS_H), (const bf16_t*)(ws + WS_WDN + l * 8 * MiB), MT, DM, FF}; pg8::StaticOrder S; S.init(MT, DM, G_, bx_);
            EpiX<0> E{(bf16_t*)(ws + WS_Y), DM, nullptr};
            pg8::gemm_phase<EpiX<0>, pg8::StaticOrder, true, true>(lds, g, S, E);
        }
        SEAM(p + 6);
        if (IN(p + 7)) { PHASE_ARGS; rows_phase(a, a->in[I_GQF] + l * DM, l == 0 ? a->in[I_GPM] + DM : nullptr, lane, wave); }
        SEAM(p + 7);
    }
#undef IN
#undef SEAM
}

#if MK_ONE_LAUNCH
#define KFN (fwd_kernel<0, 15>)
#else
#define KFN (fwd_kernel<0, 1>)
typedef void (*kfn_t)(Args);
static kfn_t kfns[15] = {fwd_kernel<0, 1>, fwd_kernel<1, 2>, fwd_kernel<2, 3>, fwd_kernel<3, 4>, fwd_kernel<4, 5>, fwd_kernel<5, 6>, fwd_kernel<6, 7>, fwd_kernel<7, 8>,
                         fwd_kernel<8, 9>, fwd_kernel<9, 10>, fwd_kernel<10, 11>, fwd_kernel<11, 12>, fwd_kernel<12, 13>, fwd_kernel<13, 14>, fwd_kernel<14, 15>};
#endif
extern "C" void kernel_launch(void* const* d_in, const int* in_sizes, int n_in, void* d_out, int out_size, void* d_ws, size_t ws_size, hipStream_t stream) {
    static int grid = 0;
    if (grid == 0) {
        if (n_in != N_IN || (size_t)out_size != O_END || ws_size < WS_END) { fprintf(stderr, "kernel_launch: unexpected shapes (n_in %d out %d ws %zu)\n", n_in, out_size, ws_size); grid = -1; return; }
        int dev = 0, cus = 0, per_cu = 0;
        (void)hipGetDevice(&dev); (void)hipDeviceGetAttribute(&cus, hipDeviceAttributeMultiprocessorCount, dev);
        if (hipFuncSetAttribute((const void*)KFN, hipFuncAttributeMaxDynamicSharedMemorySize, LDS_BYTES) != hipSuccess) { fprintf(stderr, "kernel_launch: hipFuncSetAttribute failed\n"); grid = -1; return; }
#if !MK_ONE_LAUNCH
        for (int k = 1; k < 15; ++k) (void)hipFuncSetAttribute((const void*)kfns[k], hipFuncAttributeMaxDynamicSharedMemorySize, LDS_BYTES);
#endif
        (void)hipOccupancyMaxActiveBlocksPerMultiprocessor(&per_cu, (const void*)KFN, NTHR, LDS_BYTES);
        if (per_cu < 1) per_cu = 1;
        (void)hipGetLastError();
        grid = cus * per_cu;
        fprintf(stderr, "kernel_launch: grid %d (cus %d x %d)\n", grid, cus, per_cu);
    }
    if (grid < 0) return;
    Args a{};
    for (int i = 0; i < N_IN; ++i) a.in[i] = (const float*)d_in[i];
    a.out = (float*)d_out; a.ws = (unsigned char*)d_ws;
#if MK_ONE_LAUNCH
    a.ph_lo = 0; a.ph_hi = 15;
    void* args[] = {&a};
    hipError_t e = hipLaunchCooperativeKernel((const void*)KFN, dim3(grid), dim3(NTHR), args, LDS_BYTES, stream);
    if (e != hipSuccess) fprintf(stderr, "cooperative launch failed: %s (grid %d)\n", hipGetErrorString(e), grid);
#else
    for (int k = 0; k < 15; ++k) { a.ph_lo = k; a.ph_hi = k + 1; hipLaunchKernelGGL(kfns[k], dim3(grid), dim3(NTHR), LDS_BYTES, stream, a); }
#endif
}
```

```cpp
#include <hip/hip_runtime.h>
#include <hip/hip_cooperative_groups.h>
#include <cstdio>
#include <cstdint>
namespace cg = cooperative_groups;
#ifndef MK_ONE_LAUNCH
#define MK_ONE_LAUNCH 1
#endif
namespace pg8 {
#define PG8_LAS __attribute__((address_space(3)))
typedef unsigned short bf16_t;
typedef short bf16x8 __attribute__((ext_vector_type(8)));
typedef float f32x4 __attribute__((ext_vector_type(4)));
typedef unsigned u32x4 __attribute__((ext_vector_type(4)));
constexpr int BM = 256, BK = 64, HALF = 128, HTB = HALF * BK * 2  , STAGE_BYTES = 8 * HTB, NXCD = 8, WGM = 8;

__host__ __device__ __forceinline__ int lds_byte(int r, int c) { const int st = (r >> 4) * 2 + (c >> 5), rr = r & 15, cc = c & 31, ob = rr * 64 + cc * 2; return st * 1024 + (ob ^ (((ob >> 9) & 1) << 5)); }
__host__ __device__ __forceinline__ void stage_rc(int b, int& R, int& C) { const int st = b / 1024, sb = b % 1024, swz = sb ^ (((sb >> 9) & 1) << 5); R = (st >> 1) * 16 + swz / 64; C = (st & 1) * 32 + (swz % 64) / 2; }
__host__ __device__ __forceinline__ int perm32(int rho) { const int n = rho >> 4, i = rho & 15; return 8 * (i >> 2) + 4 * n + (i & 3); }

struct Unit { int pm, pn; };
struct Gemm { const bf16_t* A; const bf16_t* Bt; int M, N, K; };

struct StaticOrder {
    int nM, nN, nwg, G, c;
    __host__ __device__ void init(int M, int N, int G_, int c_) { nM = M / BM; nN = N / BM; nwg = nM * nN; G = G_; c = c_; }
    __host__ __device__ bool next(int i, Unit& u) const {
        const long L = (long)i * G + c; if (L >= nwg) return false;
        int wgid = (int)L; { const int q = nwg / NXCD, r = nwg % NXCD, xcd = wgid % NXCD, off = wgid / NXCD; wgid = (xcd < r ? xcd * (q + 1) : r * (q + 1) + (xcd - r) * q) + off; }
        const int nig = WGM * nN, gid = wgid / nig, fm = gid * WGM, gsz = (nM - fm) < WGM ? (nM - fm) : WGM;
        u.pm = fm + ((wgid % nig) % gsz); u.pn = (wgid % nig) / gsz; return true;
    }
    __device__ __forceinline__ void a_ready(const Unit&) const {}
    __device__ __forceinline__ void done(const Unit&) const {}
};

__device__ __forceinline__ unsigned cvt_pk_bf16(float lo, float hi) { unsigned r; asm volatile("v_cvt_pk_bf16_f32 %0, %1, %2" : "=v"(r) : "v"(lo), "v"(hi)); return r; }
typedef float f32x2 __attribute__((ext_vector_type(2)));
template <class Epi, class Sched, bool ALIGN_EPI = false, bool SP2 = false>
__device__ __forceinline__ void gemm_phase(PG8_LAS unsigned char* lds, const Gemm g, const Sched& S, const Epi& E) {
    int tid_l = threadIdx.x; asm volatile("" : "+v"(tid_l));
    const int tid = tid_l, wid = __builtin_amdgcn_readfirstlane(tid >> 6), lane = tid & 63, wr = wid >> 2, wc = wid & 3, fr = lane & 15, fq = lane >> 4;
    const int K = g.K, nt = K / BK;
    unsigned voffA[2], voffB[2];
#pragma unroll
    for (int i = 0; i < 2; ++i) { int R, C; stage_rc(tid * 16 + i * 8192, R, C); const int Rb = Epi::PERM ? ((R & ~31) + perm32(R & 31)) : R;
        voffA[i] = (unsigned)(R * K + C) * 2u; voffB[i] = (unsigned)(Rb * K + C) * 2u; }
    const size_t kstep = (size_t)(BK * 2);
    const size_t hstep = (size_t)HALF * K * 2;
    const size_t tstep = 2 * hstep;
    const unsigned ldsw = (unsigned)wid * 1024u;
    const int aoff = lds_byte(wr * 64 + fr, fq * 8), boff = lds_byte(wc * 32 + fr, fq * 8);
#define PG8_SA(b, h) (((b) * 2 + (h)) * HTB)
#define PG8_SB(b, h) ((4 + (b) * 2 + (h)) * HTB)
#define PG8_STAGE(bufoff, gbase, voff) do { _Pragma("unroll") for (int _i = 0; _i < 2; ++_i) \
        __builtin_amdgcn_global_load_lds((const unsigned*)((const char*)(gbase) + (voff)[_i]), (PG8_LAS unsigned*)(lds + (bufoff) + ldsw + _i * 8192), 16, 0, 0); } while (0)
#define PG8_LDA(dst, b, h) do { _Pragma("unroll") for (int m = 0; m < 4; ++m) _Pragma("unroll") for (int k = 0; k < 2; ++k) dst[m][k] = *(const PG8_LAS bf16x8*)(lds + PG8_SA(b, h) + aoff + m * 2048 + k * 1024); } while (0)
#define PG8_LDB(dst, b, h) do { _Pragma("unroll") for (int n = 0; n < 2; ++n) _Pragma("unroll") for (int k = 0; k < 2; ++k) dst[n][k] = *(const PG8_LAS bf16x8*)(lds + PG8_SB(b, h) + boff + n * 2048 + k * 1024); } while (0)
#define PG8_MMA(ai, bj, At, Bt) do { __builtin_amdgcn_s_setprio(1); _Pragma("unroll") for (int m = 0; m < 4; ++m) _Pragma("unroll") for (int n = 0; n < 2; ++n) _Pragma("unroll") for (int k = 0; k < 2; ++k) \
        acc[ai][bj][m][n] = __builtin_amdgcn_mfma_f32_16x16x32_bf16(Bt[n][k], At[m][k], acc[ai][bj][m][n], 0, 0, 0); __builtin_amdgcn_s_setprio(0); } while (0)
#define PG8_WAIT_V(n) asm volatile("s_waitcnt vmcnt(" #n ")" ::: "memory")
#define PG8_WAIT_L(n) asm volatile("s_waitcnt lgkmcnt(" #n ")" ::: "memory")
#define PG8_BAR __builtin_amdgcn_s_barrier()
#define PG8_SCHED __builtin_amdgcn_sched_barrier(0)
    Unit cur, nxt; int ui = 0;
    if (!S.next(0, cur)) return;
    f32x4 acc[2][2][4][2];
#pragma unroll
    for (int a = 0; a < 2; ++a)
#pragma unroll
        for (int b = 0; b < 2; ++b)
#pragma unroll
            for (int m = 0; m < 4; ++m)
#pragma unroll
                for (int n = 0; n < 2; ++n) acc[a][b][m][n] = (f32x4){0.f, 0.f, 0.f, 0.f};
    bf16x8 At[4][2], B0[2][2], B1[2][2];
    const char* cA = (const char*)g.A + (size_t)cur.pm * tstep; const char* cB = (const char*)g.Bt + (size_t)cur.pn * tstep;
    S.a_ready(cur);
    if constexpr (SP2) {
        PG8_STAGE(PG8_SB(0, 0), cB, voffB); PG8_STAGE(PG8_SB(0, 1), cB + hstep, voffB); PG8_STAGE(PG8_SA(0, 0), cA, voffA); PG8_STAGE(PG8_SA(0, 1), cA + hstep, voffA);
        if (wr == 1) PG8_BAR;
        PG8_WAIT_V(2); PG8_BAR;
        PG8_STAGE(PG8_SB(1, 0), cB + kstep, voffB); PG8_STAGE(PG8_SA(1, 0), cA + kstep, voffA); PG8_STAGE(PG8_SB(1, 1), cB + hstep + kstep, voffB);
        PG8_WAIT_V(6); PG8_BAR;
    } else {
        PG8_STAGE(PG8_SB(0, 0), cB, voffB); PG8_STAGE(PG8_SA(0, 0), cA, voffA); PG8_STAGE(PG8_SB(0, 1), cB + hstep, voffB); PG8_STAGE(PG8_SA(0, 1), cA + hstep, voffA);
        if (wr == 1) PG8_BAR;
        PG8_WAIT_V(4); PG8_BAR;
        PG8_STAGE(PG8_SB(1, 0), cB + kstep, voffB); PG8_STAGE(PG8_SA(1, 0), cA + kstep, voffA); PG8_STAGE(PG8_SB(1, 1), cB + hstep + kstep, voffB);
        PG8_WAIT_V(6); PG8_BAR;
    }
    for (;;) {
        const bool has_next = S.next(ui + 1, nxt);
        const char* nA = has_next ? (const char*)g.A + (size_t)nxt.pm * tstep : cA; const char* nB = has_next ? (const char*)g.Bt + (size_t)nxt.pn * tstep : cB;
        for (int t = 0; t < nt; t += 2) {
            const bool last = (t == nt - 2);
            const char* a1 = cA + (size_t)(t + 1) * kstep;
            const char* a2 = last ? nA : cA + (size_t)(t + 2) * kstep; const char* b2 = last ? nB : cB + (size_t)(t + 2) * kstep;
            const char* a3 = a2 + kstep; const char* b3 = b2 + kstep;
            if (last && has_next) S.a_ready(nxt);
            if constexpr (SP2) {
            PG8_LDB(B0, 0, 0); PG8_LDB(B1, 0, 1); PG8_SCHED; PG8_LDA(At, 0, 0); PG8_STAGE(PG8_SA(1, 1), a1 + hstep, voffA);
            PG8_WAIT_V(8); PG8_WAIT_L(0); PG8_BAR; PG8_MMA(0, 0, At, B0); PG8_MMA(0, 1, At, B1); PG8_BAR; PG8_SCHED;
            PG8_LDA(At, 0, 1); PG8_STAGE(PG8_SB(0, 0), b2, voffB); PG8_STAGE(PG8_SB(0, 1), b2 + hstep, voffB); PG8_STAGE(PG8_SA(0, 0), a2, voffA);
            PG8_WAIT_V(8); PG8_WAIT_L(0); PG8_BAR; PG8_MMA(1, 0, At, B0); PG8_MMA(1, 1, At, B1); PG8_BAR; PG8_SCHED;
            PG8_LDB(B0, 1, 0); PG8_LDB(B1, 1, 1); PG8_SCHED; PG8_LDA(At, 1, 0); PG8_STAGE(PG8_SA(0, 1), a2 + hstep, voffA);
            PG8_WAIT_V(8); PG8_WAIT_L(0); PG8_BAR; PG8_MMA(0, 0, At, B0); PG8_MMA(0, 1, At, B1); PG8_BAR; PG8_SCHED;
            PG8_LDA(At, 1, 1); PG8_STAGE(PG8_SB(1, 0), b3, voffB); PG8_STAGE(PG8_SB(1, 1), b3 + hstep, voffB); PG8_STAGE(PG8_SA(1, 0), a3, voffA);
            PG8_WAIT_V(8); PG8_WAIT_L(0); PG8_BAR; PG8_MMA(1, 0, At, B0); PG8_MMA(1, 1, At, B1); PG8_BAR; PG8_SCHED;
            } else {
            PG8_LDB(B0, 0, 0); PG8_SCHED; PG8_LDA(At, 0, 0); PG8_STAGE(PG8_SA(1, 1), a1 + hstep, voffA);
            PG8_WAIT_L(8); PG8_BAR; PG8_WAIT_L(0); PG8_MMA(0, 0, At, B0); PG8_BAR; PG8_SCHED;
            PG8_LDB(B1, 0, 1); PG8_STAGE(PG8_SB(0, 0), b2, voffB);
            PG8_BAR; PG8_WAIT_L(0); PG8_MMA(0, 1, At, B1); PG8_BAR;
            PG8_LDA(At, 0, 1); PG8_STAGE(PG8_SA(0, 0), a2, voffA);
            PG8_BAR; PG8_WAIT_L(0); PG8_MMA(1, 0, At, B0); PG8_BAR; PG8_SCHED;
            PG8_STAGE(PG8_SB(0, 1), b2 + hstep, voffB);
            PG8_WAIT_V(6); PG8_BAR; PG8_MMA(1, 1, At, B1); PG8_BAR;
            PG8_LDB(B0, 1, 0); PG8_SCHED; PG8_LDA(At, 1, 0); PG8_STAGE(PG8_SA(0, 1), a2 + hstep, voffA);
            PG8_WAIT_L(8); PG8_BAR; PG8_WAIT_L(0); PG8_MMA(0, 0, At, B0); PG8_BAR; PG8_SCHED;
            PG8_LDB(B1, 1, 1); PG8_STAGE(PG8_SB(1, 0), b3, voffB);
            PG8_BAR; PG8_WAIT_L(0); PG8_MMA(0, 1, At, B1); PG8_BAR;
            PG8_LDA(At, 1, 1); PG8_STAGE(PG8_SA(1, 0), a3, voffA);
            PG8_BAR; PG8_WAIT_L(0); PG8_MMA(1, 0, At, B0); PG8_BAR; PG8_SCHED;
            PG8_STAGE(PG8_SB(1, 1), b3 + hstep, voffB);
            PG8_WAIT_V(6); PG8_BAR; PG8_MMA(1, 1, At, B1); PG8_BAR;
            }
        }
        if constexpr (ALIGN_EPI) { if (wr == 0) PG8_BAR; }
        if constexpr (!Epi::AFTER_DRAIN) { E(acc, cur, wr, wc, fr, fq); S.done(cur); }
        if (!has_next) break;
#pragma unroll
        for (int a = 0; a < 2; ++a)
#pragma unroll
            for (int b = 0; b < 2; ++b)
#pragma unroll
                for (int m = 0; m < 4; ++m)
#pragma unroll
                    for (int n = 0; n < 2; ++n) acc[a][b][m][n] = (f32x4){0.f, 0.f, 0.f, 0.f};
        cur = nxt; cA = nA; cB = nB; ++ui;
        if constexpr (ALIGN_EPI) { if (wr == 1) PG8_BAR; }
    }
    PG8_WAIT_V(0);
    if constexpr (!ALIGN_EPI) { if (wr == 0) PG8_BAR; }
    PG8_BAR;
    if constexpr (Epi::AFTER_DRAIN) { E.fused(acc, cur, wr, wc, fr, fq, lds, wid, lane); S.done(cur); }
#undef PG8_SA
#undef PG8_SB
#undef PG8_STAGE
#undef PG8_LDA
#undef PG8_LDB
#undef PG8_MMA
#undef PG8_WAIT_V
#undef PG8_WAIT_L
#undef PG8_BAR
#undef PG8_SCHED
}
}

typedef unsigned short bf16_t;
typedef short bf16x8 __attribute__((ext_vector_type(8)));
typedef short s16x4 __attribute__((ext_vector_type(4)));
typedef float f32x4 __attribute__((ext_vector_type(4)));
typedef float f32x2 __attribute__((ext_vector_type(2)));
typedef float f32x16 __attribute__((ext_vector_type(16)));
typedef unsigned u32x4 __attribute__((ext_vector_type(4)));
typedef unsigned u32x2 __attribute__((ext_vector_type(2)));
#define LAS __attribute__((address_space(3)))
#define DI __device__ __forceinline__

constexpr int DM = 1024, FF = 4096, MP = 16384, MS = 512, MT = MP + MS, SEQ = 4096, PAST = 1024, DSEQ = 64;
constexpr int ZP = 3072;
constexpr float LOG2E = 1.4426950408889634f;
constexpr float C2 = 0.125f * LOG2E;
constexpr float EPS = 1e-6f;
constexpr size_t O_YP = 0, O_YS = O_YP + (size_t)MP * DM, O_PAK = O_YS + (size_t)MS * DM, O_PAV = O_PAK + (size_t)MP * 512, O_PBK = O_PAV + (size_t)MP * 512,
                 O_PBV = O_PBK + (size_t)MP * 512, O_PBL = O_PBV + (size_t)MP * 512, O_PCK = O_PBL + (size_t)MP * 8, O_PCV = O_PCK + (size_t)4 * 512 * 1024,
                 O_SAK = O_PCV + (size_t)4 * 512 * 1024, O_SAV = O_SAK + (size_t)MS * 512, O_SBK = O_SAV + (size_t)MS * 512, O_SBV = O_SBK + (size_t)MS * 512,
                 O_SBL = O_SBV + (size_t)MS * 512, O_SCK = O_SBL + (size_t)MS * 8, O_SCV = O_SCK + (size_t)8 * 512 * 1024, O_END = O_SCV + (size_t)8 * 512 * 1024;
static_assert(O_END == 64622592, "output size");
constexpr size_t MiB = 1u << 20;
constexpr size_t WS_WINE = 1 * MiB, WS_WOUTE = 7 * MiB, WS_WINO = 9 * MiB, WS_WOUTO = 15 * MiB, WS_WUP = 17 * MiB  , WS_WDN = 33 * MiB  ;
constexpr size_t WS_XN = 49 * MiB, WS_Y = 82 * MiB, WS_CUMP = 115 * MiB, WS_CUMS = WS_CUMP + 524288, WS_Z = 116 * MiB, WS_ATT = 215 * MiB, WS_H = 116 * MiB, WS_END = 248 * MiB;
enum { I_XP = 0, I_XS, I_CAK, I_CAV, I_CBK, I_CBV, I_CBL, I_CCK, I_CCV, I_WINE, I_BF, I_LQ1, I_LK1, I_LQ2, I_LK2, I_SUBG, I_WOUTE, I_WINO, I_REL, I_WOUTO,
       I_GPM, I_GQM, I_GPF, I_GQF, I_WUP, I_WDN, N_IN };
constexpr int NWAVES = 8, NTHR = 512;
constexpr int LDS_BYTES = 147456;

struct Args { const float* in[N_IN]; float* out; unsigned char* ws; int ph_lo, ph_hi; };
typedef const __attribute__((address_space(4))) Args* ArgsP;
DI int launder(int v) { asm volatile("" : "+s"(v)); return v; }
DI ArgsP fresh_args() { ArgsP p = (ArgsP)__builtin_amdgcn_kernarg_segment_ptr(); asm volatile("" : "+s"(p)); return p; }

DI float wave_sum(float v) {
#pragma unroll
    for (int o = 1; o < 64; o <<= 1) v += __shfl_xor(v, o);
    return v;
}
DI unsigned pk2(float lo, float hi) { typedef __bf16 b2 __attribute__((ext_vector_type(2))); f32x2 v = {lo, hi}; b2 b = __builtin_convertvector(v, b2); return __builtin_bit_cast(unsigned, b); }
DI float bf2f(unsigned short h) { return __uint_as_float(((unsigned)h) << 16); }

template <int MODE> struct EpiX {
    static constexpr bool PERM = true, AFTER_DRAIN = false;
    bf16_t* O; int ldc; float* out;
    __device__ __forceinline__ void operator()(const pg8::f32x4 (&acc)[2][2][4][2], const pg8::Unit& u, int wr, int wc, int fr, int fq) const {
        const unsigned loff = (unsigned)(fr * ldc + 8 * fq) * 2u;
        char* ub = (char*)O + ((size_t)(u.pm * 256 + wr * 64) * ldc + u.pn * 256 + wc * 32) * 2;
        float sc = 1.f; char* fb = nullptr; unsigned floff = 0; int fpitch = 0; bool smp3 = false;
        if (MODE == 2) {
            const int seg = u.pn >> 1; fpitch = 512; floff = (unsigned)(fr * 512 + 8 * fq) * 4u;
            if (seg == 0 || seg == 3) sc = C2;
            else {
                const bool smp = u.pm >= 64;
                const size_t off = seg == 1 ? (smp ? O_SAK : O_PAK) : seg == 2 ? (smp ? O_SAV : O_PAV) : seg == 4 ? (smp ? O_SBK : O_PBK) : (smp ? O_SBV : O_PBV);
                fb = (char*)(out + off + (size_t)((smp ? u.pm - 64 : u.pm) * 256 + wr * 64) * 512 + (u.pn & 1) * 256 + wc * 32);
            }
        } else if (MODE == 3) {
            const int seg = u.pn >> 2; fpitch = 1024; floff = (unsigned)(fr * 1024 + 8 * fq) * 4u;
            if (seg == 0) sc = C2;
            else if (u.pm >= 64) { smp3 = true; fb = (char*)(out + (seg == 1 ? O_SCK : O_SCV) + (size_t)(((u.pm - 64) * 4 + wr) * 512 + 448) * 1024 + (u.pn & 3) * 256 + wc * 32); }
            else if ((u.pm & 15) >= 14) fb = (char*)(out + (seg == 1 ? O_PCK : O_PCV) + (size_t)((u.pm >> 4) * 512 + ((u.pm & 15) - 14) * 256 + wr * 64) * 1024 + (u.pn & 3) * 256 + wc * 32);
        }
#pragma unroll
        for (int ai = 0; ai < 2; ++ai)
#pragma unroll
            for (int m = 0; m < 4; ++m) {
                char* rb = ub + (size_t)(ai * 128 + m * 16) * ldc * 2;
                char* frb = nullptr;
                if (MODE >= 2 && fb) frb = fb + (size_t)((MODE == 3 && smp3) ? (ai * 1024 + m * 16) : (ai * 128 + m * 16)) * fpitch * 4;
#pragma unroll
                for (int bj = 0; bj < 2; ++bj) {
                    pg8::f32x4 v0 = acc[ai][bj][m][0], v1 = acc[ai][bj][m][1];
                    if (MODE >= 2 && frb) { *(pg8::f32x4*)(frb + bj * 512 + floff) = v0; *(pg8::f32x4*)(frb + bj * 512 + 16 + floff) = v1; }
                    if (MODE == 1) {
#pragma unroll
                        for (int e = 0; e < 4; ++e) { float a = fmaxf(v0[e], 0.f), b = fmaxf(v1[e], 0.f); v0[e] = a * a; v1[e] = b * b; }
                    }
                    if (MODE >= 2) { v0 = v0 * sc; v1 = v1 * sc; }
                    pg8::u32x4 w; w.x = pg8::cvt_pk_bf16(v0[0], v0[1]); w.y = pg8::cvt_pk_bf16(v0[2], v0[3]); w.z = pg8::cvt_pk_bf16(v1[0], v1[1]); w.w = pg8::cvt_pk_bf16(v1[2], v1[3]);
                    *(pg8::u32x4*)(rb + bj * 256 + loff) = w;
                }
                asm volatile("" ::: "memory");
            }
    }
};

namespace att {
constexpr int KP = 272, VP = 320;
constexpr int KT_B = 64 * KP, VT_B = 64 * VP;
constexpr int OFF_K = 0, OFF_V = 2 * KT_B, OFF_CUM = 2 * KT_B + 2 * VT_B  , OFF_TBL = OFF_CUM + 1024, OFF_END = OFF_TBL + 2 * 640 * 4;
static_assert(OFF_END <= 131072 && 65536 <= OFF_CUM, "attention LDS map");
struct Job {
    const bf16_t* q;
    const float* kc; const float* vc; int cpitch; int nc;
    const bf16_t* kz; const bf16_t* vz;
    int kt_lo, kt_hi, qpos0, kpos0, nq_sub;
    const float* cum; int cum_hs;
    const float* tbl;
    bf16_t* o;
    float slope2; const float* subg;
};
#define MFMA32(a, b, c) __builtin_amdgcn_mfma_f32_32x32x16_bf16((a), (b), (c), 0, 0, 0)
DI u32x4 pack8(const f32x4 a, const f32x4 b) { u32x4 r; r.x = pk2(a[0], a[1]); r.y = pk2(a[2], a[3]); r.z = pk2(b[0], b[1]); r.w = pk2(b[2], b[3]); return r; }
DI s16x4 vtr(const LAS unsigned char* p) { typedef short v4 __attribute__((ext_vector_type(4))); return __builtin_bit_cast(s16x4, __builtin_amdgcn_ds_read_tr16_b64_v4i16((LAS v4*)p)); }

DI void load_tile(const Job& J, int kt, int srow, int sch, u32x4& r0, u32x4& r1, u32x4& r2, u32x4& r3) {
    if (kt >= J.nc) {
        const size_t o0 = (size_t)((kt - J.nc) * 64 + srow) * ZP + sch * 8, o1 = o0 + (size_t)32 * ZP;
        r0 = *(const u32x4*)(J.kz + o0); r1 = *(const u32x4*)(J.kz + o1); r2 = *(const u32x4*)(J.vz + o0); r3 = *(const u32x4*)(J.vz + o1);
    }
}
DI void store_tile(const Job& J, int kt, int buf, int srow, int sch, u32x4& r0, u32x4& r1, u32x4& r2, u32x4& r3, LAS unsigned char* lds) {
    if (kt < J.nc) {
        const size_t o0 = (size_t)(kt * 64 + srow) * J.cpitch + sch * 8, o1 = o0 + (size_t)32 * J.cpitch;
        r0 = pack8(*(const f32x4*)(J.kc + o0), *(const f32x4*)(J.kc + o0 + 4)); r1 = pack8(*(const f32x4*)(J.kc + o1), *(const f32x4*)(J.kc + o1 + 4));
        r2 = pack8(*(const f32x4*)(J.vc + o0), *(const f32x4*)(J.vc + o0 + 4)); r3 = pack8(*(const f32x4*)(J.vc + o1), *(const f32x4*)(J.vc + o1 + 4));
    }
    LAS unsigned char* kb = lds + OFF_K + buf * KT_B + srow * KP + sch * 16; LAS unsigned char* vb = lds + OFF_V + buf * VT_B + srow * VP + sch * 16;
    *(LAS u32x4*)kb = r0; *(LAS u32x4*)(kb + 32 * KP) = r1; *(LAS u32x4*)vb = r2; *(LAS u32x4*)(vb + 32 * VP) = r3;
}

template <int MODE> DI Job make_job(int s_) {
    const int s = launder(s_);
    ArgsP a = fresh_args(); Job J{};
    const bf16_t* z = (const bf16_t*)(a->ws + WS_Z); bf16_t* attb = (bf16_t*)(a->ws + WS_ATT);
    if (MODE < 2) {
        const int qcol = MODE == 0 ? 0 : 1536, kcol = MODE == 0 ? 512 : 2048, vcol = MODE == 0 ? 1024 : 2560, ocol = MODE == 0 ? 0 : 512;
        if (s < 512) {
            const int j = s & 255, u = (s >> 8) ? (j >> 4) : 31 - (j >> 4), bh = j & 15, b = bh >> 2, hh = bh & 3;
            const size_t row0 = (size_t)b * SEQ + 128 * u, rb = (size_t)b * SEQ;
            J.nc = 0; J.kt_lo = 0; J.kt_hi = 2 * u + 1; J.qpos0 = 128 * u; J.kpos0 = 0; J.nq_sub = 4;
            J.q = z + row0 * ZP + qcol + hh * 128; J.kz = z + rb * ZP + kcol + hh * 128; J.vz = z + rb * ZP + vcol + hh * 128; J.o = attb + row0 * DM + ocol + hh * 128;
            J.slope2 = exp2f(-2.f * (float)(hh + 1)) * LOG2E;
            J.cum = (const float*)(a->ws + WS_CUMP) + (size_t)(b * 8 + 2 * hh) * 4096; J.cum_hs = 4096;
        } else {
            const int jj = s - 512, b = jj >> 2, hh = jj & 3; const size_t row0 = (size_t)MP + b * DSEQ;
            J.nc = 16; J.cpitch = 512; J.kt_lo = 0; J.kt_hi = 16; J.qpos0 = PAST; J.kpos0 = 0; J.nq_sub = 2;
            J.q = z + row0 * ZP + qcol + hh * 128; J.kz = z + row0 * ZP + kcol + hh * 128; J.vz = z + row0 * ZP + vcol + hh * 128; J.o = attb + row0 * DM + ocol + hh * 128;
            J.kc = a->in[MODE == 0 ? I_CAK : I_CBK] + (size_t)b * PAST * 512 + hh * 128; J.vc = a->in[MODE == 0 ? I_CAV : I_CBV] + (size_t)b * PAST * 512 + hh * 128;
            J.slope2 = exp2f(-2.f * (float)(hh + 1)) * LOG2E;
            J.cum = (const float*)(a->ws + WS_CUMS) + (size_t)(b * 8 + 2 * hh) * 1088; J.cum_hs = 1088;
        }
        J.subg = a->in[I_SUBG];
    } else {
        if (s < 1024) {
            const int bh = s & 31, b = bh >> 3, hp = bh & 7, u = s >> 5; const size_t row0 = (size_t)b * SEQ + 128 * u, rb = (size_t)b * SEQ;
            J.q = z + row0 * ZP + hp * 128; J.kz = z + rb * ZP + 1024 + hp * 128; J.vz = z + rb * ZP + 2048 + hp * 128; J.o = attb + row0 * DM + hp * 128;
            J.nc = 0; J.kt_lo = 2 * u - 8 > 0 ? 2 * u - 8 : 0; J.kt_hi = 2 * u + 1; J.qpos0 = 128 * u; J.kpos0 = 0; J.nq_sub = 4; J.tbl = a->in[I_REL] + (size_t)(2 * hp) * 513;
        } else {
            const int id = s - 1024, b = id >> 3, hp = id & 7; const size_t row0 = (size_t)MP + b * DSEQ;
            J.q = z + row0 * ZP + hp * 128; J.kz = z + row0 * ZP + 1024 + hp * 128; J.vz = z + row0 * ZP + 2048 + hp * 128; J.o = attb + row0 * DM + hp * 128;
            J.kc = a->in[I_CCK] + (size_t)b * 512 * 1024 + hp * 128; J.vc = a->in[I_CCV] + (size_t)b * 512 * 1024 + hp * 128; J.cpitch = 1024; J.nc = 8;
            J.kt_lo = 0; J.kt_hi = 8; J.qpos0 = PAST; J.kpos0 = 512; J.nq_sub = 2; J.tbl = a->in[I_REL] + (size_t)(2 * hp) * 513;
        }
    }
    return J;
}

template <int MODE>
DI void attn_unit(LAS unsigned char* lds, const int slot) {
    constexpr int NDB = (MODE == 0) ? 4 : 2;
    int tid_l = threadIdx.x; asm volatile("" : "+v"(tid_l));
    const int tid = tid_l, lane = tid & 63, wid = __builtin_amdgcn_readfirstlane(tid >> 6);
    const int qs = wid >> 1, half = wid & 1, r32 = lane & 31, hi = lane >> 5;
    const int srow = tid >> 4, sch = tid & 15;
    const int qin = (32 * qs + r32) & 63;
    bool active; int qc_w, kc0, kt, nt, qk0;
    bf16x8 qr[4];
    u32x4 r0 = {0u, 0u, 0u, 0u}, r1 = r0, r2 = r0, r3 = r0; float cumv = 0.f;
    __syncthreads();
    {
        const Job J = make_job<MODE>(slot);
        active = qs < J.nq_sub; qc_w = (J.qpos0 + 32 * qs) >> 6; kc0 = J.kpos0 >> 6; kt = J.kt_lo; nt = J.kt_hi - J.kt_lo + 1; qk0 = J.qpos0 - J.kpos0;
        if (MODE == 2) {
            for (int e = tid; e < 1280; e += NTHR) { const int hs = e >= 640 ? 1 : 0, idx = e - hs * 640, rel = idx - 63, c = (rel > 256 ? 256 : rel) + 256;
                ((LAS float*)(lds + OFF_TBL))[e] = J.tbl[hs * 513 + c] * LOG2E; }
        }
        const bf16_t* qp = J.q + (size_t)((active ? 32 * qs : 0) + r32) * ZP + half * 64 + 8 * hi;
#pragma unroll
        for (int d0 = 0; d0 < 4; ++d0) qr[d0] = *(const bf16x8*)(qp + 16 * d0);
        load_tile(J, kt, srow, sch, r0, r1, r2, r3);
        if (MODE == 1 && tid < 128) cumv = J.cum[(size_t)(tid >> 6) * J.cum_hs + kt * 64 + (tid & 63)];
        store_tile(J, kt, 0, srow, sch, r0, r1, r2, r3, lds);
        if (MODE == 1 && tid < 128) ((LAS float*)(lds + OFF_CUM))[tid] = cumv;
    }
    f32x16 o[NDB];
#pragma unroll
    for (int d = 0; d < NDB; ++d)
#pragma unroll
        for (int i = 0; i < 16; ++i) o[d][i] = 0.f;
    float m_run = -INFINITY, l_run = 0.f;
    __syncthreads();
    const int b16 = (lane >> 4) & 1, q4 = (lane & 15) >> 2, p4 = lane & 3;
    const int vcol0 = (MODE == 0) ? 0 : 64 * half;
    for (int it = 0; it < nt; ++it, ++kt) {
        const int buf = it & 1; const bool more = it + 1 < nt;
        float slope2 = 0.f;
        {
            const Job J = make_job<MODE>(slot);
            if (more) { load_tile(J, kt + 1, srow, sch, r0, r1, r2, r3); if (MODE == 1 && tid < 128) cumv = J.cum[(size_t)(tid >> 6) * J.cum_hs + (kt + 1) * 64 + (tid & 63)]; }
            if (MODE == 0) slope2 = J.slope2;
        }
        const int kc = kc0 + kt;
        const bool vis = active && kc <= qc_w && (MODE != 2 || kc >= qc_w - 8);
        if (vis) {
            const LAS unsigned char* Kb = lds + OFF_K + buf * KT_B + r32 * KP + half * 128 + hi * 16;
            f32x16 p0, p1;
#pragma unroll
            for (int i = 0; i < 16; ++i) { p0[i] = 0.f; p1[i] = 0.f; }
#pragma unroll
            for (int d0 = 0; d0 < 4; ++d0) {
                const bf16x8 kf0 = *(const LAS bf16x8*)(Kb + d0 * 32), kf1 = *(const LAS bf16x8*)(Kb + 32 * KP + d0 * 32);
                p0 = MFMA32(kf0, qr[d0], p0); p1 = MFMA32(kf1, qr[d0], p1);
            }
            const int qk = qk0 + 32 * qs + r32 - kt * 64 - 4 * hi;
            if (MODE == 0) {
                const float qrel = (float)qk;
#pragma unroll
                for (int i = 0; i < 16; ++i) { const float ci = (float)((i & 3) + 8 * (i >> 2));
                    p0[i] = fmaf(-slope2, fabsf(qrel - ci), p0[i]); p1[i] = fmaf(-slope2, fabsf(qrel - 32.f - ci), p1[i]); }
            } else if (MODE == 1) {
                const LAS float* ct = (const LAS float*)(lds + OFF_CUM) + buf * 128 + half * 64 + 4 * hi;
#pragma unroll
                for (int g = 0; g < 4; ++g) { const f32x4 c0 = *(const LAS f32x4*)(ct + 8 * g), c1 = *(const LAS f32x4*)(ct + 32 + 8 * g);
#pragma unroll
                    for (int e = 0; e < 4; ++e) { p0[4 * g + e] -= c0[e]; p1[4 * g + e] -= c1[e]; } }
                if (kc == qc_w) {
#pragma unroll
                    for (int i = 0; i < 16; ++i) { const int kin = (i & 3) + 8 * (i >> 2) + 4 * hi; if (kin > qin) p0[i] = -INFINITY; if (kin + 32 > qin) p1[i] = -INFINITY; }
                }
            } else {
                const LAS float* tb = (const LAS float*)(lds + OFF_TBL) + half * 640 + (qk + 63 - 59);
#pragma unroll
                for (int i = 0; i < 16; ++i) { const int ci = (i & 3) + 8 * (i >> 2); p0[i] += tb[59 - ci]; p1[i] += tb[59 - 32 - ci]; }
            }
            float mx = fmaxf(p0[0], p1[0]);
#pragma unroll
            for (int i = 1; i < 16; ++i) mx = fmaxf(mx, fmaxf(p0[i], p1[i]));
            mx = fmaxf(mx, __shfl_xor(mx, 32));
            const float m_new = fmaxf(m_run, mx), alpha = __builtin_amdgcn_exp2f(m_run - m_new);
            m_run = m_new; l_run *= alpha;
#pragma unroll
            for (int d = 0; d < NDB; ++d)
#pragma unroll
                for (int i = 0; i < 16; ++i) o[d][i] *= alpha;
            float ls = 0.f;
#pragma unroll
            for (int i = 0; i < 16; ++i) { p0[i] = __builtin_amdgcn_exp2f(p0[i] - m_new); p1[i] = __builtin_amdgcn_exp2f(p1[i] - m_new); ls += p0[i] + p1[i]; }
            l_run += ls;
            bf16x8 pf[4];
            { u32x4 t;
              t.x = pk2(p0[0], p0[1]); t.y = pk2(p0[2], p0[3]); t.z = pk2(p0[4], p0[5]); t.w = pk2(p0[6], p0[7]); pf[0] = __builtin_bit_cast(bf16x8, t);
              t.x = pk2(p0[8], p0[9]); t.y = pk2(p0[10], p0[11]); t.z = pk2(p0[12], p0[13]); t.w = pk2(p0[14], p0[15]); pf[1] = __builtin_bit_cast(bf16x8, t);
              t.x = pk2(p1[0], p1[1]); t.y = pk2(p1[2], p1[3]); t.z = pk2(p1[4], p1[5]); t.w = pk2(p1[6], p1[7]); pf[2] = __builtin_bit_cast(bf16x8, t);
              t.x = pk2(p1[8], p1[9]); t.y = pk2(p1[10], p1[11]); t.z = pk2(p1[12], p1[13]); t.w = pk2(p1[14], p1[15]); pf[3] = __builtin_bit_cast(bf16x8, t); }
            const LAS unsigned char* Vb = lds + OFF_V + buf * VT_B + (4 * hi + q4) * VP + (vcol0 + 16 * b16 + 4 * p4) * 2;
#pragma unroll
            for (int ks = 0; ks < 4; ++ks) {
#pragma unroll
                for (int d = 0; d < NDB; ++d) {
                    const LAS unsigned char* a = Vb + (16 * ks) * VP + d * 64;
                    const s16x4 lo = vtr(a), hv = vtr(a + 8 * VP);
                    const bf16x8 vf = __builtin_shufflevector(lo, hv, 0, 1, 2, 3, 4, 5, 6, 7);
                    o[d] = MFMA32(vf, pf[ks], o[d]);
                }
                __builtin_amdgcn_sched_barrier(0);
            }
        }
        if (more) {
            const Job J = make_job<MODE>(slot);
            store_tile(J, kt + 1, buf ^ 1, srow, sch, r0, r1, r2, r3, lds); if (MODE == 1 && tid < 128) ((LAS float*)(lds + OFF_CUM))[(buf ^ 1) * 128 + tid] = cumv;
        }
        __syncthreads();
    }
    const float l_tot = l_run + __shfl_xor(l_run, 32);
    const float inv = active ? 1.f / l_tot : 0.f;
    if (MODE != 0) {
        if (active) {
            const Job J = make_job<MODE>(slot);
            bf16_t* op = J.o + (size_t)(32 * qs + r32) * DM + half * 64 + 4 * hi;
#pragma unroll
            for (int d = 0; d < NDB; ++d)
#pragma unroll
                for (int g = 0; g < 4; ++g) { u32x2 w; w.x = pk2(o[d][4 * g] * inv, o[d][4 * g + 1] * inv); w.y = pk2(o[d][4 * g + 2] * inv, o[d][4 * g + 3] * inv);
                    *(u32x2*)(op + 32 * d + 8 * g) = w; }
        }
    } else {
        LAS float* ex = (LAS float*)lds + qs * 4096 + lane;
        if (active && half == 1) {
#pragma unroll
            for (int d = 0; d < NDB; ++d)
#pragma unroll
                for (int i = 0; i < 16; ++i) ex[(d * 16 + i) * 64] = o[d][i] * inv;
        }
        __syncthreads();
        if (active && half == 0) {
            const Job J = make_job<MODE>(slot);
            ArgsP a = fresh_args();
            const float lam = expf(wave_sum(a->in[I_LQ1][lane] * a->in[I_LK1][lane])) - expf(wave_sum(a->in[I_LQ2][lane] * a->in[I_LK2][lane])) + 0.2f;
            float ss = 0.f;
#pragma unroll
            for (int d = 0; d < NDB; ++d)
#pragma unroll
                for (int i = 0; i < 16; ++i) { const float v = o[d][i] * inv - lam * ex[(d * 16 + i) * 64]; o[d][i] = v; ss += v * v; }
            ss += __shfl_xor(ss, 32);
            const float rs = rsqrtf(ss * (1.f / 128.f) + EPS) * 0.8f;
            bf16_t* op = J.o + (size_t)(32 * qs + r32) * DM + 4 * hi;
#pragma unroll
            for (int d = 0; d < NDB; ++d)
#pragma unroll
                for (int g = 0; g < 4; ++g) { const f32x4 gg = *(const f32x4*)(J.subg + 32 * d + 8 * g + 4 * hi);
                    u32x2 w; w.x = pk2(o[d][4 * g] * rs * gg[0], o[d][4 * g + 1] * rs * gg[1]); w.y = pk2(o[d][4 * g + 2] * rs * gg[2], o[d][4 * g + 3] * rs * gg[3]);
                    *(u32x2*)(op + 32 * d + 8 * g) = w; }
        }
    }
}
}

#define LDS_WAIT() asm volatile("s_waitcnt lgkmcnt(0)" ::: "memory")
DI void transpose_item(const float* W, int ldw, int K, int nblk, bf16_t* WT, LAS float* scr, int item, int lane) {
    const int kb = item / nblk, nb = item - kb * nblk, k0 = 64 * kb, n0 = 32 * nb;
#pragma unroll 8
    for (int i = 0; i < 32; ++i) { const int kk = 2 * i + (lane >> 5); scr[kk * 33 + (lane & 31)] = W[(size_t)(k0 + kk) * ldw + n0 + (lane & 31)]; }
    LDS_WAIT();
    const int c = lane & 7;
#pragma unroll
    for (int j = 0; j < 4; ++j) { const int n = (lane >> 3) + 8 * j; const LAS float* s = scr + (8 * c) * 33 + n;
        u32x4 o; o.x = pk2(s[0 * 33], s[1 * 33]); o.y = pk2(s[2 * 33], s[3 * 33]); o.z = pk2(s[4 * 33], s[5 * 33]); o.w = pk2(s[6 * 33], s[7 * 33]);
        *(u32x4*)(WT + (size_t)(n0 + n) * K + k0 + 8 * c) = o; }
    LDS_WAIT();
}
DI float log_sigmoid(float x) { return fminf(x, 0.f) - log1pf(expf(-fabsf(x))); }

DI void prologue_phase(LAS unsigned char* lds, ArgsP a, int tid, int lane, int wave) {
    unsigned char* ws = a->ws;
    const int gw = launder((int)blockIdx.x) * NWAVES + wave, NGW = launder((int)gridDim.x) * NWAVES;
    {
        LAS float* scr = (LAS float*)(lds + wave * 8448);
        constexpr int I_IN = 16 * 96, I_O = 16 * 32, I_UP = 16 * 128, I_DN = 64 * 32;
        constexpr int NITEMS = 2 * I_IN + 2 * I_O + 2 * I_UP + 2 * I_DN;
        for (int it = gw; it < NITEMS; it += NGW) {
            int r = it;
            if (r < I_IN) { transpose_item(a->in[I_WINE], 3080, 1024, 96, (bf16_t*)(ws + WS_WINE), scr, r, lane); continue; } r -= I_IN;
            if (r < I_IN) { transpose_item(a->in[I_WINO], 3072, 1024, 96, (bf16_t*)(ws + WS_WINO), scr, r, lane); continue; } r -= I_IN;
            if (r < I_O) { transpose_item(a->in[I_WOUTE], 1024, 1024, 32, (bf16_t*)(ws + WS_WOUTE), scr, r, lane); continue; } r -= I_O;
            if (r < I_O) { transpose_item(a->in[I_WOUTO], 1024, 1024, 32, (bf16_t*)(ws + WS_WOUTO), scr, r, lane); continue; } r -= I_O;
            if (r < 2 * I_UP) { const int l = r / I_UP; transpose_item(a->in[I_WUP] + (size_t)l * 1024 * 4096, 4096, 1024, 128, (bf16_t*)(ws + WS_WUP + l * 8 * MiB), scr, r - l * I_UP, lane); continue; } r -= 2 * I_UP;
            { const int l = r / I_DN; transpose_item(a->in[I_WDN] + (size_t)l * 4096 * 1024, 1024, 4096, 32, (bf16_t*)(ws + WS_WDN + l * 8 * MiB), scr, r - l * I_DN, lane); }
        }
    }
    {
        const size_t per_b = (size_t)448 * 1024 / 4, total = 2 * 8 * per_b;
        for (size_t i = (size_t)blockIdx.x * NTHR + tid; i < total; i += (size_t)gridDim.x * NTHR) {
            const int kv = (int)(i / (8 * per_b)); const size_t r = i - (size_t)kv * 8 * per_b; const int b = (int)(r / per_b); const size_t e = r - (size_t)b * per_b;
            const f32x4* src = (const f32x4*)(a->in[kv ? I_CCV : I_CCK] + (size_t)b * 512 * 1024 + 64 * 1024) + e;
            f32x4* dst = (f32x4*)(a->out + (kv ? O_SCV : O_SCK) + (size_t)b * 512 * 1024) + e;
            *dst = *src;
        }
    }
    LAS float* wf = (LAS float*)(lds + 98304);
    __syncthreads();
    for (int e = tid; e < 8192; e += NTHR) { const int k = e >> 3, o = e & 7; wf[o * 1024 + k] = a->in[I_WINE][(size_t)k * 3080 + 3072 + o]; }
    __syncthreads();
    const float* gp = a->in[I_GPM]; bf16_t* xn = (bf16_t*)(ws + WS_XN);
    f32x4 g[4];
#pragma unroll
    for (int j = 0; j < 4; ++j) g[j] = ((const f32x4*)gp)[lane + 64 * j];
    for (int m = gw; m < MT; m += NGW) {
        const float* xr = m < MP ? a->in[I_XP] + (size_t)m * DM : a->in[I_XS] + (size_t)(m - MP) * DM;
        f32x4 v[4]; float ss = 0.f;
#pragma unroll
        for (int j = 0; j < 4; ++j) { v[j] = ((const f32x4*)xr)[lane + 64 * j]; ss += (v[j].x * v[j].x + v[j].y * v[j].y) + (v[j].z * v[j].z + v[j].w * v[j].w); }
#pragma unroll
        for (int j = 0; j < 4; ++j) ((f32x4*)(a->out + (size_t)m * DM))[lane + 64 * j] = v[j];
        const float rstd = rsqrtf(wave_sum(ss) * (1.f / DM) + EPS);
#pragma unroll
        for (int j = 0; j < 4; ++j) { v[j] = v[j] * rstd * g[j]; u32x2 w; w.x = pk2(v[j].x, v[j].y); w.y = pk2(v[j].z, v[j].w); ((u32x2*)(xn + (size_t)m * DM))[lane + 64 * j] = w; }
        float mine = 0.f;
#pragma unroll
        for (int o = 0; o < 8; ++o) { float acc = 0.f;
#pragma unroll
            for (int j = 0; j < 4; ++j) { const f32x4 w = *(const LAS f32x4*)(wf + o * 1024 + 4 * (lane + 64 * j)); acc += (v[j].x * w.x + v[j].y * w.y) + (v[j].z * w.z + v[j].w * w.w); }
            acc = wave_sum(acc); if (lane == o) mine = acc; }
        if (lane < 8) { const float lf = log_sigmoid(mine + a->in[I_BF][lane]);
            if (m < MP) a->out[O_PBL + (size_t)m * 8 + lane] = lf; else a->out[O_SBL + (size_t)(m - MP) * 8 + lane] = lf; }
    }
}

DI void scan_seq(ArgsP a, int seq, int lane) {
    float* cump = (float*)(a->ws + WS_CUMP); float* cums = (float*)(a->ws + WS_CUMS);
    const bool smp = seq >= 32; const int s = smp ? seq - 32 : seq, b = s >> 3, h = s & 7, n = smp ? 17 : 64, i0 = lane * n;
    const float* src0 = smp ? a->in[I_CBL] + (size_t)b * 1024 * 8 + h : a->out + O_PBL + (size_t)b * 4096 * 8 + h;
    const float* src1 = a->out + O_SBL + (size_t)b * 64 * 8 + h;
    float* dst = smp ? cums + (size_t)(b * 8 + h) * 1088 : cump + (size_t)(b * 8 + h) * 4096;
    float tot = 0.f;
    for (int i = 0; i < n; ++i) { const int idx = i0 + i; tot += (smp && idx >= 1024) ? src1[(size_t)(idx - 1024) * 8] : src0[(size_t)idx * 8]; }
    float x = tot;
#pragma unroll
    for (int o = 1; o < 64; o <<= 1) { const float t = __shfl_up(x, o); if (lane >= o) x += t; }
    float run = x - tot;
    for (int i = 0; i < n; ++i) { const int idx = i0 + i; run += (smp && idx >= 1024) ? src1[(size_t)(idx - 1024) * 8] : src0[(size_t)idx * 8]; dst[idx] = run * LOG2E; }
}

DI void rows_phase(ArgsP a, const float* gpost, const float* gnext, int lane, int wave) {
    const bf16_t* Y = (const bf16_t*)(a->ws + WS_Y); bf16_t* xn = (bf16_t*)(a->ws + WS_XN);
    const int gw = launder((int)blockIdx.x) * NWAVES + wave, NGW = launder((int)gridDim.x) * NWAVES;
    for (int m = gw; m < MT; m += NGW) {
        f32x4 y[4], x[4]; float ss = 0.f;
#pragma unroll
        for (int j = 0; j < 4; ++j) { const u32x2 w = ((const u32x2*)(Y + (size_t)m * DM))[lane + 64 * j];
            y[j].x = __uint_as_float(w.x << 16); y[j].y = __uint_as_float(w.x & 0xffff0000u); y[j].z = __uint_as_float(w.y << 16); y[j].w = __uint_as_float(w.y & 0xffff0000u);
            ss += (y[j].x * y[j].x + y[j].y * y[j].y) + (y[j].z * y[j].z + y[j].w * y[j].w);
            x[j] = ((const f32x4*)(a->out + (size_t)m * DM))[lane + 64 * j]; }
        const float rstd = rsqrtf(wave_sum(ss) * (1.f / DM) + EPS);
        float s2 = 0.f;
#pragma unroll
        for (int j = 0; j < 4; ++j) { const f32x4 g = ((const f32x4*)gpost)[lane + 64 * j]; x[j] = x[j] + y[j] * rstd * g;
            ((f32x4*)(a->out + (size_t)m * DM))[lane + 64 * j] = x[j]; s2 += (x[j].x * x[j].x + x[j].y * x[j].y) + (x[j].z * x[j].z + x[j].w * x[j].w); }
        if (gnext) {
            const float r2 = rsqrtf(wave_sum(s2) * (1.f / DM) + EPS);
#pragma unroll
            for (int j = 0; j < 4; ++j) { const f32x4 g = ((const f32x4*)gnext)[lane + 64 * j]; const f32x4 h = x[j] * r2 * g;
                u32x2 w; w.x = pk2(h.x, h.y); w.y = pk2(h.z, h.w); ((u32x2*)(xn + (size_t)m * DM))[lane + 64 * j] = w; }
        }
    }
}

DI void attn_even_phase(LAS unsigned char* lds) {
    const int bx = launder((int)blockIdx.x), G = launder((int)gridDim.x);
#ifndef T_NO_M0
    for (int s = bx; s < 544; s += G) att::attn_unit<0>(lds, s);
#endif
    for (int i = 0;; ++i) {
        int s = i * G + bx;
        if (G == 256 && i == 2) s = (bx >= 32 && bx < 64) ? 512 + bx - 32 : 544;
        if (s >= 544) break;
#ifndef T_NO_M1
        att::attn_unit<1>(lds, s);
#endif
    }
}
DI void attn_odd_phase(LAS unsigned char* lds) {
    const int bx = launder((int)blockIdx.x), G = launder((int)gridDim.x);
    for (int s = bx; s < 1088; s += G) att::attn_unit<2>(lds, s);
}

typedef unsigned short bf16;
#define XB_TMO      128
#define XB_XCNT(j)  (256  + 64 * (j))
#define XB_XSUB(j)  (1280 + 64 * (j))
#define XB_XGEN(j)  (2304 + 64 * (j))
#define XB_TOP      3328
#define XB_TOPGEN   3392
#define XCD_BAR_WORDS 3456
#define XB_SPIN_CAP (1u << 18)

__device__ __forceinline__ unsigned xb_ld(unsigned* p)              { return __hip_atomic_load(p, __ATOMIC_RELAXED, __HIP_MEMORY_SCOPE_AGENT); }
__device__ __forceinline__ unsigned xb_add(unsigned* p, unsigned v) { return __hip_atomic_fetch_add(p, v, __ATOMIC_RELAXED, __HIP_MEMORY_SCOPE_AGENT); }
__device__ __forceinline__ unsigned xb_xcc_id() { return (unsigned)__builtin_amdgcn_s_getreg((3 << 11) | 20) & 0xFu; }
#define XB_SPIN(cond, bar) do { unsigned _sp = 0; while (cond) { __builtin_amdgcn_s_sleep(1); \
    if ((++_sp & 255u) == 0u) { if (xb_ld(&(bar)[XB_TMO])) break; if (_sp > XB_SPIN_CAP) { atomicAdd(&(bar)[XB_TMO], 1u); break; } } } } while (0)

struct XcdBarrier {
    unsigned* bar; unsigned x;
    volatile LAS unsigned* st;
};

__device__ __forceinline__ XcdBarrier xcd_barrier_post(unsigned* bar, volatile LAS unsigned* st) {
    XcdBarrier b; b.bar = bar; b.x = xb_xcc_id(); b.st = st;
    if (threadIdx.x == 0) (void)xb_add(&bar[XB_XCNT(b.x)], 1u);
    return b;
}
__device__ __forceinline__ void xcd_barrier_complete(unsigned* bar, unsigned x, unsigned& nloc, unsigned& nx) {
    const unsigned G = gridDim.x * gridDim.y * gridDim.z;
    unsigned sum, cnt, mine, sp = 0u;
    for (;;) {
        sum = 0u; cnt = 0u; mine = 0u;
#pragma unroll
        for (unsigned j = 0; j < 16; ++j) { const unsigned c = xb_ld(&bar[XB_XCNT(j)]); sum += c; cnt += (c > 0u) ? 1u : 0u; mine = (j == x) ? c : mine; }
        if (sum == G) break;
        __builtin_amdgcn_s_sleep(1);
        if ((++sp & 255u) == 0u) { if (xb_ld(&bar[XB_TMO])) break; if (sp > XB_SPIN_CAP) { atomicAdd(&bar[XB_TMO], 1u); break; } }
    }
    nloc = mine > 0u ? mine : 1u; nx = cnt > 0u ? cnt : 1u;
}

__device__ __forceinline__ void xcd_barrier(const XcdBarrier& b) {
    asm volatile("s_waitcnt vmcnt(0)" ::: "memory");
    __syncthreads();
    if (threadIdx.x == 0) {
        unsigned* bar = b.bar;
        __builtin_amdgcn_s_waitcnt(0);
        unsigned nloc = b.st[0], nx = b.st[1];
        if (nloc == 0u) { xcd_barrier_complete(bar, b.x, nloc, nx); b.st[0] = nloc; b.st[1] = nx; }
        const unsigned old = xb_add(&bar[XB_XSUB(b.x)], 1u);
        const unsigned gen = old / nloc;
        if (old + 1u == (gen + 1u) * nloc) {
            __builtin_amdgcn_fence(__ATOMIC_RELEASE, "agent");
            asm volatile("s_waitcnt vmcnt(0)" ::: "memory");
            const unsigned og = xb_add(&bar[XB_TOP], 1u);
            const unsigned tg = og / nx;
            if (og + 1u == (tg + 1u) * nx) xb_add(&bar[XB_TOPGEN], 1u);
            else XB_SPIN(xb_ld(&bar[XB_TOPGEN]) == tg, bar);
            __builtin_amdgcn_fence(__ATOMIC_ACQUIRE, "agent");
            xb_add(&bar[XB_XGEN(b.x)], 1u);
            asm volatile("s_waitcnt vmcnt(0)" ::: "memory");
        } else {
            XB_SPIN(xb_ld(&bar[XB_XGEN(b.x)]) == gen, bar);
            __builtin_amdgcn_fence(__ATOMIC_ACQUIRE, "agent");
            asm volatile("s_waitcnt vmcnt(0)" ::: "memory");
        }
    }
    __syncthreads();
}

template <int PH_LO, int PH_HI>
__global__ void __launch_bounds__(NTHR, 2) fwd_kernel(Args a_unused) {
    extern __shared__ __attribute__((aligned(16))) unsigned char lds_raw[];
    LAS unsigned char* lds = (LAS unsigned char*)lds_raw;
    cg::grid_group grid = cg::this_grid();
    constexpr bool ONE = (PH_HI - PH_LO) > 1;
    if (ONE) {
        { int t0 = threadIdx.x; if (t0 < 64) ((LAS unsigned*)(lds + 131072))[t0] = 0u; }
        __syncthreads();
        ArgsP a0 = fresh_args();
        (void)xcd_barrier_post((unsigned*)a0->ws, (volatile LAS unsigned*)(lds + 131072 + 32));
    }
#define IN(k) (PH_LO <= (k) && (k) < PH_HI)
#define SEAM(k) do { if (IN(k) && IN((k) + 1)) { if ((k) == PH_LO) grid.sync(); else { ArgsP ab = fresh_args(); XcdBarrier bb; bb.bar = (unsigned*)ab->ws; bb.x = xb_xcc_id(); bb.st = (volatile LAS unsigned*)(lds + 131072 + 32); xcd_barrier(bb); } } } while (0)
#define PHASE_ARGS int tid = threadIdx.x; asm volatile("" : "+v"(tid)); const int lane = tid & 63, wave = __builtin_amdgcn_readfirstlane(tid >> 6); (void)lane; (void)wave; ArgsP a = fresh_args(); unsigned char* ws = a->ws; (void)ws; const int bx_ = launder((int)blockIdx.x), G_ = launder((int)gridDim.x); (void)bx_; (void)G_
    if (IN(0)) { PHASE_ARGS; prologue_phase(lds, a, tid, lane, wave); __syncthreads(); }
    SEAM(0);
#pragma unroll
    for (int l = 0; l < 2; ++l) {
        const int p = l * 7;
        if (IN(p + 1)) {
            PHASE_ARGS;
            if (l == 0) {
                if (bx_ >= 64 && bx_ < 76) scan_seq(a, (bx_ - 64) * 8 + wave, lane);
                else if (G_ < 76 && bx_ == 0) { for (int q = wave; q < 96; q += NWAVES) scan_seq(a, q, lane); }
                __syncthreads();
                pg8::Gemm g{(const bf16_t*)(ws + WS_XN), (const bf16_t*)(ws + WS_WINE), MT, 3072, DM}; pg8::StaticOrder S; S.init(MT, 3072, G_, bx_);
                EpiX<2> E{(bf16_t*)(ws + WS_Z), ZP, a->out};
                pg8::gemm_phase<EpiX<2>, pg8::StaticOrder, true, true>(lds, g, S, E);
            } else {
                pg8::Gemm g{(const bf16_t*)(ws + WS_XN), (const bf16_t*)(ws + WS_WINO), MT, 3072, DM}; pg8::StaticOrder S; S.init(MT, 3072, G_, bx_);
                EpiX<3> E{(bf16_t*)(ws + WS_Z), ZP, a->out};
                pg8::gemm_phase<EpiX<3>, pg8::StaticOrder, true, true>(lds, g, S, E);
            }
        }
        SEAM(p + 1);
        if (IN(p + 2)) {
#ifndef T_NO_EVEN
            if (l == 0) attn_even_phase(lds);
#endif
#ifndef T_NO_ODD
            if (l == 1) attn_odd_phase(lds);
#endif
            __syncthreads(); }
        SEAM(p + 2);
        if (IN(p + 3)) {
            PHASE_ARGS;
            pg8::Gemm g{(const bf16_t*)(ws + WS_ATT), (const bf16_t*)(ws + (l == 0 ? WS_WOUTE : WS_WOUTO)), MT, DM, DM}; pg8::StaticOrder S; S.init(MT, DM, G_, bx_);
            EpiX<0> E{(bf16_t*)(ws + WS_Y), DM, nullptr};
            pg8::gemm_phase<EpiX<0>, pg8::StaticOrder, true, true>(lds, g, S, E);
        }
        SEAM(p + 3);
        if (IN(p + 4)) { PHASE_ARGS; rows_phase(a, a->in[I_GQM] + l * DM, a->in[I_GPF] + l * DM, lane, wave); }
        SEAM(p + 4);
        if (IN(p + 5)) {
            PHASE_ARGS;
            pg8::Gemm g{(const bf16_t*)(ws + WS_XN), (const bf16_t*)(ws + WS_WUP + l * 8 * MiB), MT, FF, DM}; pg8::StaticOrder S; S.init(MT, FF, G_, bx_);
            EpiX<1> E{(bf16_t*)(ws + WS_H), FF, nullptr};
            pg8::gemm_phase<EpiX<1>, pg8::StaticOrder, true, true>(lds, g, S, E);
        }
        SEAM(p + 5);
        if (IN(p + 6)) {
            PHASE_ARGS;
            pg8::Gemm g{(const bf16_t*)(ws + WS_H), (const bf16_t*)(ws + WS_WDN + l * 8 * MiB), MT, DM, FF}; pg8::StaticOrder S; S.init(MT, DM, G_, bx_);
            EpiX<0> E{(bf16_t*)(ws + WS_Y), DM, nullptr};
            pg8::gemm_phase<EpiX<0>, pg8::StaticOrder, true, true>(lds, g, S, E);
        }
        SEAM(p + 6);
        if (IN(p + 7)) { PHASE_ARGS; rows_phase(a, a->in[I_GQF] + l * DM, l == 0 ? a->in[I_GPM] + DM : nullptr, lane, wave); }
        SEAM(p + 7);
    }
#undef IN
#undef SEAM
}

#if MK_ONE_LAUNCH
#define KFN (fwd_kernel<0, 15>)
#else
#define KFN (fwd_kernel<0, 1>)
typedef void (*kfn_t)(Args);
static kfn_t kfns[15] = {fwd_kernel<0, 1>, fwd_kernel<1, 2>, fwd_kernel<2, 3>, fwd_kernel<3, 4>, fwd_kernel<4, 5>, fwd_kernel<5, 6>, fwd_kernel<6, 7>, fwd_kernel<7, 8>,
                         fwd_kernel<8, 9>, fwd_kernel<9, 10>, fwd_kernel<10, 11>, fwd_kernel<11, 12>, fwd_kernel<12, 13>, fwd_kernel<13, 14>, fwd_kernel<14, 15>};
#endif
extern "C" void kernel_launch(void* const* d_in, const int* in_sizes, int n_in, void* d_out, int out_size, void* d_ws, size_t ws_size, hipStream_t stream) {
    static int grid = 0;
    if (grid == 0) {
        if (n_in != N_IN || (size_t)out_size != O_END || ws_size < WS_END) { fprintf(stderr, "kernel_launch: unexpected shapes (n_in %d out %d ws %zu)\n", n_in, out_size, ws_size); grid = -1; return; }
        int dev = 0, cus = 0, per_cu = 0;
        (void)hipGetDevice(&dev); (void)hipDeviceGetAttribute(&cus, hipDeviceAttributeMultiprocessorCount, dev);
        if (hipFuncSetAttribute((const void*)KFN, hipFuncAttributeMaxDynamicSharedMemorySize, LDS_BYTES) != hipSuccess) { fprintf(stderr, "kernel_launch: hipFuncSetAttribute failed\n"); grid = -1; return; }
#if !MK_ONE_LAUNCH
        for (int k = 1; k < 15; ++k) (void)hipFuncSetAttribute((const void*)kfns[k], hipFuncAttributeMaxDynamicSharedMemorySize, LDS_BYTES);
#endif
        (void)hipOccupancyMaxActiveBlocksPerMultiprocessor(&per_cu, (const void*)KFN, NTHR, LDS_BYTES);
        if (per_cu < 1) per_cu = 1;
        (void)hipGetLastError();
        grid = cus * per_cu;
        fprintf(stderr, "kernel_launch: grid %d (cus %d x %d)\n", grid, cus, per_cu);
    }
    if (grid < 0) return;
    Args a{};
    for (int i = 0; i < N_IN; ++i) a.in[i] = (const float*)d_in[i];
    a.out = (float*)d_out; a.ws = (unsigned char*)d_ws;
#if MK_ONE_LAUNCH
    if (hipMemsetAsync(d_ws, 0, 16384, stream) != hipSuccess) { fprintf(stderr, "kernel_launch: memset failed\n"); return; }
    a.ph_lo = 0; a.ph_hi = 15;
    void* args[] = {&a};
    hipError_t e = hipLaunchCooperativeKernel((const void*)KFN, dim3(grid), dim3(NTHR), args, LDS_BYTES, stream);
    if (e != hipSuccess) fprintf(stderr, "cooperative launch failed: %s (grid %d)\n", hipGetErrorString(e), grid);
#else
    for (int k = 0; k < 15; ++k) { a.ph_lo = k; a.ph_hi = k + 1; hipLaunchKernelGGL(kfns[k], dim3(grid), dim3(NTHR), LDS_BYTES, stream, a); }
#endif
}
```

```cpp
#include <hip/hip_runtime.h>
#include <hip/hip_cooperative_groups.h>
#include <cstdio>
#include <cstdint>
namespace cg = cooperative_groups;
#ifndef MK_ONE_LAUNCH
#define MK_ONE_LAUNCH 1
#endif
namespace pg8 {
#define PG8_LAS __attribute__((address_space(3)))
typedef unsigned short bf16_t;
typedef short bf16x8 __attribute__((ext_vector_type(8)));
typedef float f32x4 __attribute__((ext_vector_type(4)));
typedef unsigned u32x4 __attribute__((ext_vector_type(4)));
constexpr int BM = 256, BK = 64, HALF = 128, HTB = HALF * BK * 2  , STAGE_BYTES = 8 * HTB, NXCD = 8, WGM = 8;

__host__ __device__ __forceinline__ int lds_byte(int r, int c) { const int st = (r >> 4) * 2 + (c >> 5), rr = r & 15, cc = c & 31, ob = rr * 64 + cc * 2; return st * 1024 + (ob ^ (((ob >> 9) & 1) << 5)); }
__host__ __device__ __forceinline__ void stage_rc(int b, int& R, int& C) { const int st = b / 1024, sb = b % 1024, swz = sb ^ (((sb >> 9) & 1) << 5); R = (st >> 1) * 16 + swz / 64; C = (st & 1) * 32 + (swz % 64) / 2; }
__host__ __device__ __forceinline__ int perm32(int rho) { const int n = rho >> 4, i = rho & 15; return 8 * (i >> 2) + 4 * n + (i & 3); }

struct Unit { int pm, pn; };
struct Gemm { const bf16_t* A; const bf16_t* Bt; int M, N, K; };

struct StaticOrder {
    int nM, nN, nwg, G, c;
    __host__ __device__ void init(int M, int N, int G_, int c_) { nM = M / BM; nN = N / BM; nwg = nM * nN; G = G_; c = c_; }
    __host__ __device__ bool next(int i, Unit& u) const {
        const long L = (long)i * G + c; if (L >= nwg) return false;
        int wgid = (int)L; { const int q = nwg / NXCD, r = nwg % NXCD, xcd = wgid % NXCD, off = wgid / NXCD; wgid = (xcd < r ? xcd * (q + 1) : r * (q + 1) + (xcd - r) * q) + off; }
        const int nig = WGM * nN, gid = wgid / nig, fm = gid * WGM, gsz = (nM - fm) < WGM ? (nM - fm) : WGM;
        u.pm = fm + ((wgid % nig) % gsz); u.pn = (wgid % nig) / gsz; return true;
    }
    __device__ __forceinline__ void a_ready(const Unit&) const {}
    __device__ __forceinline__ void done(const Unit&) const {}
};

__device__ __forceinline__ unsigned cvt_pk_bf16(float lo, float hi) { unsigned r; asm volatile("v_cvt_pk_bf16_f32 %0, %1, %2" : "=v"(r) : "v"(lo), "v"(hi)); return r; }
typedef float f32x2 __attribute__((ext_vector_type(2)));
template <class Epi, class Sched, bool ALIGN_EPI = false, bool SP2 = false>
__device__ __forceinline__ void gemm_phase(PG8_LAS unsigned char* lds, const Gemm g, const Sched& S, const Epi& E) {
    int tid_l = threadIdx.x; asm volatile("" : "+v"(tid_l));
    const int tid = tid_l, wid = __builtin_amdgcn_readfirstlane(tid >> 6), lane = tid & 63, wr = wid >> 2, wc = wid & 3, fr = lane & 15, fq = lane >> 4;
    const int K = g.K, nt = K / BK;
    unsigned voffA[2], voffB[2];
#pragma unroll
    for (int i = 0; i < 2; ++i) { int R, C; stage_rc(tid * 16 + i * 8192, R, C); const int Rb = Epi::PERM ? ((R & ~31) + perm32(R & 31)) : R;
        voffA[i] = (unsigned)(R * K + C) * 2u; voffB[i] = (unsigned)(Rb * K + C) * 2u; }
    const size_t kstep = (size_t)(BK * 2);
    const size_t hstep = (size_t)HALF * K * 2;
    const size_t tstep = 2 * hstep;
    const unsigned ldsw = (unsigned)wid * 1024u;
    const int aoff = lds_byte(wr * 64 + fr, fq * 8), boff = lds_byte(wc * 32 + fr, fq * 8);
#define PG8_SA(b, h) (((b) * 2 + (h)) * HTB)
#define PG8_SB(b, h) ((4 + (b) * 2 + (h)) * HTB)
#define PG8_STAGE(bufoff, gbase, voff) do { _Pragma("unroll") for (int _i = 0; _i < 2; ++_i) \
        __builtin_amdgcn_global_load_lds((const unsigned*)((const char*)(gbase) + (voff)[_i]), (PG8_LAS unsigned*)(lds + (bufoff) + ldsw + _i * 8192), 16, 0, 0); } while (0)
#define PG8_LDA(dst, b, h) do { _Pragma("unroll") for (int m = 0; m < 4; ++m) _Pragma("unroll") for (int k = 0; k < 2; ++k) dst[m][k] = *(const PG8_LAS bf16x8*)(lds + PG8_SA(b, h) + aoff + m * 2048 + k * 1024); } while (0)
#define PG8_LDB(dst, b, h) do { _Pragma("unroll") for (int n = 0; n < 2; ++n) _Pragma("unroll") for (int k = 0; k < 2; ++k) dst[n][k] = *(const PG8_LAS bf16x8*)(lds + PG8_SB(b, h) + boff + n * 2048 + k * 1024); } while (0)
#define PG8_MMA(ai, bj, At, Bt) do { __builtin_amdgcn_s_setprio(1); _Pragma("unroll") for (int m = 0; m < 4; ++m) _Pragma("unroll") for (int n = 0; n < 2; ++n) _Pragma("unroll") for (int k = 0; k < 2; ++k) \
        acc[ai][bj][m][n] = __builtin_amdgcn_mfma_f32_16x16x32_bf16(Bt[n][k], At[m][k], acc[ai][bj][m][n], 0, 0, 0); __builtin_amdgcn_s_setprio(0); } while (0)
#define PG8_WAIT_V(n) asm volatile("s_waitcnt vmcnt(" #n ")" ::: "memory")
#define PG8_WAIT_L(n) asm volatile("s_waitcnt lgkmcnt(" #n ")" ::: "memory")
#define PG8_BAR __builtin_amdgcn_s_barrier()
#define PG8_SCHED __builtin_amdgcn_sched_barrier(0)
    Unit cur, nxt; int ui = 0;
    if (!S.next(0, cur)) return;
    f32x4 acc[2][2][4][2];
#pragma unroll
    for (int a = 0; a < 2; ++a)
#pragma unroll
        for (int b = 0; b < 2; ++b)
#pragma unroll
            for (int m = 0; m < 4; ++m)
#pragma unroll
                for (int n = 0; n < 2; ++n) acc[a][b][m][n] = (f32x4){0.f, 0.f, 0.f, 0.f};
    bf16x8 At[4][2], B0[2][2], B1[2][2];
    const char* cA = (const char*)g.A + (size_t)cur.pm * tstep; const char* cB = (const char*)g.Bt + (size_t)cur.pn * tstep;
    S.a_ready(cur);
    if constexpr (SP2) {
        PG8_STAGE(PG8_SB(0, 0), cB, voffB); PG8_STAGE(PG8_SB(0, 1), cB + hstep, voffB); PG8_STAGE(PG8_SA(0, 0), cA, voffA); PG8_STAGE(PG8_SA(0, 1), cA + hstep, voffA);
        if (wr == 1) PG8_BAR;
        PG8_WAIT_V(2); PG8_BAR;
        PG8_STAGE(PG8_SB(1, 0), cB + kstep, voffB); PG8_STAGE(PG8_SA(1, 0), cA + kstep, voffA); PG8_STAGE(PG8_SB(1, 1), cB + hstep + kstep, voffB);
        PG8_WAIT_V(6); PG8_BAR;
    } else {
        PG8_STAGE(PG8_SB(0, 0), cB, voffB); PG8_STAGE(PG8_SA(0, 0), cA, voffA); PG8_STAGE(PG8_SB(0, 1), cB + hstep, voffB); PG8_STAGE(PG8_SA(0, 1), cA + hstep, voffA);
        if (wr == 1) PG8_BAR;
        PG8_WAIT_V(4); PG8_BAR;
        PG8_STAGE(PG8_SB(1, 0), cB + kstep, voffB); PG8_STAGE(PG8_SA(1, 0), cA + kstep, voffA); PG8_STAGE(PG8_SB(1, 1), cB + hstep + kstep, voffB);
        PG8_WAIT_V(6); PG8_BAR;
    }
    for (;;) {
        const bool has_next = S.next(ui + 1, nxt);
        const char* nA = has_next ? (const char*)g.A + (size_t)nxt.pm * tstep : cA; const char* nB = has_next ? (const char*)g.Bt + (size_t)nxt.pn * tstep : cB;
        for (int t = 0; t < nt; t += 2) {
            const bool last = (t == nt - 2);
            const char* a1 = cA + (size_t)(t + 1) * kstep;
            const char* a2 = last ? nA : cA + (size_t)(t + 2) * kstep; const char* b2 = last ? nB : cB + (size_t)(t + 2) * kstep;
            const char* a3 = a2 + kstep; const char* b3 = b2 + kstep;
            if (last && has_next) S.a_ready(nxt);
            if constexpr (SP2) {
            PG8_LDB(B0, 0, 0); PG8_LDB(B1, 0, 1); PG8_SCHED; PG8_LDA(At, 0, 0); PG8_STAGE(PG8_SA(1, 1), a1 + hstep, voffA);
            PG8_WAIT_V(8); PG8_WAIT_L(0); PG8_BAR; PG8_MMA(0, 0, At, B0); PG8_MMA(0, 1, At, B1); PG8_BAR; PG8_SCHED;
            PG8_LDA(At, 0, 1); PG8_STAGE(PG8_SB(0, 0), b2, voffB); PG8_STAGE(PG8_SB(0, 1), b2 + hstep, voffB); PG8_STAGE(PG8_SA(0, 0), a2, voffA);
            PG8_WAIT_V(8); PG8_WAIT_L(0); PG8_BAR; PG8_MMA(1, 0, At, B0); PG8_MMA(1, 1, At, B1); PG8_BAR; PG8_SCHED;
            PG8_LDB(B0, 1, 0); PG8_LDB(B1, 1, 1); PG8_SCHED; PG8_LDA(At, 1, 0); PG8_STAGE(PG8_SA(0, 1), a2 + hstep, voffA);
            PG8_WAIT_V(8); PG8_WAIT_L(0); PG8_BAR; PG8_MMA(0, 0, At, B0); PG8_MMA(0, 1, At, B1); PG8_BAR; PG8_SCHED;
            PG8_LDA(At, 1, 1); PG8_STAGE(PG8_SB(1, 0), b3, voffB); PG8_STAGE(PG8_SB(1, 1), b3 + hstep, voffB); PG8_STAGE(PG8_SA(1, 0), a3, voffA);
            PG8_WAIT_V(8); PG8_WAIT_L(0); PG8_BAR; PG8_MMA(1, 0, At, B0); PG8_MMA(1, 1, At, B1); PG8_BAR; PG8_SCHED;
            } else {
            PG8_LDB(B0, 0, 0); PG8_SCHED; PG8_LDA(At, 0, 0); PG8_STAGE(PG8_SA(1, 1), a1 + hstep, voffA);
            PG8_WAIT_L(8); PG8_BAR; PG8_WAIT_L(0); PG8_MMA(0, 0, At, B0); PG8_BAR; PG8_SCHED;
            PG8_LDB(B1, 0, 1); PG8_STAGE(PG8_SB(0, 0), b2, voffB);
            PG8_BAR; PG8_WAIT_L(0); PG8_MMA(0, 1, At, B1); PG8_BAR;
            PG8_LDA(At, 0, 1); PG8_STAGE(PG8_SA(0, 0), a2, voffA);
            PG8_BAR; PG8_WAIT_L(0); PG8_MMA(1, 0, At, B0); PG8_BAR; PG8_SCHED;
            PG8_STAGE(PG8_SB(0, 1), b2 + hstep, voffB);
            PG8_WAIT_V(6); PG8_BAR; PG8_MMA(1, 1, At, B1); PG8_BAR;
            PG8_LDB(B0, 1, 0); PG8_SCHED; PG8_LDA(At, 1, 0); PG8_STAGE(PG8_SA(0, 1), a2 + hstep, voffA);
            PG8_WAIT_L(8); PG8_BAR; PG8_WAIT_L(0); PG8_MMA(0, 0, At, B0); PG8_BAR; PG8_SCHED;
            PG8_LDB(B1, 1, 1); PG8_STAGE(PG8_SB(1, 0), b3, voffB);
            PG8_BAR; PG8_WAIT_L(0); PG8_MMA(0, 1, At, B1); PG8_BAR;
            PG8_LDA(At, 1, 1); PG8_STAGE(PG8_SA(1, 0), a3, voffA);
            PG8_BAR; PG8_WAIT_L(0); PG8_MMA(1, 0, At, B0); PG8_BAR; PG8_SCHED;
            PG8_STAGE(PG8_SB(1, 1), b3 + hstep, voffB);
            PG8_WAIT_V(6); PG8_BAR; PG8_MMA(1, 1, At, B1); PG8_BAR;
            }
        }
        if constexpr (ALIGN_EPI) { if (wr == 0) PG8_BAR; }
        if constexpr (!Epi::AFTER_DRAIN) { E(acc, cur, wr, wc, fr, fq); S.done(cur); }
        if (!has_next) break;
#pragma unroll
        for (int a = 0; a < 2; ++a)
#pragma unroll
            for (int b = 0; b < 2; ++b)
#pragma unroll
                for (int m = 0; m < 4; ++m)
#pragma unroll
                    for (int n = 0; n < 2; ++n) acc[a][b][m][n] = (f32x4){0.f, 0.f, 0.f, 0.f};
        cur = nxt; cA = nA; cB = nB; ++ui;
        if constexpr (ALIGN_EPI) { if (wr == 1) PG8_BAR; }
    }
    PG8_WAIT_V(0);
    if constexpr (!ALIGN_EPI) { if (wr == 0) PG8_BAR; }
    PG8_BAR;
    if constexpr (Epi::AFTER_DRAIN) { E.fused(acc, cur, wr, wc, fr, fq, lds, wid, lane); S.done(cur); }
#undef PG8_SA
#undef PG8_SB
#undef PG8_STAGE
#undef PG8_LDA
#undef PG8_LDB
#undef PG8_MMA
#undef PG8_WAIT_V
#undef PG8_WAIT_L
#undef PG8_BAR
#undef PG8_SCHED
}
}

typedef unsigned short bf16_t;
typedef short bf16x8 __attribute__((ext_vector_type(8)));
typedef short s16x4 __attribute__((ext_vector_type(4)));
typedef float f32x4 __attribute__((ext_vector_type(4)));
typedef float f32x2 __attribute__((ext_vector_type(2)));
typedef float f32x16 __attribute__((ext_vector_type(16)));
typedef unsigned u32x4 __attribute__((ext_vector_type(4)));
typedef unsigned u32x2 __attribute__((ext_vector_type(2)));
#define LAS __attribute__((address_space(3)))
#define DI __device__ __forceinline__

constexpr int DM = 1024, FF = 4096, MP = 16384, MS = 512, MT = MP + MS, SEQ = 4096, PAST = 1024, DSEQ = 64;
constexpr int ZP = 3072;
constexpr float LOG2E = 1.4426950408889634f;
constexpr float C2 = 0.125f * LOG2E;
constexpr float EPS = 1e-6f;
constexpr size_t O_YP = 0, O_YS = O_YP + (size_t)MP * DM, O_PAK = O_YS + (size_t)MS * DM, O_PAV = O_PAK + (size_t)MP * 512, O_PBK = O_PAV + (size_t)MP * 512,
                 O_PBV = O_PBK + (size_t)MP * 512, O_PBL = O_PBV + (size_t)MP * 512, O_PCK = O_PBL + (size_t)MP * 8, O_PCV = O_PCK + (size_t)4 * 512 * 1024,
                 O_SAK = O_PCV + (size_t)4 * 512 * 1024, O_SAV = O_SAK + (size_t)MS * 512, O_SBK = O_SAV + (size_t)MS * 512, O_SBV = O_SBK + (size_t)MS * 512,
                 O_SBL = O_SBV + (size_t)MS * 512, O_SCK = O_SBL + (size_t)MS * 8, O_SCV = O_SCK + (size_t)8 * 512 * 1024, O_END = O_SCV + (size_t)8 * 512 * 1024;
static_assert(O_END == 64622592, "output size");
constexpr size_t MiB = 1u << 20;
constexpr size_t WS_WINE = 1 * MiB, WS_WOUTE = 7 * MiB, WS_WUP0 = 9 * MiB, WS_WDN0 = 17 * MiB, WS_WINO = 25 * MiB, WS_WOUTO = 31 * MiB, WS_WUP1 = 33 * MiB, WS_WDN1 = 41 * MiB;
constexpr size_t WS_PART_DN = 1 * MiB;
constexpr size_t WS_PART_OUT = 116 * MiB;
constexpr size_t WS_XN = 49 * MiB, WS_Y = 82 * MiB, WS_CUMP = 115 * MiB, WS_CUMS = WS_CUMP + 524288, WS_Z = 116 * MiB, WS_ATT = 215 * MiB, WS_H = 116 * MiB, WS_END = 248 * MiB;
enum { I_XP = 0, I_XS, I_CAK, I_CAV, I_CBK, I_CBV, I_CBL, I_CCK, I_CCV, I_WINE, I_BF, I_LQ1, I_LK1, I_LQ2, I_LK2, I_SUBG, I_WOUTE, I_WINO, I_REL, I_WOUTO,
       I_GPM, I_GQM, I_GPF, I_GQF, I_WUP, I_WDN, N_IN };
constexpr int NWAVES = 8, NTHR = 512;
constexpr int LDS_BYTES = 147456;

struct Args { const float* in[N_IN]; float* out; unsigned char* ws; int ph_lo, ph_hi; };
typedef const __attribute__((address_space(4))) Args* ArgsP;
DI int launder(int v) { asm volatile("" : "+s"(v)); return v; }
DI ArgsP fresh_args() { ArgsP p = (ArgsP)__builtin_amdgcn_kernarg_segment_ptr(); asm volatile("" : "+s"(p)); return p; }

DI float wave_sum(float v) {
#pragma unroll
    for (int o = 1; o < 64; o <<= 1) v += __shfl_xor(v, o);
    return v;
}
DI unsigned pk2(float lo, float hi) { typedef __bf16 b2 __attribute__((ext_vector_type(2))); f32x2 v = {lo, hi}; b2 b = __builtin_convertvector(v, b2); return __builtin_bit_cast(unsigned, b); }
DI float bf2f(unsigned short h) { return __uint_as_float(((unsigned)h) << 16); }

template <int MODE> struct EpiX {
    static constexpr bool PERM = true, AFTER_DRAIN = false;
    bf16_t* O; int ldc; float* out;
    __device__ __forceinline__ void operator()(const pg8::f32x4 (&acc)[2][2][4][2], const pg8::Unit& u, int wr, int wc, int fr, int fq) const {
        const unsigned loff = (unsigned)(fr * ldc + 8 * fq) * 2u;
        char* ub = (char*)O + ((size_t)(u.pm * 256 + wr * 64) * ldc + u.pn * 256 + wc * 32) * 2;
        float sc = 1.f; char* fb = nullptr; unsigned floff = 0; int fpitch = 0; bool smp3 = false;
        if (MODE == 2) {
            const int seg = u.pn >> 1; fpitch = 512; floff = (unsigned)(fr * 512 + 8 * fq) * 4u;
            if (seg == 0 || seg == 3) sc = C2;
            else {
                const bool smp = u.pm >= 64;
                const size_t off = seg == 1 ? (smp ? O_SAK : O_PAK) : seg == 2 ? (smp ? O_SAV : O_PAV) : seg == 4 ? (smp ? O_SBK : O_PBK) : (smp ? O_SBV : O_PBV);
                fb = (char*)(out + off + (size_t)((smp ? u.pm - 64 : u.pm) * 256 + wr * 64) * 512 + (u.pn & 1) * 256 + wc * 32);
            }
        } else if (MODE == 3) {
            const int seg = u.pn >> 2; fpitch = 1024; floff = (unsigned)(fr * 1024 + 8 * fq) * 4u;
            if (seg == 0) sc = C2;
            else if (u.pm >= 64) { smp3 = true; fb = (char*)(out + (seg == 1 ? O_SCK : O_SCV) + (size_t)(((u.pm - 64) * 4 + wr) * 512 + 448) * 1024 + (u.pn & 3) * 256 + wc * 32); }
            else if ((u.pm & 15) >= 14) fb = (char*)(out + (seg == 1 ? O_PCK : O_PCV) + (size_t)((u.pm >> 4) * 512 + ((u.pm & 15) - 14) * 256 + wr * 64) * 1024 + (u.pn & 3) * 256 + wc * 32);
        }
#pragma unroll
        for (int ai = 0; ai < 2; ++ai)
#pragma unroll
            for (int m = 0; m < 4; ++m) {
                char* rb = ub + (size_t)(ai * 128 + m * 16) * ldc * 2;
                char* frb = nullptr;
                if (MODE >= 2 && fb) frb = fb + (size_t)((MODE == 3 && smp3) ? (ai * 1024 + m * 16) : (ai * 128 + m * 16)) * fpitch * 4;
#pragma unroll
                for (int bj = 0; bj < 2; ++bj) {
                    pg8::f32x4 v0 = acc[ai][bj][m][0], v1 = acc[ai][bj][m][1];
                    if (MODE >= 2 && frb) { *(pg8::f32x4*)(frb + bj * 512 + floff) = v0; *(pg8::f32x4*)(frb + bj * 512 + 16 + floff) = v1; }
                    if (MODE == 1) {
#pragma unroll
                        for (int e = 0; e < 4; ++e) { float a = fmaxf(v0[e], 0.f), b = fmaxf(v1[e], 0.f); v0[e] = a * a; v1[e] = b * b; }
                    }
                    if (MODE >= 2) { v0 = v0 * sc; v1 = v1 * sc; }
                    pg8::u32x4 w; w.x = pg8::cvt_pk_bf16(v0[0], v0[1]); w.y = pg8::cvt_pk_bf16(v0[2], v0[3]); w.z = pg8::cvt_pk_bf16(v1[0], v1[1]); w.w = pg8::cvt_pk_bf16(v1[2], v1[3]);
                    *(pg8::u32x4*)(rb + bj * 256 + loff) = w;
                }
                asm volatile("" ::: "memory");
            }
    }
};

namespace att {
constexpr int KP = 272, VP = 320;
constexpr int KT_B = 64 * KP, VT_B = 64 * VP;
constexpr int OFF_K = 0, OFF_V = 2 * KT_B, OFF_CUM = 2 * KT_B + 2 * VT_B  , OFF_TBL = OFF_CUM + 1024, OFF_END = OFF_TBL + 2 * 640 * 4;
static_assert(OFF_END <= 131072 && 65536 <= OFF_CUM, "attention LDS map");
struct Job {
    const bf16_t* q;
    const float* kc; const float* vc; int cpitch; int nc;
    const bf16_t* kz; const bf16_t* vz;
    int kt_lo, kt_hi, qpos0, kpos0, nq_sub;
    const float* cum; int cum_hs;
    const float* tbl;
    bf16_t* o;
    float slope2; const float* subg;
};
#define MFMA32(a, b, c) __builtin_amdgcn_mfma_f32_32x32x16_bf16((a), (b), (c), 0, 0, 0)
DI u32x4 pack8(const f32x4 a, const f32x4 b) { u32x4 r; r.x = pk2(a[0], a[1]); r.y = pk2(a[2], a[3]); r.z = pk2(b[0], b[1]); r.w = pk2(b[2], b[3]); return r; }
DI s16x4 vtr(const LAS unsigned char* p) { typedef short v4 __attribute__((ext_vector_type(4))); return __builtin_bit_cast(s16x4, __builtin_amdgcn_ds_read_tr16_b64_v4i16((LAS v4*)p)); }

DI void load_tile(const Job& J, int kt, int srow, int sch, u32x4& r0, u32x4& r1, u32x4& r2, u32x4& r3) {
    if (kt >= J.nc) {
        const size_t o0 = (size_t)((kt - J.nc) * 64 + srow) * ZP + sch * 8, o1 = o0 + (size_t)32 * ZP;
        r0 = *(const u32x4*)(J.kz + o0); r1 = *(const u32x4*)(J.kz + o1); r2 = *(const u32x4*)(J.vz + o0); r3 = *(const u32x4*)(J.vz + o1);
    }
}
DI void store_tile(const Job& J, int kt, int buf, int srow, int sch, u32x4& r0, u32x4& r1, u32x4& r2, u32x4& r3, LAS unsigned char* lds) {
    if (kt < J.nc) {
        const size_t o0 = (size_t)(kt * 64 + srow) * J.cpitch + sch * 8, o1 = o0 + (size_t)32 * J.cpitch;
        r0 = pack8(*(const f32x4*)(J.kc + o0), *(const f32x4*)(J.kc + o0 + 4)); r1 = pack8(*(const f32x4*)(J.kc + o1), *(const f32x4*)(J.kc + o1 + 4));
        r2 = pack8(*(const f32x4*)(J.vc + o0), *(const f32x4*)(J.vc + o0 + 4)); r3 = pack8(*(const f32x4*)(J.vc + o1), *(const f32x4*)(J.vc + o1 + 4));
    }
    LAS unsigned char* kb = lds + OFF_K + buf * KT_B + srow * KP + sch * 16; LAS unsigned char* vb = lds + OFF_V + buf * VT_B + srow * VP + sch * 16;
    *(LAS u32x4*)kb = r0; *(LAS u32x4*)(kb + 32 * KP) = r1; *(LAS u32x4*)vb = r2; *(LAS u32x4*)(vb + 32 * VP) = r3;
}

template <int MODE> DI Job make_job(int s_) {
    const int s = launder(s_);
    ArgsP a = fresh_args(); Job J{};
    const bf16_t* z = (const bf16_t*)(a->ws + WS_Z); bf16_t* attb = (bf16_t*)(a->ws + WS_ATT);
    if (MODE < 2) {
        const int qcol = MODE == 0 ? 0 : 1536, kcol = MODE == 0 ? 512 : 2048, vcol = MODE == 0 ? 1024 : 2560, ocol = MODE == 0 ? 0 : 512;
        if (s < 512) {
            const int j = s & 255, u = (s >> 8) ? (j >> 4) : 31 - (j >> 4), bh = j & 15, b = bh >> 2, hh = bh & 3;
            const size_t row0 = (size_t)b * SEQ + 128 * u, rb = (size_t)b * SEQ;
            J.nc = 0; J.kt_lo = 0; J.kt_hi = 2 * u + 1; J.qpos0 = 128 * u; J.kpos0 = 0; J.nq_sub = 4;
            J.q = z + row0 * ZP + qcol + hh * 128; J.kz = z + rb * ZP + kcol + hh * 128; J.vz = z + rb * ZP + vcol + hh * 128; J.o = attb + row0 * DM + ocol + hh * 128;
            J.slope2 = exp2f(-2.f * (float)(hh + 1)) * LOG2E;
            J.cum = (const float*)(a->ws + WS_CUMP) + (size_t)(b * 8 + 2 * hh) * 4096; J.cum_hs = 4096;
        } else {
            const int jj = s - 512, b = jj >> 2, hh = jj & 3; const size_t row0 = (size_t)MP + b * DSEQ;
            J.nc = 16; J.cpitch = 512; J.kt_lo = 0; J.kt_hi = 16; J.qpos0 = PAST; J.kpos0 = 0; J.nq_sub = 2;
            J.q = z + row0 * ZP + qcol + hh * 128; J.kz = z + row0 * ZP + kcol + hh * 128; J.vz = z + row0 * ZP + vcol + hh * 128; J.o = attb + row0 * DM + ocol + hh * 128;
            J.kc = a->in[MODE == 0 ? I_CAK : I_CBK] + (size_t)b * PAST * 512 + hh * 128; J.vc = a->in[MODE == 0 ? I_CAV : I_CBV] + (size_t)b * PAST * 512 + hh * 128;
            J.slope2 = exp2f(-2.f * (float)(hh + 1)) * LOG2E;
            J.cum = (const float*)(a->ws + WS_CUMS) + (size_t)(b * 8 + 2 * hh) * 1088; J.cum_hs = 1088;
        }
        J.subg = a->in[I_SUBG];
    } else {
        if (s < 1024) {
            const int bh = s & 31, b = bh >> 3, hp = bh & 7, u = s >> 5; const size_t row0 = (size_t)b * SEQ + 128 * u, rb = (size_t)b * SEQ;
            J.q = z + row0 * ZP + hp * 128; J.kz = z + rb * ZP + 1024 + hp * 128; J.vz = z + rb * ZP + 2048 + hp * 128; J.o = attb + row0 * DM + hp * 128;
            J.nc = 0; J.kt_lo = 2 * u - 8 > 0 ? 2 * u - 8 : 0; J.kt_hi = 2 * u + 1; J.qpos0 = 128 * u; J.kpos0 = 0; J.nq_sub = 4; J.tbl = a->in[I_REL] + (size_t)(2 * hp) * 513;
        } else {
            const int id = s - 1024, b = id >> 3, hp = id & 7; const size_t row0 = (size_t)MP + b * DSEQ;
            J.q = z + row0 * ZP + hp * 128; J.kz = z + row0 * ZP + 1024 + hp * 128; J.vz = z + row0 * ZP + 2048 + hp * 128; J.o = attb + row0 * DM + hp * 128;
            J.kc = a->in[I_CCK] + (size_t)b * 512 * 1024 + hp * 128; J.vc = a->in[I_CCV] + (size_t)b * 512 * 1024 + hp * 128; J.cpitch = 1024; J.nc = 8;
            J.kt_lo = 0; J.kt_hi = 8; J.qpos0 = PAST; J.kpos0 = 512; J.nq_sub = 2; J.tbl = a->in[I_REL] + (size_t)(2 * hp) * 513;
        }
    }
    return J;
}

template <int MODE>
DI void attn_unit(LAS unsigned char* lds, const int slot) {
    constexpr int NDB = (MODE == 0) ? 4 : 2;
    int tid_l = threadIdx.x; asm volatile("" : "+v"(tid_l));
    const int tid = tid_l, lane = tid & 63, wid = __builtin_amdgcn_readfirstlane(tid >> 6);
    const int qs = wid >> 1, half = wid & 1, r32 = lane & 31, hi = lane >> 5;
    const int srow = tid >> 4, sch = tid & 15;
    const int qin = (32 * qs + r32) & 63;
    bool active; int qc_w, kc0, kt, nt, qk0;
    bf16x8 qr[4];
    u32x4 r0 = {0u, 0u, 0u, 0u}, r1 = r0, r2 = r0, r3 = r0, n0 = r0, n1 = r0, n2 = r0, n3 = r0; float cumv = 0.f, cumn = 0.f;
    __syncthreads();
    Job J = make_job<MODE>(slot);
    const float slope2 = J.slope2;
    {
        active = qs < J.nq_sub; qc_w = (J.qpos0 + 32 * qs) >> 6; kc0 = J.kpos0 >> 6; kt = J.kt_lo; nt = J.kt_hi - J.kt_lo + 1; qk0 = J.qpos0 - J.kpos0;
        if (MODE == 2) {
            for (int e = tid; e < 1280; e += NTHR) { const int hs = e >= 640 ? 1 : 0, idx = e - hs * 640, rel = idx - 63, c = (rel > 256 ? 256 : rel) + 256;
                ((LAS float*)(lds + OFF_TBL))[e] = J.tbl[hs * 513 + c] * LOG2E; }
        }
        const bf16_t* qp = J.q + (size_t)((active ? 32 * qs : 0) + r32) * ZP + half * 64 + 8 * hi;
#pragma unroll
        for (int d0 = 0; d0 < 4; ++d0) qr[d0] = *(const bf16x8*)(qp + 16 * d0);
        load_tile(J, kt, srow, sch, r0, r1, r2, r3);
        if (MODE == 1 && tid < 128) cumv = J.cum[(size_t)(tid >> 6) * J.cum_hs + kt * 64 + (tid & 63)];
        store_tile(J, kt, 0, srow, sch, r0, r1, r2, r3, lds);
        if (MODE == 1 && tid < 128) ((LAS float*)(lds + OFF_CUM))[tid] = cumv;
        if (nt > 1) { load_tile(J, kt + 1, srow, sch, r0, r1, r2, r3); if (MODE == 1 && tid < 128) cumv = J.cum[(size_t)(tid >> 6) * J.cum_hs + (kt + 1) * 64 + (tid & 63)]; }
    }
    f32x16 o[NDB];
#pragma unroll
    for (int d = 0; d < NDB; ++d)
#pragma unroll
        for (int i = 0; i < 16; ++i) o[d][i] = 0.f;
    float m_ref = 0.f, l_run = 0.f; bool first = true;
    __syncthreads();
    const int b16 = (lane >> 4) & 1, q4 = (lane & 15) >> 2, p4 = lane & 3;
    const int vcol0 = (MODE == 0) ? 0 : 64 * half;
    for (int it = 0; it < nt; ++kt) {
        {
        const int buf = it & 1; const bool more = it + 1 < nt;
        {
            if (it + 2 < nt) { load_tile(J, kt + 2, srow, sch, n0, n1, n2, n3); if (MODE == 1 && tid < 128) cumn = J.cum[(size_t)(tid >> 6) * J.cum_hs + (kt + 2) * 64 + (tid & 63)]; }
        }
        const int kc = kc0 + kt;
        const bool vis = active && kc <= qc_w && (MODE != 2 || kc >= qc_w - 8);
        if (vis) {
            const LAS unsigned char* Kb = lds + OFF_K + buf * KT_B + r32 * KP + half * 128 + hi * 16;
            const int qk = qk0 + 32 * qs + r32 - kt * 64 - 4 * hi;
            bf16x8 kf[8];
#pragma unroll
            for (int d0 = 0; d0 < 4; ++d0) { kf[2 * d0] = *(const LAS bf16x8*)(Kb + d0 * 32); kf[2 * d0 + 1] = *(const LAS bf16x8*)(Kb + 32 * KP + d0 * 32); }
            f32x16 p0, p1;
            if (MODE == 0) {
                if (kc < qc_w) {
                    const float base = fmaf(-slope2, (float)qk, -m_ref);
#pragma unroll
                    for (int i = 0; i < 16; ++i) { const float ci = (float)((i & 3) + 8 * (i >> 2)); p0[i] = fmaf(slope2, ci, base); p1[i] = fmaf(slope2, ci + 32.f, base); }
                } else {
                    const float qrel = (float)qk, nm = -m_ref;
#pragma unroll
                    for (int i = 0; i < 16; ++i) { const float ci = (float)((i & 3) + 8 * (i >> 2)); p0[i] = fmaf(-slope2, fabsf(qrel - ci), nm); p1[i] = fmaf(-slope2, fabsf(qrel - 32.f - ci), nm); }
                }
            } else if (MODE == 1) {
                const LAS float* ct = (const LAS float*)(lds + OFF_CUM) + buf * 128 + half * 64 + 4 * hi; const float nm = -m_ref;
#pragma unroll
                for (int g = 0; g < 4; ++g) { const f32x4 c0 = *(const LAS f32x4*)(ct + 8 * g), c1 = *(const LAS f32x4*)(ct + 32 + 8 * g);
#pragma unroll
                    for (int e = 0; e < 4; ++e) { p0[4 * g + e] = nm - c0[e]; p1[4 * g + e] = nm - c1[e]; } }
            } else {
                const LAS float* tb = (const LAS float*)(lds + OFF_TBL) + half * 640 + (qk + 63 - 59);
#pragma unroll
                for (int i = 0; i < 16; ++i) { const int ci = (i & 3) + 8 * (i >> 2); p0[i] = tb[59 - ci] - m_ref; p1[i] = tb[59 - 32 - ci] - m_ref; }
            }
            __builtin_amdgcn_sched_barrier(0);
#pragma unroll
            for (int d0 = 0; d0 < 4; ++d0) { p0 = MFMA32(kf[2 * d0], qr[d0], p0); p1 = MFMA32(kf[2 * d0 + 1], qr[d0], p1); }
            const LAS unsigned char* Vb = lds + OFF_V + buf * VT_B + (4 * hi + q4) * VP + (vcol0 + 16 * b16 + 4 * p4) * 2;
            s16x4 vr[2][NDB][2];
#pragma unroll
            for (int d = 0; d < NDB; ++d) { vr[0][d][0] = vtr(Vb + d * 64); vr[0][d][1] = vtr(Vb + d * 64 + 8 * VP); }
            __builtin_amdgcn_sched_barrier(0);
            if (MODE == 1 && kc == qc_w) {
#pragma unroll
                for (int i = 0; i < 16; ++i) { const int kin = (i & 3) + 8 * (i >> 2) + 4 * hi; if (kin > qin) p0[i] = -INFINITY; if (kin + 32 > qin) p1[i] = -INFINITY; }
            }
            float mx = fmaxf(fmaxf(p0[0], p1[0]), p0[1]);
#pragma unroll
            for (int i = 2; i < 16; i += 2) mx = fmaxf(fmaxf(mx, p0[i]), p0[i + 1]);
#pragma unroll
            for (int i = 1; i < 16; i += 2) mx = fmaxf(fmaxf(mx, p1[i]), p1[i + 1 < 16 ? i + 1 : i]);
            { auto rr = __builtin_amdgcn_permlane32_swap(__float_as_uint(mx), __float_as_uint(mx), false, false); mx = fmaxf(__uint_as_float(rr[0]), __uint_as_float(rr[1])); }
            if (first || __any(mx > 8.f)) {
                const float dl = first ? mx : fmaxf(mx, 0.f), f = first ? 1.f : __builtin_amdgcn_exp2f(-dl);
                m_ref += dl; l_run *= f;
#pragma unroll
                for (int i = 0; i < 16; ++i) { p0[i] -= dl; p1[i] -= dl; }
#pragma unroll
                for (int d = 0; d < NDB; ++d)
#pragma unroll
                    for (int i = 0; i < 16; ++i) o[d][i] *= f;
                first = false;
            }
            float ls = 0.f;
#pragma unroll
            for (int i = 0; i < 16; ++i) { p0[i] = __builtin_amdgcn_exp2f(p0[i]); p1[i] = __builtin_amdgcn_exp2f(p1[i]); ls += p0[i] + p1[i]; }
            l_run += ls;
            bf16x8 pf[4];
            { u32x4 t;
              t.x = pk2(p0[0], p0[1]); t.y = pk2(p0[2], p0[3]); t.z = pk2(p0[4], p0[5]); t.w = pk2(p0[6], p0[7]); pf[0] = __builtin_bit_cast(bf16x8, t);
              t.x = pk2(p0[8], p0[9]); t.y = pk2(p0[10], p0[11]); t.z = pk2(p0[12], p0[13]); t.w = pk2(p0[14], p0[15]); pf[1] = __builtin_bit_cast(bf16x8, t);
              t.x = pk2(p1[0], p1[1]); t.y = pk2(p1[2], p1[3]); t.z = pk2(p1[4], p1[5]); t.w = pk2(p1[6], p1[7]); pf[2] = __builtin_bit_cast(bf16x8, t);
              t.x = pk2(p1[8], p1[9]); t.y = pk2(p1[10], p1[11]); t.z = pk2(p1[12], p1[13]); t.w = pk2(p1[14], p1[15]); pf[3] = __builtin_bit_cast(bf16x8, t); }
#pragma unroll
            for (int ks = 0; ks < 4; ++ks) {
                if (ks < 3) {
#pragma unroll
                    for (int d = 0; d < NDB; ++d) { const LAS unsigned char* a = Vb + (16 * (ks + 1)) * VP + d * 64; vr[(ks + 1) & 1][d][0] = vtr(a); vr[(ks + 1) & 1][d][1] = vtr(a + 8 * VP); }
                }
                __builtin_amdgcn_sched_barrier(0);
#pragma unroll
                for (int d = 0; d < NDB; ++d) {
                    const bf16x8 vf = __builtin_shufflevector(vr[ks & 1][d][0], vr[ks & 1][d][1], 0, 1, 2, 3, 4, 5, 6, 7);
                    o[d] = MFMA32(vf, pf[ks], o[d]);
                }
                __builtin_amdgcn_sched_barrier(0);
            }
        }
        if (more) {
            store_tile(J, kt + 1, buf ^ 1, srow, sch, r0, r1, r2, r3, lds); if (MODE == 1 && tid < 128) ((LAS float*)(lds + OFF_CUM))[(buf ^ 1) * 128 + tid] = cumv;
        }
        __syncthreads();
        }
        ++it; ++kt;
        if (it >= nt) break;
        {
        const int buf = it & 1; const bool more = it + 1 < nt;
        {
            if (it + 2 < nt) { load_tile(J, kt + 2, srow, sch, r0, r1, r2, r3); if (MODE == 1 && tid < 128) cumv = J.cum[(size_t)(tid >> 6) * J.cum_hs + (kt + 2) * 64 + (tid & 63)]; }
        }
        const int kc = kc0 + kt;
        const bool vis = active && kc <= qc_w && (MODE != 2 || kc >= qc_w - 8);
        if (vis) {
            const LAS unsigned char* Kb = lds + OFF_K + buf * KT_B + r32 * KP + half * 128 + hi * 16;
            const int qk = qk0 + 32 * qs + r32 - kt * 64 - 4 * hi;
            bf16x8 kf[8];
#pragma unroll
            for (int d0 = 0; d0 < 4; ++d0) { kf[2 * d0] = *(const LAS bf16x8*)(Kb + d0 * 32); kf[2 * d0 + 1] = *(const LAS bf16x8*)(Kb + 32 * KP + d0 * 32); }
            f32x16 p0, p1;
            if (MODE == 0) {
                if (kc < qc_w) {
                    const float base = fmaf(-slope2, (float)qk, -m_ref);
#pragma unroll
                    for (int i = 0; i < 16; ++i) { const float ci = (float)((i & 3) + 8 * (i >> 2)); p0[i] = fmaf(slope2, ci, base); p1[i] = fmaf(slope2, ci + 32.f, base); }
                } else {
                    const float qrel = (float)qk, nm = -m_ref;
#pragma unroll
                    for (int i = 0; i < 16; ++i) { const float ci = (float)((i & 3) + 8 * (i >> 2)); p0[i] = fmaf(-slope2, fabsf(qrel - ci), nm); p1[i] = fmaf(-slope2, fabsf(qrel - 32.f - ci), nm); }
                }
            } else if (MODE == 1) {
                const LAS float* ct = (const LAS float*)(lds + OFF_CUM) + buf * 128 + half * 64 + 4 * hi; const float nm = -m_ref;
#pragma unroll
                for (int g = 0; g < 4; ++g) { const f32x4 c0 = *(const LAS f32x4*)(ct + 8 * g), c1 = *(const LAS f32x4*)(ct + 32 + 8 * g);
#pragma unroll
                    for (int e = 0; e < 4; ++e) { p0[4 * g + e] = nm - c0[e]; p1[4 * g + e] = nm - c1[e]; } }
            } else {
                const LAS float* tb = (const LAS float*)(lds + OFF_TBL) + half * 640 + (qk + 63 - 59);
#pragma unroll
                for (int i = 0; i < 16; ++i) { const int ci = (i & 3) + 8 * (i >> 2); p0[i] = tb[59 - ci] - m_ref; p1[i] = tb[59 - 32 - ci] - m_ref; }
            }
            __builtin_amdgcn_sched_barrier(0);
#pragma unroll
            for (int d0 = 0; d0 < 4; ++d0) { p0 = MFMA32(kf[2 * d0], qr[d0], p0); p1 = MFMA32(kf[2 * d0 + 1], qr[d0], p1); }
            const LAS unsigned char* Vb = lds + OFF_V + buf * VT_B + (4 * hi + q4) * VP + (vcol0 + 16 * b16 + 4 * p4) * 2;
            s16x4 vr[2][NDB][2];
#pragma unroll
            for (int d = 0; d < NDB; ++d) { vr[0][d][0] = vtr(Vb + d * 64); vr[0][d][1] = vtr(Vb + d * 64 + 8 * VP); }
            __builtin_amdgcn_sched_barrier(0);
            if (MODE == 1 && kc == qc_w) {
#pragma unroll
                for (int i = 0; i < 16; ++i) { const int kin = (i & 3) + 8 * (i >> 2) + 4 * hi; if (kin > qin) p0[i] = -INFINITY; if (kin + 32 > qin) p1[i] = -INFINITY; }
            }
            float mx = fmaxf(fmaxf(p0[0], p1[0]), p0[1]);
#pragma unroll
            for (int i = 2; i < 16; i += 2) mx = fmaxf(fmaxf(mx, p0[i]), p0[i + 1]);
#pragma unroll
            for (int i = 1; i < 16; i += 2) mx = fmaxf(fmaxf(mx, p1[i]), p1[i + 1 < 16 ? i + 1 : i]);
            { auto rr = __builtin_amdgcn_permlane32_swap(__float_as_uint(mx), __float_as_uint(mx), false, false); mx = fmaxf(__uint_as_float(rr[0]), __uint_as_float(rr[1])); }
            if (first || __any(mx > 8.f)) {
                const float dl = first ? mx : fmaxf(mx, 0.f), f = first ? 1.f : __builtin_amdgcn_exp2f(-dl);
                m_ref += dl; l_run *= f;
#pragma unroll
                for (int i = 0; i < 16; ++i) { p0[i] -= dl; p1[i] -= dl; }
#pragma unroll
                for (int d = 0; d < NDB; ++d)
#pragma unroll
                    for (int i = 0; i < 16; ++i) o[d][i] *= f;
                first = false;
            }
            float ls = 0.f;
#pragma unroll
            for (int i = 0; i < 16; ++i) { p0[i] = __builtin_amdgcn_exp2f(p0[i]); p1[i] = __builtin_amdgcn_exp2f(p1[i]); ls += p0[i] + p1[i]; }
            l_run += ls;
            bf16x8 pf[4];
            { u32x4 t;
              t.x = pk2(p0[0], p0[1]); t.y = pk2(p0[2], p0[3]); t.z = pk2(p0[4], p0[5]); t.w = pk2(p0[6], p0[7]); pf[0] = __builtin_bit_cast(bf16x8, t);
              t.x = pk2(p0[8], p0[9]); t.y = pk2(p0[10], p0[11]); t.z = pk2(p0[12], p0[13]); t.w = pk2(p0[14], p0[15]); pf[1] = __builtin_bit_cast(bf16x8, t);
              t.x = pk2(p1[0], p1[1]); t.y = pk2(p1[2], p1[3]); t.z = pk2(p1[4], p1[5]); t.w = pk2(p1[6], p1[7]); pf[2] = __builtin_bit_cast(bf16x8, t);
              t.x = pk2(p1[8], p1[9]); t.y = pk2(p1[10], p1[11]); t.z = pk2(p1[12], p1[13]); t.w = pk2(p1[14], p1[15]); pf[3] = __builtin_bit_cast(bf16x8, t); }
#pragma unroll
            for (int ks = 0; ks < 4; ++ks) {
                if (ks < 3) {
#pragma unroll
                    for (int d = 0; d < NDB; ++d) { const LAS unsigned char* a = Vb + (16 * (ks + 1)) * VP + d * 64; vr[(ks + 1) & 1][d][0] = vtr(a); vr[(ks + 1) & 1][d][1] = vtr(a + 8 * VP); }
                }
                __builtin_amdgcn_sched_barrier(0);
#pragma unroll
                for (int d = 0; d < NDB; ++d) {
                    const bf16x8 vf = __builtin_shufflevector(vr[ks & 1][d][0], vr[ks & 1][d][1], 0, 1, 2, 3, 4, 5, 6, 7);
                    o[d] = MFMA32(vf, pf[ks], o[d]);
                }
                __builtin_amdgcn_sched_barrier(0);
            }
        }
        if (more) {
            store_tile(J, kt + 1, buf ^ 1, srow, sch, n0, n1, n2, n3, lds); if (MODE == 1 && tid < 128) ((LAS float*)(lds + OFF_CUM))[(buf ^ 1) * 128 + tid] = cumn;
        }
        __syncthreads();
        }
        ++it;
    }
    const float l_tot = l_run + __shfl_xor(l_run, 32);
    const float inv = active ? 1.f / l_tot : 0.f;
    if (MODE != 0) {
        if (active) {
            const Job J = make_job<MODE>(slot);
            bf16_t* op = J.o + (size_t)(32 * qs + r32) * DM + half * 64 + 4 * hi;
#pragma unroll
            for (int d = 0; d < NDB; ++d)
#pragma unroll
                for (int g = 0; g < 4; ++g) { u32x2 w; w.x = pk2(o[d][4 * g] * inv, o[d][4 * g + 1] * inv); w.y = pk2(o[d][4 * g + 2] * inv, o[d][4 * g + 3] * inv);
                    *(u32x2*)(op + 32 * d + 8 * g) = w; }
        }
    } else {
        LAS float* ex = (LAS float*)lds + qs * 4096 + lane;
        if (active && half == 1) {
#pragma unroll
            for (int d = 0; d < NDB; ++d)
#pragma unroll
                for (int i = 0; i < 16; ++i) ex[(d * 16 + i) * 64] = o[d][i] * inv;
        }
        __syncthreads();
        if (active && half == 0) {
            const Job J = make_job<MODE>(slot);
            ArgsP a = fresh_args();
            const float lam = expf(wave_sum(a->in[I_LQ1][lane] * a->in[I_LK1][lane])) - expf(wave_sum(a->in[I_LQ2][lane] * a->in[I_LK2][lane])) + 0.2f;
            float ss = 0.f;
#pragma unroll
            for (int d = 0; d < NDB; ++d)
#pragma unroll
                for (int i = 0; i < 16; ++i) { const float v = o[d][i] * inv - lam * ex[(d * 16 + i) * 64]; o[d][i] = v; ss += v * v; }
            ss += __shfl_xor(ss, 32);
            const float rs = rsqrtf(ss * (1.f / 128.f) + EPS) * 0.8f;
            bf16_t* op = J.o + (size_t)(32 * qs + r32) * DM + 4 * hi;
#pragma unroll
            for (int d = 0; d < NDB; ++d)
#pragma unroll
                for (int g = 0; g < 4; ++g) { const f32x4 gg = *(const f32x4*)(J.subg + 32 * d + 8 * g + 4 * hi);
                    u32x2 w; w.x = pk2(o[d][4 * g] * rs * gg[0], o[d][4 * g + 1] * rs * gg[1]); w.y = pk2(o[d][4 * g + 2] * rs * gg[2], o[d][4 * g + 3] * rs * gg[3]);
                    *(u32x2*)(op + 32 * d + 8 * g) = w; }
        }
    }
}
}

#define LDS_WAIT() asm volatile("s_waitcnt lgkmcnt(0)" ::: "memory")
DI void transpose_item(const float* W, int ldw, int K, int nblk, bf16_t* WT, LAS float* scr, int item, int lane) {
    const int kb = item / nblk, nb = item - kb * nblk, k0 = 64 * kb, n0 = 32 * nb;
#pragma unroll 8
    for (int i = 0; i < 32; ++i) { const int kk = 2 * i + (lane >> 5); scr[kk * 33 + (lane & 31)] = W[(size_t)(k0 + kk) * ldw + n0 + (lane & 31)]; }
    LDS_WAIT();
    const int c = lane & 7;
#pragma unroll
    for (int j = 0; j < 4; ++j) { const int n = (lane >> 3) + 8 * j; const LAS float* s = scr + (8 * c) * 33 + n;
        u32x4 o; o.x = pk2(s[0 * 33], s[1 * 33]); o.y = pk2(s[2 * 33], s[3 * 33]); o.z = pk2(s[4 * 33], s[5 * 33]); o.w = pk2(s[6 * 33], s[7 * 33]);
        *(u32x4*)(WT + (size_t)(n0 + n) * K + k0 + 8 * c) = o; }
    LDS_WAIT();
}
DI float log_sigmoid(float x) { return fminf(x, 0.f) - log1pf(expf(-fabsf(x))); }

DI void prologue_phase(LAS unsigned char* lds, ArgsP a, int tid, int lane, int wave) {
    unsigned char* ws = a->ws;
    const int gw = launder((int)blockIdx.x) * NWAVES + wave, NGW = launder((int)gridDim.x) * NWAVES;
    {
        LAS float* scr = (LAS float*)(lds + wave * 8448);
        constexpr int I_IN = 16 * 96, I_O = 16 * 32, I_UP = 16 * 128, I_DN = 64 * 32;
        constexpr int NITEMS = 2 * I_IN + 2 * I_O + 2 * I_UP + 2 * I_DN;
        for (int it = gw; it < NITEMS; it += NGW) {
            int r = it;
            if (r < I_IN) { transpose_item(a->in[I_WINE], 3080, 1024, 96, (bf16_t*)(ws + WS_WINE), scr, r, lane); continue; } r -= I_IN;
            if (r < I_IN) { transpose_item(a->in[I_WINO], 3072, 1024, 96, (bf16_t*)(ws + WS_WINO), scr, r, lane); continue; } r -= I_IN;
            if (r < I_O) { transpose_item(a->in[I_WOUTE], 1024, 1024, 32, (bf16_t*)(ws + WS_WOUTE), scr, r, lane); continue; } r -= I_O;
            if (r < I_O) { transpose_item(a->in[I_WOUTO], 1024, 1024, 32, (bf16_t*)(ws + WS_WOUTO), scr, r, lane); continue; } r -= I_O;
            if (r < 2 * I_UP) { const int l = r / I_UP; transpose_item(a->in[I_WUP] + (size_t)l * 1024 * 4096, 4096, 1024, 128, (bf16_t*)(ws + (l ? WS_WUP1 : WS_WUP0)), scr, r - l * I_UP, lane); continue; } r -= 2 * I_UP;
            { const int l = r / I_DN; transpose_item(a->in[I_WDN] + (size_t)l * 4096 * 1024, 1024, 4096, 32, (bf16_t*)(ws + (l ? WS_WDN1 : WS_WDN0)), scr, r - l * I_DN, lane); }
        }
    }
    {
        const size_t per_b = (size_t)448 * 1024 / 4, total = 2 * 8 * per_b;
        for (size_t i = (size_t)blockIdx.x * NTHR + tid; i < total; i += (size_t)gridDim.x * NTHR) {
            const int kv = (int)(i / (8 * per_b)); const size_t r = i - (size_t)kv * 8 * per_b; const int b = (int)(r / per_b); const size_t e = r - (size_t)b * per_b;
            const f32x4* src = (const f32x4*)(a->in[kv ? I_CCV : I_CCK] + (size_t)b * 512 * 1024 + 64 * 1024) + e;
            f32x4* dst = (f32x4*)(a->out + (kv ? O_SCV : O_SCK) + (size_t)b * 512 * 1024) + e;
            *dst = *src;
        }
    }
    LAS float* wf = (LAS float*)(lds + 98304);
    __syncthreads();
    for (int e = tid; e < 8192; e += NTHR) { const int k = e >> 3, o = e & 7; wf[o * 1024 + k] = a->in[I_WINE][(size_t)k * 3080 + 3072 + o]; }
    __syncthreads();
    const float* gp = a->in[I_GPM]; bf16_t* xn = (bf16_t*)(ws + WS_XN);
    f32x4 g[4];
#pragma unroll
    for (int j = 0; j < 4; ++j) g[j] = ((const f32x4*)gp)[lane + 64 * j];
    for (int m = gw; m < MT; m += NGW) {
        const float* xr = m < MP ? a->in[I_XP] + (size_t)m * DM : a->in[I_XS] + (size_t)(m - MP) * DM;
        f32x4 v[4]; float ss = 0.f;
#pragma unroll
        for (int j = 0; j < 4; ++j) { v[j] = ((const f32x4*)xr)[lane + 64 * j]; ss += (v[j].x * v[j].x + v[j].y * v[j].y) + (v[j].z * v[j].z + v[j].w * v[j].w); }
#pragma unroll
        for (int j = 0; j < 4; ++j) ((f32x4*)(a->out + (size_t)m * DM))[lane + 64 * j] = v[j];
        const float rstd = rsqrtf(wave_sum(ss) * (1.f / DM) + EPS);
#pragma unroll
        for (int j = 0; j < 4; ++j) { v[j] = v[j] * rstd * g[j]; u32x2 w; w.x = pk2(v[j].x, v[j].y); w.y = pk2(v[j].z, v[j].w); ((u32x2*)(xn + (size_t)m * DM))[lane + 64 * j] = w; }
        float mine = 0.f;
#pragma unroll
        for (int o = 0; o < 8; ++o) { float acc = 0.f;
#pragma unroll
            for (int j = 0; j < 4; ++j) { const f32x4 w = *(const LAS f32x4*)(wf + o * 1024 + 4 * (lane + 64 * j)); acc += (v[j].x * w.x + v[j].y * w.y) + (v[j].z * w.z + v[j].w * w.w); }
            acc = wave_sum(acc); if (lane == o) mine = acc; }
        if (lane < 8) { const float lf = log_sigmoid(mine + a->in[I_BF][lane]);
            if (m < MP) a->out[O_PBL + (size_t)m * 8 + lane] = lf; else a->out[O_SBL + (size_t)(m - MP) * 8 + lane] = lf; }
    }
}

DI void scan_seq(ArgsP a, int seq, int lane) {
    float* cump = (float*)(a->ws + WS_CUMP); float* cums = (float*)(a->ws + WS_CUMS);
    const bool smp = seq >= 32; const int s = smp ? seq - 32 : seq, b = s >> 3, h = s & 7, n = smp ? 17 : 64, i0 = lane * n;
    const float* src0 = smp ? a->in[I_CBL] + (size_t)b * 1024 * 8 + h : a->out + O_PBL + (size_t)b * 4096 * 8 + h;
    const float* src1 = a->out + O_SBL + (size_t)b * 64 * 8 + h;
    float* dst = smp ? cums + (size_t)(b * 8 + h) * 1088 : cump + (size_t)(b * 8 + h) * 4096;
    float tot = 0.f;
    for (int i = 0; i < n; ++i) { const int idx = i0 + i; tot += (smp && idx >= 1024) ? src1[(size_t)(idx - 1024) * 8] : src0[(size_t)idx * 8]; }
    float x = tot;
#pragma unroll
    for (int o = 1; o < 64; o <<= 1) { const float t = __shfl_up(x, o); if (lane >= o) x += t; }
    float run = x - tot;
    for (int i = 0; i < n; ++i) { const int idx = i0 + i; run += (smp && idx >= 1024) ? src1[(size_t)(idx - 1024) * 8] : src0[(size_t)idx * 8]; dst[idx] = run * LOG2E; }
}

constexpr int RW = 3;
DI void rows_phase(ArgsP a, const float* gpost, const float* gnext, const float* part, int nparts, int lane, int wave, float scl = 1.f) {
    const bf16_t* Y = (const bf16_t*)(a->ws + WS_Y); bf16_t* xn = (bf16_t*)(a->ws + WS_XN); float* X = a->out;
    const int gw = launder((int)blockIdx.x) * NWAVES + wave, NGW = launder((int)gridDim.x) * NWAVES;
    f32x4 gp[4], gn[4];
#pragma unroll
    for (int j = 0; j < 4; ++j) { gp[j] = ((const f32x4*)gpost)[lane + 64 * j]; gn[j] = gnext ? ((const f32x4*)gnext)[lane + 64 * j] : (f32x4){0.f, 0.f, 0.f, 0.f}; }
    for (int m0 = gw; m0 < MT; m0 += RW * NGW) {
        f32x4 y[RW][4], x[RW][4];
#pragma unroll
        for (int r = 0; r < RW; ++r) {
            const int m = m0 + r * NGW;
            if (m < MT) {
#pragma unroll
                for (int j = 0; j < 4; ++j) {
                    if (m < MP) { const u32x2 w = ((const u32x2*)(Y + (size_t)m * DM))[lane + 64 * j];
                        y[r][j].x = __uint_as_float(w.x << 16); y[r][j].y = __uint_as_float(w.x & 0xffff0000u); y[r][j].z = __uint_as_float(w.y << 16); y[r][j].w = __uint_as_float(w.y & 0xffff0000u); }
                    else { y[r][j] = ((const f32x4*)(part + (size_t)(m - MP) * DM))[lane + 64 * j];
                        for (int p = 1; p < nparts; ++p) y[r][j] = y[r][j] + ((const f32x4*)(part + ((size_t)p * MS + (m - MP)) * DM))[lane + 64 * j]; }
                    x[r][j] = ((const f32x4*)(X + (size_t)m * DM))[lane + 64 * j];
                }
            }
        }
#pragma unroll
        for (int r = 0; r < RW; ++r) {
            const int m = m0 + r * NGW;
            if (m < MT) {
                float ss = 0.f;
#pragma unroll
                for (int j = 0; j < 4; ++j) ss += (y[r][j].x * y[r][j].x + y[r][j].y * y[r][j].y) + (y[r][j].z * y[r][j].z + y[r][j].w * y[r][j].w);
                const float rstd = rsqrtf(wave_sum(ss) * (1.f / DM) + EPS);
                float s2 = 0.f;
#pragma unroll
                for (int j = 0; j < 4; ++j) { x[r][j] = x[r][j] + y[r][j] * (rstd * scl) * gp[j];
                    ((f32x4*)(X + (size_t)m * DM))[lane + 64 * j] = x[r][j]; s2 += (x[r][j].x * x[r][j].x + x[r][j].y * x[r][j].y) + (x[r][j].z * x[r][j].z + x[r][j].w * x[r][j].w); }
                if (gnext) {
                    const float r2 = rsqrtf(wave_sum(s2) * (1.f / DM) + EPS);
#pragma unroll
                    for (int j = 0; j < 4; ++j) { const f32x4 h = x[r][j] * r2 * gn[j];
                        u32x2 w; w.x = pk2(h.x, h.y); w.y = pk2(h.z, h.w); ((u32x2*)(xn + (size_t)m * DM))[lane + 64 * j] = w; }
                }
            }
        }
    }
}

DI void sgemm_sample(const bf16_t* A, int K, const bf16_t* Wt, float* P, int gw, int NGW, int lane) {
    const int r32 = lane & 31, hi = lane >> 5, nks = K >> 9, nunits = 16 * 16 * nks;
    for (int u = gw; u < nunits; u += NGW) {
        const int ks = u % nks, t = u / nks, cb = t & 15, rb = t >> 4;
        const bf16_t* ap = A + (size_t)(rb * 32 + r32) * K + ks * 512 + 8 * hi;
        const bf16_t* bp0 = Wt + (size_t)(cb * 64 + r32) * K + ks * 512 + 8 * hi; const bf16_t* bp1 = bp0 + (size_t)32 * K;
        f32x16 c0, c1;
#pragma unroll
        for (int i = 0; i < 16; ++i) { c0[i] = 0.f; c1[i] = 0.f; }
        bf16x8 a[4], b0[4], b1[4];
#pragma unroll
        for (int j = 0; j < 4; ++j) { a[j] = *(const bf16x8*)(ap + 16 * j); b0[j] = *(const bf16x8*)(bp0 + 16 * j); b1[j] = *(const bf16x8*)(bp1 + 16 * j); }
#pragma unroll
        for (int g = 0; g < 8; ++g) {
            bf16x8 na[4], nb0[4], nb1[4];
            if (g < 7) {
#pragma unroll
                for (int j = 0; j < 4; ++j) { na[j] = *(const bf16x8*)(ap + 64 * (g + 1) + 16 * j); nb0[j] = *(const bf16x8*)(bp0 + 64 * (g + 1) + 16 * j); nb1[j] = *(const bf16x8*)(bp1 + 64 * (g + 1) + 16 * j); }
            }
#pragma unroll
            for (int j = 0; j < 4; ++j) { c0 = __builtin_amdgcn_mfma_f32_32x32x16_bf16(a[j], b0[j], c0, 0, 0, 0); c1 = __builtin_amdgcn_mfma_f32_32x32x16_bf16(a[j], b1[j], c1, 0, 0, 0); }
            if (g < 7) {
#pragma unroll
                for (int j = 0; j < 4; ++j) { a[j] = na[j]; b0[j] = nb0[j]; b1[j] = nb1[j]; }
            }
        }
        float* pp = P + ((size_t)ks * MS + rb * 32 + 4 * hi) * DM + cb * 64 + r32;
#pragma unroll
        for (int i = 0; i < 16; ++i) { const int row = (i & 3) + 8 * (i >> 2); pp[(size_t)row * DM] = c0[i]; pp[(size_t)row * DM + 32] = c1[i]; }
    }
}

DI void attn_even_phase(LAS unsigned char* lds) {
    const int bx = launder((int)blockIdx.x), G = launder((int)gridDim.x);
#ifndef T_NO_M0
    for (int s = bx; s < 544; s += G) att::attn_unit<0>(lds, s);
#endif
    for (int i = 0;; ++i) {
        int s = i * G + bx;
        if (G == 256 && i == 2) s = (bx >= 32 && bx < 64) ? 512 + bx - 32 : 544;
        if (s >= 544) break;
#ifndef T_NO_M1
        att::attn_unit<1>(lds, s);
#endif
    }
}
DI void attn_odd_phase(LAS unsigned char* lds) {
    const int bx = launder((int)blockIdx.x), G = launder((int)gridDim.x);
    for (int s = bx; s < 1088; s += G) att::attn_unit<2>(lds, s);
}

typedef unsigned short bf16;
#define XB_TMO      128
#define XB_XCNT(j)  (256  + 64 * (j))
#define XB_XSUB(j)  (1280 + 64 * (j))
#define XB_XGEN(j)  (2304 + 64 * (j))
#define XB_TOP      3328
#define XB_TOPGEN   3392
#define XCD_BAR_WORDS 3456
#define XB_SPIN_CAP (1u << 18)

__device__ __forceinline__ unsigned xb_ld(unsigned* p)              { return __hip_atomic_load(p, __ATOMIC_RELAXED, __HIP_MEMORY_SCOPE_AGENT); }
__device__ __forceinline__ unsigned xb_add(unsigned* p, unsigned v) { return __hip_atomic_fetch_add(p, v, __ATOMIC_RELAXED, __HIP_MEMORY_SCOPE_AGENT); }
__device__ __forceinline__ unsigned xb_xcc_id() { return (unsigned)__builtin_amdgcn_s_getreg((3 << 11) | 20) & 0xFu; }
#define XB_SPIN(cond, bar) do { unsigned _sp = 0; while (cond) { __builtin_amdgcn_s_sleep(1); \
    if ((++_sp & 255u) == 0u) { if (xb_ld(&(bar)[XB_TMO])) break; if (_sp > XB_SPIN_CAP) { atomicAdd(&(bar)[XB_TMO], 1u); break; } } } } while (0)

struct XcdBarrier {
    unsigned* bar; unsigned x;
    volatile LAS unsigned* st;
};

__device__ __forceinline__ XcdBarrier xcd_barrier_post(unsigned* bar, volatile LAS unsigned* st) {
    XcdBarrier b; b.bar = bar; b.x = xb_xcc_id(); b.st = st;
    if (threadIdx.x == 0) (void)xb_add(&bar[XB_XCNT(b.x)], 1u);
    return b;
}
__device__ __forceinline__ void xcd_barrier_complete(unsigned* bar, unsigned x, unsigned& nloc, unsigned& nx) {
    const unsigned G = gridDim.x * gridDim.y * gridDim.z;
    unsigned sum, cnt, mine, sp = 0u;
    for (;;) {
        sum = 0u; cnt = 0u; mine = 0u;
#pragma unroll
        for (unsigned j = 0; j < 16; ++j) { const unsigned c = xb_ld(&bar[XB_XCNT(j)]); sum += c; cnt += (c > 0u) ? 1u : 0u; mine = (j == x) ? c : mine; }
        if (sum == G) break;
        __builtin_amdgcn_s_sleep(1);
        if ((++sp & 255u) == 0u) { if (xb_ld(&bar[XB_TMO])) break; if (sp > XB_SPIN_CAP) { atomicAdd(&bar[XB_TMO], 1u); break; } }
    }
    nloc = mine > 0u ? mine : 1u; nx = cnt > 0u ? cnt : 1u;
}

__device__ __forceinline__ void xcd_barrier(const XcdBarrier& b) {
    asm volatile("s_waitcnt vmcnt(0)" ::: "memory");
    __syncthreads();
    if (threadIdx.x == 0) {
        unsigned* bar = b.bar;
        __builtin_amdgcn_s_waitcnt(0);
        unsigned nloc = b.st[0], nx = b.st[1];
        if (nloc == 0u) { xcd_barrier_complete(bar, b.x, nloc, nx); b.st[0] = nloc; b.st[1] = nx; }
        const unsigned old = xb_add(&bar[XB_XSUB(b.x)], 1u);
        const unsigned gen = old / nloc;
        if (old + 1u == (gen + 1u) * nloc) {
            __builtin_amdgcn_fence(__ATOMIC_RELEASE, "agent");
            asm volatile("s_waitcnt vmcnt(0)" ::: "memory");
            const unsigned og = xb_add(&bar[XB_TOP], 1u);
            const unsigned tg = og / nx;
            if (og + 1u == (tg + 1u) * nx) xb_add(&bar[XB_TOPGEN], 1u);
            else XB_SPIN(xb_ld(&bar[XB_TOPGEN]) == tg, bar);
            __builtin_amdgcn_fence(__ATOMIC_ACQUIRE, "agent");
            xb_add(&bar[XB_XGEN(b.x)], 1u);
            asm volatile("s_waitcnt vmcnt(0)" ::: "memory");
        } else {
            XB_SPIN(xb_ld(&bar[XB_XGEN(b.x)]) == gen, bar);
            __builtin_amdgcn_fence(__ATOMIC_ACQUIRE, "agent");
            asm volatile("s_waitcnt vmcnt(0)" ::: "memory");
        }
    }
    __syncthreads();
}

template <int PH_LO, int PH_HI>
__global__ void __launch_bounds__(NTHR, 2) fwd_kernel(Args a_unused) {
    extern __shared__ __attribute__((aligned(16))) unsigned char lds_raw[];
    LAS unsigned char* lds = (LAS unsigned char*)lds_raw;
    cg::grid_group grid = cg::this_grid();
    constexpr bool ONE = (PH_HI - PH_LO) > 1;
    if (ONE) {
        { int t0 = threadIdx.x; if (t0 < 64) ((LAS unsigned*)(lds + 131072))[t0] = 0u; }
        __syncthreads();
        ArgsP a0 = fresh_args();
        (void)xcd_barrier_post((unsigned*)a0->ws, (volatile LAS unsigned*)(lds + 131072 + 32));
    }
#define IN(k) (PH_LO <= (k) && (k) < PH_HI)
#ifndef T_DUP
#define T_DUP (-1)
#endif
#define REPS(k) for (int rep_ = 0; rep_ < ((k) == T_DUP ? 2 : 1); ++rep_)
#define SEAM(k) do { if (IN(k) && IN((k) + 1)) { if ((k) == PH_LO) grid.sync(); else { ArgsP ab = fresh_args(); XcdBarrier bb; bb.bar = (unsigned*)ab->ws; bb.x = xb_xcc_id(); bb.st = (volatile LAS unsigned*)(lds + 131072 + 32); xcd_barrier(bb); } } } while (0)
#define PHASE_ARGS int tid = threadIdx.x; asm volatile("" : "+v"(tid)); const int lane = tid & 63, wave = __builtin_amdgcn_readfirstlane(tid >> 6); (void)lane; (void)wave; ArgsP a = fresh_args(); unsigned char* ws = a->ws; (void)ws; const int bx_ = launder((int)blockIdx.x), G_ = launder((int)gridDim.x); (void)bx_; (void)G_
    if (IN(0)) REPS(0) { PHASE_ARGS; prologue_phase(lds, a, tid, lane, wave); __syncthreads(); }
    SEAM(0);
#pragma unroll
    for (int l = 0; l < 2; ++l) {
        const int p = l * 7;
        if (IN(p + 1)) REPS(p + 1) {
            PHASE_ARGS;
            if (l == 0) {
                if (bx_ >= 64 && bx_ < 76) scan_seq(a, (bx_ - 64) * 8 + wave, lane);
                else if (G_ < 76 && bx_ == 0) { for (int q = wave; q < 96; q += NWAVES) scan_seq(a, q, lane); }
                __syncthreads();
                pg8::Gemm g{(const bf16_t*)(ws + WS_XN), (const bf16_t*)(ws + WS_WINE), MT, 3072, DM}; pg8::StaticOrder S; S.init(MT, 3072, G_, bx_);
                EpiX<2> E{(bf16_t*)(ws + WS_Z), ZP, a->out};
                pg8::gemm_phase<EpiX<2>, pg8::StaticOrder, true, true>(lds, g, S, E);
            } else {
                pg8::Gemm g{(const bf16_t*)(ws + WS_XN), (const bf16_t*)(ws + WS_WINO), MT, 3072, DM}; pg8::StaticOrder S; S.init(MT, 3072, G_, bx_);
                EpiX<3> E{(bf16_t*)(ws + WS_Z), ZP, a->out};
                pg8::gemm_phase<EpiX<3>, pg8::StaticOrder, true, true>(lds, g, S, E);
            }
        }
        SEAM(p + 1);
        if (IN(p + 2)) REPS(p + 2) {
#ifndef T_NO_EVEN
            if (l == 0) attn_even_phase(lds);
#endif
#ifndef T_NO_ODD
            if (l == 1) attn_odd_phase(lds);
#endif
            __syncthreads(); }
        SEAM(p + 2);
        if (IN(p + 3)) REPS(p + 3) {
            PHASE_ARGS;
            sgemm_sample((const bf16_t*)(ws + WS_ATT) + (size_t)MP * DM, DM, (const bf16_t*)(ws + (l == 0 ? WS_WOUTE : WS_WOUTO)), (float*)(ws + WS_PART_OUT), bx_ * NWAVES + wave, G_ * NWAVES, lane);
            __syncthreads();
            pg8::Gemm g{(const bf16_t*)(ws + WS_ATT), (const bf16_t*)(ws + (l == 0 ? WS_WOUTE : WS_WOUTO)), MP, DM, DM}; pg8::StaticOrder S; S.init(MP, DM, G_, bx_);
            EpiX<0> E{(bf16_t*)(ws + WS_Y), DM, nullptr};
            pg8::gemm_phase<EpiX<0>, pg8::StaticOrder, true, true>(lds, g, S, E);
        }
        SEAM(p + 3);
        if (IN(p + 4)) REPS(p + 4) { PHASE_ARGS; rows_phase(a, a->in[I_GQM] + l * DM, a->in[I_GPF] + l * DM, (const float*)(ws + WS_PART_OUT), 2, lane, wave, rep_ == 0 ? 1.f : 0.f); }
        SEAM(p + 4);
        if (IN(p + 5)) REPS(p + 5) {
            PHASE_ARGS;
            pg8::Gemm g{(const bf16_t*)(ws + WS_XN), (const bf16_t*)(ws + (l ? WS_WUP1 : WS_WUP0)), MT, FF, DM}; pg8::StaticOrder S; S.init(MT, FF, G_, bx_);
            EpiX<1> E{(bf16_t*)(ws + WS_H), FF, nullptr};
            pg8::gemm_phase<EpiX<1>, pg8::StaticOrder, true, true>(lds, g, S, E);
        }
        SEAM(p + 5);
        if (IN(p + 6)) REPS(p + 6) {
            PHASE_ARGS;
            sgemm_sample((const bf16_t*)(ws + WS_H) + (size_t)MP * FF, FF, (const bf16_t*)(ws + (l ? WS_WDN1 : WS_WDN0)), (float*)(ws + WS_PART_DN), bx_ * NWAVES + wave, G_ * NWAVES, lane);
            __syncthreads();
            pg8::Gemm g{(const bf16_t*)(ws + WS_H), (const bf16_t*)(ws + (l ? WS_WDN1 : WS_WDN0)), MP, DM, FF}; pg8::StaticOrder S; S.init(MP, DM, G_, bx_);
            EpiX<0> E{(bf16_t*)(ws + WS_Y), DM, nullptr};
            pg8::gemm_phase<EpiX<0>, pg8::StaticOrder, true, true>(lds, g, S, E);
        }
        SEAM(p + 6);
        if (IN(p + 7)) REPS(p + 7) { PHASE_ARGS; rows_phase(a, a->in[I_GQF] + l * DM, l == 0 ? a->in[I_GPM] + DM : nullptr, (const float*)(ws + WS_PART_DN), 8, lane, wave); }
        SEAM(p + 7);
    }
#undef IN
#undef SEAM
}

#if MK_ONE_LAUNCH
#define KFN (fwd_kernel<0, 15>)
#else
#define KFN (fwd_kernel<0, 1>)
typedef void (*kfn_t)(Args);
static kfn_t kfns[15] = {fwd_kernel<0, 1>, fwd_kernel<1, 2>, fwd_kernel<2, 3>, fwd_kernel<3, 4>, fwd_kernel<4, 5>, fwd_kernel<5, 6>, fwd_kernel<6, 7>, fwd_kernel<7, 8>,
                         fwd_kernel<8, 9>, fwd_kernel<9, 10>, fwd_kernel<10, 11>, fwd_kernel<11, 12>, fwd_kernel<12, 13>, fwd_kernel<13, 14>, fwd_kernel<14, 15>};
#endif
extern "C" void kernel_launch(void* const* d_in, const int* in_sizes, int n_in, void* d_out, int out_size, void* d_ws, size_t ws_size, hipStream_t stream) {
    static int grid = 0;
    if (grid == 0) {
        if (n_in != N_IN || (size_t)out_size != O_END || ws_size < WS_END) { fprintf(stderr, "kernel_launch: unexpected shapes (n_in %d out %d ws %zu)\n", n_in, out_size, ws_size); grid = -1; return; }
        int dev = 0, cus = 0, per_cu = 0;
        (void)hipGetDevice(&dev); (void)hipDeviceGetAttribute(&cus, hipDeviceAttributeMultiprocessorCount, dev);
        if (hipFuncSetAttribute((const void*)KFN, hipFuncAttributeMaxDynamicSharedMemorySize, LDS_BYTES) != hipSuccess) { fprintf(stderr, "kernel_launch: hipFuncSetAttribute failed\n"); grid = -1; return; }
#if !MK_ONE_LAUNCH
        for (int k = 1; k < 15; ++k) (void)hipFuncSetAttribute((const void*)kfns[k], hipFuncAttributeMaxDynamicSharedMemorySize, LDS_BYTES);
#endif
        (void)hipOccupancyMaxActiveBlocksPerMultiprocessor(&per_cu, (const void*)KFN, NTHR, LDS_BYTES);
        if (per_cu < 1) per_cu = 1;
        (void)hipGetLastError();
        grid = cus * per_cu;
        fprintf(stderr, "kernel_launch: grid %d (cus %d x %d)\n", grid, cus, per_cu);
    }
    if (grid < 0) return;
    Args a{};
    for (int i = 0; i < N_IN; ++i) a.in[i] = (const float*)d_in[i];
    a.out = (float*)d_out; a.ws = (unsigned char*)d_ws;
#if MK_ONE_LAUNCH
    if (hipMemsetAsync(d_ws, 0, 16384, stream) != hipSuccess) { fprintf(stderr, "kernel_launch: memset failed\n"); return; }
    a.ph_lo = 0; a.ph_hi = 15;
    void* args[] = {&a};
    hipError_t e = hipLaunchCooperativeKernel((const void*)KFN, dim3(grid), dim3(NTHR), args, LDS_BYTES, stream);
    if (e != hipSuccess) fprintf(stderr, "cooperative launch failed: %s (grid %d)\n", hipGetErrorString(e), grid);
#else
    for (int k = 0; k < 15; ++k) { a.ph_lo = k; a.ph_hi = k + 1; hipLaunchKernelGGL(kfns[k], dim3(grid), dim3(NTHR), LDS_BYTES, stream, a); }
#endif
}
```

```cpp
#include <hip/hip_runtime.h>
#include <hip/hip_cooperative_groups.h>
#include <cstdio>
#include <cstdint>
namespace cg = cooperative_groups;
#ifndef MK_ONE_LAUNCH
#define MK_ONE_LAUNCH 1
#endif
namespace pg8 {
#define PG8_LAS __attribute__((address_space(3)))
typedef unsigned short bf16_t;
typedef short bf16x8 __attribute__((ext_vector_type(8)));
typedef float f32x4 __attribute__((ext_vector_type(4)));
typedef unsigned u32x4 __attribute__((ext_vector_type(4)));
constexpr int BM = 256, BK = 64, HALF = 128, HTB = HALF * BK * 2  , STAGE_BYTES = 8 * HTB, NXCD = 8, WGM = 8;

__host__ __device__ __forceinline__ int lds_byte(int r, int c) { const int st = (r >> 4) * 2 + (c >> 5), rr = r & 15, cc = c & 31, ob = rr * 64 + cc * 2; return st * 1024 + (ob ^ (((ob >> 9) & 1) << 5)); }
__host__ __device__ __forceinline__ void stage_rc(int b, int& R, int& C) { const int st = b / 1024, sb = b % 1024, swz = sb ^ (((sb >> 9) & 1) << 5); R = (st >> 1) * 16 + swz / 64; C = (st & 1) * 32 + (swz % 64) / 2; }
__host__ __device__ __forceinline__ int perm32(int rho) { const int n = rho >> 4, i = rho & 15; return 8 * (i >> 2) + 4 * n + (i & 3); }

struct Unit { int pm, pn; };
struct Gemm { const bf16_t* A; const bf16_t* Bt; int M, N, K; };

struct StaticOrder {
    int nM, nN, nwg, G, c;
    __host__ __device__ void init(int M, int N, int G_, int c_) { nM = M / BM; nN = N / BM; nwg = nM * nN; G = G_; c = c_; }
    __host__ __device__ bool next(int i, Unit& u) const {
        const long L = (long)i * G + c; if (L >= nwg) return false;
        int wgid = (int)L; { const int q = nwg / NXCD, r = nwg % NXCD, xcd = wgid % NXCD, off = wgid / NXCD; wgid = (xcd < r ? xcd * (q + 1) : r * (q + 1) + (xcd - r) * q) + off; }
        const int nig = WGM * nN, gid = wgid / nig, fm = gid * WGM, gsz = (nM - fm) < WGM ? (nM - fm) : WGM;
        u.pm = fm + ((wgid % nig) % gsz); u.pn = (wgid % nig) / gsz; return true;
    }
    __device__ __forceinline__ void a_ready(const Unit&) const {}
    __device__ __forceinline__ void done(const Unit&) const {}
};

__device__ __forceinline__ unsigned cvt_pk_bf16(float lo, float hi) { unsigned r; asm volatile("v_cvt_pk_bf16_f32 %0, %1, %2" : "=v"(r) : "v"(lo), "v"(hi)); return r; }
typedef float f32x2 __attribute__((ext_vector_type(2)));
template <class Epi, class Sched, bool ALIGN_EPI = false, bool SP2 = false>
__device__ __forceinline__ void gemm_phase(PG8_LAS unsigned char* lds, const Gemm g, const Sched& S, const Epi& E) {
    int tid_l = threadIdx.x; asm volatile("" : "+v"(tid_l));
    const int tid = tid_l, wid = __builtin_amdgcn_readfirstlane(tid >> 6), lane = tid & 63, wr = wid >> 2, wc = wid & 3, fr = lane & 15, fq = lane >> 4;
    const int K = g.K, nt = K / BK;
    unsigned voffA[2], voffB[2];
#pragma unroll
    for (int i = 0; i < 2; ++i) { int R, C; stage_rc(tid * 16 + i * 8192, R, C); const int Rb = Epi::PERM ? ((R & ~31) + perm32(R & 31)) : R;
        voffA[i] = (unsigned)(R * K + C) * 2u; voffB[i] = (unsigned)(Rb * K + C) * 2u; }
    const size_t kstep = (size_t)(BK * 2);
    const size_t hstep = (size_t)HALF * K * 2;
    const size_t tstep = 2 * hstep;
    const unsigned ldsw = (unsigned)wid * 1024u;
    const int aoff = lds_byte(wr * 64 + fr, fq * 8), boff = lds_byte(wc * 32 + fr, fq * 8);
#define PG8_SA(b, h) (((b) * 2 + (h)) * HTB)
#define PG8_SB(b, h) ((4 + (b) * 2 + (h)) * HTB)
#define PG8_STAGE(bufoff, gbase, voff) do { _Pragma("unroll") for (int _i = 0; _i < 2; ++_i) \
        __builtin_amdgcn_global_load_lds((const unsigned*)((const char*)(gbase) + (voff)[_i]), (PG8_LAS unsigned*)(lds + (bufoff) + ldsw + _i * 8192), 16, 0, 0); } while (0)
#define PG8_LDA(dst, b, h) do { _Pragma("unroll") for (int m = 0; m < 4; ++m) _Pragma("unroll") for (int k = 0; k < 2; ++k) dst[m][k] = *(const PG8_LAS bf16x8*)(lds + PG8_SA(b, h) + aoff + m * 2048 + k * 1024); } while (0)
#define PG8_LDB(dst, b, h) do { _Pragma("unroll") for (int n = 0; n < 2; ++n) _Pragma("unroll") for (int k = 0; k < 2; ++k) dst[n][k] = *(const PG8_LAS bf16x8*)(lds + PG8_SB(b, h) + boff + n * 2048 + k * 1024); } while (0)
#define PG8_MMA(ai, bj, At, Bt) do { __builtin_amdgcn_s_setprio(1); _Pragma("unroll") for (int m = 0; m < 4; ++m) _Pragma("unroll") for (int n = 0; n < 2; ++n) _Pragma("unroll") for (int k = 0; k < 2; ++k) \
        acc[ai][bj][m][n] = __builtin_amdgcn_mfma_f32_16x16x32_bf16(Bt[n][k], At[m][k], acc[ai][bj][m][n], 0, 0, 0); __builtin_amdgcn_s_setprio(0); } while (0)
#define PG8_WAIT_V(n) asm volatile("s_waitcnt vmcnt(" #n ")" ::: "memory")
#define PG8_WAIT_L(n) asm volatile("s_waitcnt lgkmcnt(" #n ")" ::: "memory")
#define PG8_BAR __builtin_amdgcn_s_barrier()
#define PG8_SCHED __builtin_amdgcn_sched_barrier(0)
    Unit cur, nxt; int ui = 0;
    if (!S.next(0, cur)) return;
    f32x4 acc[2][2][4][2];
#pragma unroll
    for (int a = 0; a < 2; ++a)
#pragma unroll
        for (int b = 0; b < 2; ++b)
#pragma unroll
            for (int m = 0; m < 4; ++m)
#pragma unroll
                for (int n = 0; n < 2; ++n) acc[a][b][m][n] = (f32x4){0.f, 0.f, 0.f, 0.f};
    bf16x8 At[4][2], B0[2][2], B1[2][2];
    const char* cA = (const char*)g.A + (size_t)cur.pm * tstep; const char* cB = (const char*)g.Bt + (size_t)cur.pn * tstep;
    S.a_ready(cur);
    if constexpr (SP2) {
        PG8_STAGE(PG8_SB(0, 0), cB, voffB); PG8_STAGE(PG8_SB(0, 1), cB + hstep, voffB); PG8_STAGE(PG8_SA(0, 0), cA, voffA); PG8_STAGE(PG8_SA(0, 1), cA + hstep, voffA);
        if (wr == 1) PG8_BAR;
        PG8_WAIT_V(2); PG8_BAR;
        PG8_STAGE(PG8_SB(1, 0), cB + kstep, voffB); PG8_STAGE(PG8_SA(1, 0), cA + kstep, voffA); PG8_STAGE(PG8_SB(1, 1), cB + hstep + kstep, voffB);
        PG8_WAIT_V(6); PG8_BAR;
    } else {
        PG8_STAGE(PG8_SB(0, 0), cB, voffB); PG8_STAGE(PG8_SA(0, 0), cA, voffA); PG8_STAGE(PG8_SB(0, 1), cB + hstep, voffB); PG8_STAGE(PG8_SA(0, 1), cA + hstep, voffA);
        if (wr == 1) PG8_BAR;
        PG8_WAIT_V(4); PG8_BAR;
        PG8_STAGE(PG8_SB(1, 0), cB + kstep, voffB); PG8_STAGE(PG8_SA(1, 0), cA + kstep, voffA); PG8_STAGE(PG8_SB(1, 1), cB + hstep + kstep, voffB);
        PG8_WAIT_V(6); PG8_BAR;
    }
    for (;;) {
        const bool has_next = S.next(ui + 1, nxt);
        const char* nA = has_next ? (const char*)g.A + (size_t)nxt.pm * tstep : cA; const char* nB = has_next ? (const char*)g.Bt + (size_t)nxt.pn * tstep : cB;
        for (int t = 0; t < nt; t += 2) {
            const bool last = (t == nt - 2);
            const char* a1 = cA + (size_t)(t + 1) * kstep;
            const char* a2 = last ? nA : cA + (size_t)(t + 2) * kstep; const char* b2 = last ? nB : cB + (size_t)(t + 2) * kstep;
            const char* a3 = a2 + kstep; const char* b3 = b2 + kstep;
            if (last && has_next) S.a_ready(nxt);
            if constexpr (SP2) {
            PG8_LDB(B0, 0, 0); PG8_LDB(B1, 0, 1); PG8_SCHED; PG8_LDA(At, 0, 0); PG8_STAGE(PG8_SA(1, 1), a1 + hstep, voffA);
            PG8_WAIT_V(8); PG8_WAIT_L(0); PG8_BAR; PG8_MMA(0, 0, At, B0); PG8_MMA(0, 1, At, B1); PG8_BAR; PG8_SCHED;
            PG8_LDA(At, 0, 1); PG8_STAGE(PG8_SB(0, 0), b2, voffB); PG8_STAGE(PG8_SB(0, 1), b2 + hstep, voffB); PG8_STAGE(PG8_SA(0, 0), a2, voffA);
            PG8_WAIT_V(8); PG8_WAIT_L(0); PG8_BAR; PG8_MMA(1, 0, At, B0); PG8_MMA(1, 1, At, B1); PG8_BAR; PG8_SCHED;
            PG8_LDB(B0, 1, 0); PG8_LDB(B1, 1, 1); PG8_SCHED; PG8_LDA(At, 1, 0); PG8_STAGE(PG8_SA(0, 1), a2 + hstep, voffA);
            PG8_WAIT_V(8); PG8_WAIT_L(0); PG8_BAR; PG8_MMA(0, 0, At, B0); PG8_MMA(0, 1, At, B1); PG8_BAR; PG8_SCHED;
            PG8_LDA(At, 1, 1); PG8_STAGE(PG8_SB(1, 0), b3, voffB); PG8_STAGE(PG8_SB(1, 1), b3 + hstep, voffB); PG8_STAGE(PG8_SA(1, 0), a3, voffA);
            PG8_WAIT_V(8); PG8_WAIT_L(0); PG8_BAR; PG8_MMA(1, 0, At, B0); PG8_MMA(1, 1, At, B1); PG8_BAR; PG8_SCHED;
            } else {
            PG8_LDB(B0, 0, 0); PG8_SCHED; PG8_LDA(At, 0, 0); PG8_STAGE(PG8_SA(1, 1), a1 + hstep, voffA);
            PG8_WAIT_L(8); PG8_BAR; PG8_WAIT_L(0); PG8_MMA(0, 0, At, B0); PG8_BAR; PG8_SCHED;
            PG8_LDB(B1, 0, 1); PG8_STAGE(PG8_SB(0, 0), b2, voffB);
            PG8_BAR; PG8_WAIT_L(0); PG8_MMA(0, 1, At, B1); PG8_BAR;
            PG8_LDA(At, 0, 1); PG8_STAGE(PG8_SA(0, 0), a2, voffA);
            PG8_BAR; PG8_WAIT_L(0); PG8_MMA(1, 0, At, B0); PG8_BAR; PG8_SCHED;
            PG8_STAGE(PG8_SB(0, 1), b2 + hstep, voffB);
            PG8_WAIT_V(6); PG8_BAR; PG8_MMA(1, 1, At, B1); PG8_BAR;
            PG8_LDB(B0, 1, 0); PG8_SCHED; PG8_LDA(At, 1, 0); PG8_STAGE(PG8_SA(0, 1), a2 + hstep, voffA);
            PG8_WAIT_L(8); PG8_BAR; PG8_WAIT_L(0); PG8_MMA(0, 0, At, B0); PG8_BAR; PG8_SCHED;
            PG8_LDB(B1, 1, 1); PG8_STAGE(PG8_SB(1, 0), b3, voffB);
            PG8_BAR; PG8_WAIT_L(0); PG8_MMA(0, 1, At, B1); PG8_BAR;
            PG8_LDA(At, 1, 1); PG8_STAGE(PG8_SA(1, 0), a3, voffA);
            PG8_BAR; PG8_WAIT_L(0); PG8_MMA(1, 0, At, B0); PG8_BAR; PG8_SCHED;
            PG8_STAGE(PG8_SB(1, 1), b3 + hstep, voffB);
            PG8_WAIT_V(6); PG8_BAR; PG8_MMA(1, 1, At, B1); PG8_BAR;
            }
        }
        if constexpr (ALIGN_EPI) { if (wr == 0) PG8_BAR; }
        if constexpr (!Epi::AFTER_DRAIN) { E(acc, cur, wr, wc, fr, fq); S.done(cur); }
        if (!has_next) break;
#pragma unroll
        for (int a = 0; a < 2; ++a)
#pragma unroll
            for (int b = 0; b < 2; ++b)
#pragma unroll
                for (int m = 0; m < 4; ++m)
#pragma unroll
                    for (int n = 0; n < 2; ++n) acc[a][b][m][n] = (f32x4){0.f, 0.f, 0.f, 0.f};
        cur = nxt; cA = nA; cB = nB; ++ui;
        if constexpr (ALIGN_EPI) { if (wr == 1) PG8_BAR; }
    }
    PG8_WAIT_V(0);
    if constexpr (!ALIGN_EPI) { if (wr == 0) PG8_BAR; }
    PG8_BAR;
    if constexpr (Epi::AFTER_DRAIN) { E.fused(acc, cur, wr, wc, fr, fq, lds, wid, lane); S.done(cur); }
#undef PG8_SA
#undef PG8_SB
#undef PG8_STAGE
#undef PG8_LDA
#undef PG8_LDB
#undef PG8_MMA
#undef PG8_WAIT_V
#undef PG8_WAIT_L
#undef PG8_BAR
#undef PG8_SCHED
}
}

typedef unsigned short bf16_t;
typedef short bf16x8 __attribute__((ext_vector_type(8)));
typedef short s16x4 __attribute__((ext_vector_type(4)));
typedef float f32x4 __attribute__((ext_vector_type(4)));
typedef float f32x2 __attribute__((ext_vector_type(2)));
typedef float f32x16 __attribute__((ext_vector_type(16)));
typedef unsigned u32x4 __attribute__((ext_vector_type(4)));
typedef unsigned u32x2 __attribute__((ext_vector_type(2)));
#define LAS __attribute__((address_space(3)))
#define DI __device__ __forceinline__

constexpr int DM = 1024, FF = 4096, MP = 16384, MS = 512, MT = MP + MS, SEQ = 4096, PAST = 1024, DSEQ = 64;
constexpr int ZP = 3072;
constexpr float LOG2E = 1.4426950408889634f;
constexpr float C2 = 0.125f * LOG2E;
constexpr float EPS = 1e-6f;
constexpr size_t O_YP = 0, O_YS = O_YP + (size_t)MP * DM, O_PAK = O_YS + (size_t)MS * DM, O_PAV = O_PAK + (size_t)MP * 512, O_PBK = O_PAV + (size_t)MP * 512,
                 O_PBV = O_PBK + (size_t)MP * 512, O_PBL = O_PBV + (size_t)MP * 512, O_PCK = O_PBL + (size_t)MP * 8, O_PCV = O_PCK + (size_t)4 * 512 * 1024,
                 O_SAK = O_PCV + (size_t)4 * 512 * 1024, O_SAV = O_SAK + (size_t)MS * 512, O_SBK = O_SAV + (size_t)MS * 512, O_SBV = O_SBK + (size_t)MS * 512,
                 O_SBL = O_SBV + (size_t)MS * 512, O_SCK = O_SBL + (size_t)MS * 8, O_SCV = O_SCK + (size_t)8 * 512 * 1024, O_END = O_SCV + (size_t)8 * 512 * 1024;
static_assert(O_END == 64622592, "output size");
constexpr size_t MiB = 1u << 20;
constexpr size_t WS_WINE = 1 * MiB, WS_WOUTE = 7 * MiB, WS_WUP0 = 9 * MiB, WS_WDN0 = 17 * MiB, WS_WINO = 25 * MiB, WS_WOUTO = 31 * MiB, WS_WUP1 = 33 * MiB, WS_WDN1 = 41 * MiB;
constexpr size_t WS_PART_DN = 1 * MiB;
constexpr size_t WS_PART_OUT = 116 * MiB;
constexpr size_t WS_XN = 49 * MiB, WS_Y = 82 * MiB, WS_CUMP = 115 * MiB, WS_CUMS = WS_CUMP + 524288, WS_Z = 116 * MiB, WS_ATT = 215 * MiB, WS_H = 116 * MiB, WS_END = 248 * MiB;
enum { I_XP = 0, I_XS, I_CAK, I_CAV, I_CBK, I_CBV, I_CBL, I_CCK, I_CCV, I_WINE, I_BF, I_LQ1, I_LK1, I_LQ2, I_LK2, I_SUBG, I_WOUTE, I_WINO, I_REL, I_WOUTO,
       I_GPM, I_GQM, I_GPF, I_GQF, I_WUP, I_WDN, N_IN };
constexpr int NWAVES = 8, NTHR = 512;
constexpr int LDS_BYTES = 147456;

struct Args { const float* in[N_IN]; float* out; unsigned char* ws; int ph_lo, ph_hi; };
typedef const __attribute__((address_space(4))) Args* ArgsP;
DI int launder(int v) { asm volatile("" : "+s"(v)); return v; }
DI bool ab_never();
DI ArgsP fresh_args() { ArgsP p = (ArgsP)__builtin_amdgcn_kernarg_segment_ptr(); asm volatile("" : "+s"(p)); return p; }

DI float wave_sum(float v) {
#pragma unroll
    for (int o = 1; o < 64; o <<= 1) v += __shfl_xor(v, o);
    return v;
}
DI unsigned pk2(float lo, float hi) { typedef __bf16 b2 __attribute__((ext_vector_type(2))); f32x2 v = {lo, hi}; b2 b = __builtin_convertvector(v, b2); return __builtin_bit_cast(unsigned, b); }
DI float bf2f(unsigned short h) { return __uint_as_float(((unsigned)h) << 16); }

DI bool ab_never() { return fresh_args()->ph_lo == 0x7fffffff; }

template <int MODE> struct EpiX {
    static constexpr bool PERM = true, AFTER_DRAIN = false;
    bf16_t* O; int ldc; float* out;
    __device__ __forceinline__ void operator()(const pg8::f32x4 (&acc)[2][2][4][2], const pg8::Unit& u, int wr, int wc, int fr, int fq) const {
        const unsigned loff = (unsigned)(fr * ldc + 8 * fq) * 2u;
        char* ub = (char*)O + ((size_t)(u.pm * 256 + wr * 64) * ldc + u.pn * 256 + wc * 32) * 2;
        float sc = 1.f; char* fb = nullptr; unsigned floff = 0; int fpitch = 0; bool smp3 = false;
        if (MODE == 2) {
            const int seg = u.pn >> 1; fpitch = 512; floff = (unsigned)(fr * 512 + 8 * fq) * 4u;
            if (seg == 0 || seg == 3) sc = C2;
            else {
                if (u.pm >= 64) {
                    const size_t off = seg == 1 ? O_SAK : seg == 2 ? O_SAV : seg == 4 ? O_SBK : O_SBV;
                    fb = (char*)(out + off + (size_t)((u.pm - 64) * 256 + wr * 64) * 512 + (u.pn & 1) * 256 + wc * 32);
                }
            }
        } else if (MODE == 3) {
            const int seg = u.pn >> 2; fpitch = 1024; floff = (unsigned)(fr * 1024 + 8 * fq) * 4u;
            if (seg == 0) sc = C2;
            else if (u.pm >= 64) { smp3 = true; fb = (char*)(out + (seg == 1 ? O_SCK : O_SCV) + (size_t)(((u.pm - 64) * 4 + wr) * 512 + 448) * 1024 + (u.pn & 3) * 256 + wc * 32); }
            else if ((u.pm & 15) >= 14) fb = (char*)(out + (seg == 1 ? O_PCK : O_PCV) + (size_t)((u.pm >> 4) * 512 + ((u.pm & 15) - 14) * 256 + wr * 64) * 1024 + (u.pn & 3) * 256 + wc * 32);
        }
#pragma unroll
        for (int ai = 0; ai < 2; ++ai)
#pragma unroll
            for (int m = 0; m < 4; ++m) {
                char* rb = ub + (size_t)(ai * 128 + m * 16) * ldc * 2;
                char* frb = nullptr;
                if (MODE >= 2 && fb) frb = fb + (size_t)((MODE == 3 && smp3) ? (ai * 1024 + m * 16) : (ai * 128 + m * 16)) * fpitch * 4;
#pragma unroll
                for (int bj = 0; bj < 2; ++bj) {
                    pg8::f32x4 v0 = acc[ai][bj][m][0], v1 = acc[ai][bj][m][1];
                    if (MODE >= 2 && frb) { *(pg8::f32x4*)(frb + bj * 512 + floff) = v0; *(pg8::f32x4*)(frb + bj * 512 + 16 + floff) = v1; }
                    if (MODE == 1) {
#pragma unroll
                        for (int e = 0; e < 4; ++e) { float a = fmaxf(v0[e], 0.f), b = fmaxf(v1[e], 0.f); v0[e] = a * a; v1[e] = b * b; }
                    }
                    if (MODE >= 2) { v0 = v0 * sc; v1 = v1 * sc; }
                    pg8::u32x4 w; w.x = pg8::cvt_pk_bf16(v0[0], v0[1]); w.y = pg8::cvt_pk_bf16(v0[2], v0[3]); w.z = pg8::cvt_pk_bf16(v1[0], v1[1]); w.w = pg8::cvt_pk_bf16(v1[2], v1[3]);
                    *(pg8::u32x4*)(rb + bj * 256 + loff) = w;
                }
                asm volatile("" ::: "memory");
            }
    }
};

namespace att {
constexpr int KP = 272, VP = 320;
constexpr int KT_B = 64 * KP, VT_B = 64 * VP;
constexpr int OFF_K = 0, OFF_V = 2 * KT_B, OFF_CUM = 2 * KT_B + 2 * VT_B  , OFF_TBL = OFF_CUM + 1024, OFF_END = OFF_TBL + 2 * 640 * 4;
static_assert(OFF_END <= 131072 && 65536 <= OFF_CUM, "attention LDS map");
struct Job {
    const bf16_t* q;
    const float* kc; const float* vc; int cpitch; int nc;
    const bf16_t* kz; const bf16_t* vz;
    int kt_lo, kt_hi, qpos0, kpos0, nq_sub;
    const float* cum; int cum_hs;
    const float* tbl;
    bf16_t* o;
    float slope2; const float* subg;
};
#define MFMA32(a, b, c) __builtin_amdgcn_mfma_f32_32x32x16_bf16((a), (b), (c), 0, 0, 0)
DI u32x4 pack8(const f32x4 a, const f32x4 b) { u32x4 r; r.x = pk2(a[0], a[1]); r.y = pk2(a[2], a[3]); r.z = pk2(b[0], b[1]); r.w = pk2(b[2], b[3]); return r; }
DI s16x4 vtr(const LAS unsigned char* p) { typedef short v4 __attribute__((ext_vector_type(4))); return __builtin_bit_cast(s16x4, __builtin_amdgcn_ds_read_tr16_b64_v4i16((LAS v4*)p)); }

DI void load_tile(const Job& J, int kt, int srow, int sch, u32x4& r0, u32x4& r1, u32x4& r2, u32x4& r3) {
    if (kt >= J.nc) {
        const size_t o0 = (size_t)((kt - J.nc) * 64 + srow) * ZP + sch * 8, o1 = o0 + (size_t)32 * ZP;
        r0 = *(const u32x4*)(J.kz + o0); r1 = *(const u32x4*)(J.kz + o1); r2 = *(const u32x4*)(J.vz + o0); r3 = *(const u32x4*)(J.vz + o1);
    }
}
template <int MODE> DI void store_tile(const Job& J, int kt, int buf, int srow, int sch, u32x4& r0, u32x4& r1, u32x4& r2, u32x4& r3, LAS unsigned char* lds, float* fk = nullptr, float* fv = nullptr, int own_lo = -4) {
    if (kt < J.nc) {
        const size_t o0 = (size_t)(kt * 64 + srow) * J.cpitch + sch * 8, o1 = o0 + (size_t)32 * J.cpitch;
        const f32x4 ka = *(const f32x4*)(J.kc + o0), kb_ = *(const f32x4*)(J.kc + o0 + 4), kc_ = *(const f32x4*)(J.kc + o1), kd = *(const f32x4*)(J.kc + o1 + 4);
        const f32x4 va = *(const f32x4*)(J.vc + o0), vb_ = *(const f32x4*)(J.vc + o0 + 4), vc_ = *(const f32x4*)(J.vc + o1), vd = *(const f32x4*)(J.vc + o1 + 4);
        if (MODE == 2 && fk && kt >= 1) {
            const size_t d0 = (size_t)(kt * 64 + srow) * 1024 + sch * 8, d1 = d0 + (size_t)32 * 1024;
            *(f32x4*)(fk + d0) = ka; *(f32x4*)(fk + d0 + 4) = kb_; *(f32x4*)(fk + d1) = kc_; *(f32x4*)(fk + d1 + 4) = kd;
            *(f32x4*)(fv + d0) = va; *(f32x4*)(fv + d0 + 4) = vb_; *(f32x4*)(fv + d1) = vc_; *(f32x4*)(fv + d1 + 4) = vd;
        }
        r0 = pack8(ka, kb_); r1 = pack8(kc_, kd); r2 = pack8(va, vb_); r3 = pack8(vc_, vd);
    }
    if (MODE < 2 && fk && (unsigned)(kt - own_lo) < 2u) {
        const size_t o0 = (size_t)(kt * 64 + srow) * 512 + sch * 8, o1 = o0 + (size_t)32 * 512;
#define BF_LO(w) __uint_as_float((w) << 16)
#define BF_HI(w) __uint_as_float((w) & 0xffff0000u)
#define ST8(p, r) do { *(f32x4*)(p) = (f32x4){BF_LO(r.x), BF_HI(r.x), BF_LO(r.y), BF_HI(r.y)}; *(f32x4*)((p) + 4) = (f32x4){BF_LO(r.z), BF_HI(r.z), BF_LO(r.w), BF_HI(r.w)}; } while (0)
        ST8(fk + o0, r0); ST8(fk + o1, r1); ST8(fv + o0, r2); ST8(fv + o1, r3);
#undef ST8
#undef BF_LO
#undef BF_HI
    }
    LAS unsigned char* kb = lds + OFF_K + buf * KT_B + srow * KP + sch * 16; LAS unsigned char* vb = lds + OFF_V + buf * VT_B + srow * VP + sch * 16;
    *(LAS u32x4*)kb = r0; *(LAS u32x4*)(kb + 32 * KP) = r1; *(LAS u32x4*)vb = r2; *(LAS u32x4*)(vb + 32 * VP) = r3;
}

template <int MODE> DI Job make_job(int s_) {
    const int s = launder(s_);
    ArgsP a = fresh_args(); Job J{};
    const bf16_t* z = (const bf16_t*)(a->ws + WS_Z); bf16_t* attb = (bf16_t*)(a->ws + WS_ATT);
    if (MODE < 2) {
        const int qcol = MODE == 0 ? 0 : 1536, kcol = MODE == 0 ? 512 : 2048, vcol = MODE == 0 ? 1024 : 2560, ocol = MODE == 0 ? 0 : 512;
        if (s < 512) {
            const int j = s & 255, u = (s >> 8) ? (j >> 4) : 31 - (j >> 4), bh = j & 15, b = bh >> 2, hh = bh & 3;
            const size_t row0 = (size_t)b * SEQ + 128 * u, rb = (size_t)b * SEQ;
            J.nc = 0; J.kt_lo = 0; J.kt_hi = 2 * u + 1; J.qpos0 = 128 * u; J.kpos0 = 0; J.nq_sub = 4;
            J.q = z + row0 * ZP + qcol + hh * 128; J.kz = z + rb * ZP + kcol + hh * 128; J.vz = z + rb * ZP + vcol + hh * 128; J.o = attb + row0 * DM + ocol + hh * 128;
            J.slope2 = exp2f(-2.f * (float)(hh + 1)) * LOG2E;
            J.cum = (const float*)(a->ws + WS_CUMP) + (size_t)(b * 8 + 2 * hh) * 4096; J.cum_hs = 4096;
        } else {
            const int jj = s - 512, b = jj >> 2, hh = jj & 3; const size_t row0 = (size_t)MP + b * DSEQ;
            J.nc = 16; J.cpitch = 512; J.kt_lo = 0; J.kt_hi = 16; J.qpos0 = PAST; J.kpos0 = 0; J.nq_sub = 2;
            J.q = z + row0 * ZP + qcol + hh * 128; J.kz = z + row0 * ZP + kcol + hh * 128; J.vz = z + row0 * ZP + vcol + hh * 128; J.o = attb + row0 * DM + ocol + hh * 128;
            J.kc = a->in[MODE == 0 ? I_CAK : I_CBK] + (size_t)b * PAST * 512 + hh * 128; J.vc = a->in[MODE == 0 ? I_CAV : I_CBV] + (size_t)b * PAST * 512 + hh * 128;
            J.slope2 = exp2f(-2.f * (float)(hh + 1)) * LOG2E;
            J.cum = (const float*)(a->ws + WS_CUMS) + (size_t)(b * 8 + 2 * hh) * 1088; J.cum_hs = 1088;
        }
        J.subg = a->in[I_SUBG];
    } else {
        if (s < 1024) {
            const int bh = s & 31, b = bh >> 3, hp = bh & 7, u = s >> 5; const size_t row0 = (size_t)b * SEQ + 128 * u, rb = (size_t)b * SEQ;
            J.q = z + row0 * ZP + hp * 128; J.kz = z + rb * ZP + 1024 + hp * 128; J.vz = z + rb * ZP + 2048 + hp * 128; J.o = attb + row0 * DM + hp * 128;
            J.nc = 0; J.kt_lo = 2 * u - 8 > 0 ? 2 * u - 8 : 0; J.kt_hi = 2 * u + 1; J.qpos0 = 128 * u; J.kpos0 = 0; J.nq_sub = 4; J.tbl = a->in[I_REL] + (size_t)(2 * hp) * 513;
        } else {
            const int id = s - 1024, b = id >> 3, hp = id & 7; const size_t row0 = (size_t)MP + b * DSEQ;
            J.q = z + row0 * ZP + hp * 128; J.kz = z + row0 * ZP + 1024 + hp * 128; J.vz = z + row0 * ZP + 2048 + hp * 128; J.o = attb + row0 * DM + hp * 128;
            J.kc = a->in[I_CCK] + (size_t)b * 512 * 1024 + hp * 128; J.vc = a->in[I_CCV] + (size_t)b * 512 * 1024 + hp * 128; J.cpitch = 1024; J.nc = 8;
            J.kt_lo = 0; J.kt_hi = 8; J.qpos0 = PAST; J.kpos0 = 512; J.nq_sub = 2; J.tbl = a->in[I_REL] + (size_t)(2 * hp) * 513;
        }
    }
    return J;
}

template <int MODE>
DI void attn_unit(LAS unsigned char* lds, const int slot) {
    constexpr int NDB = (MODE == 0) ? 4 : 2;
    int tid_l = threadIdx.x; asm volatile("" : "+v"(tid_l));
    const int tid = tid_l, lane = tid & 63, wid = __builtin_amdgcn_readfirstlane(tid >> 6);
    const int qs = wid >> 1, half = wid & 1, r32 = lane & 31, hi = lane >> 5;
    const int srow = tid >> 4, sch = tid & 15;
    const int qin = (32 * qs + r32) & 63;
    bool active; int qc_w, kc0, kt, nt, qk0;
    bf16x8 qr[4];
    u32x4 r0 = {0u, 0u, 0u, 0u}, r1 = r0, r2 = r0, r3 = r0, n0 = r0, n1 = r0, n2 = r0, n3 = r0; float cumv = 0.f, cumn = 0.f;
    __syncthreads();
    Job J = make_job<MODE>(slot);
    float* fk = nullptr; float* fv = nullptr; int own_lo = -4;
    if (MODE == 2 && slot >= 1024) {
        const int id = slot - 1024; ArgsP a = fresh_args();
        const size_t off = (size_t)(id >> 3) * 512 * 1024 + (id & 7) * 128;
        fk = a->out + O_SCK + off - (size_t)64 * 1024; fv = a->out + O_SCV + off - (size_t)64 * 1024;
    }
    if (MODE < 2 && slot < 512) {
        const int j = slot & 255, u = (slot >> 8) ? (j >> 4) : 31 - (j >> 4), bh = j & 15; ArgsP a = fresh_args();
        const size_t off = (size_t)(bh >> 2) * SEQ * 512 + (bh & 3) * 128;
        fk = a->out + (MODE == 0 ? O_PAK : O_PBK) + off; fv = a->out + (MODE == 0 ? O_PAV : O_PBV) + off; own_lo = 2 * u;
    }
    const float slope2 = J.slope2;
    {
        active = qs < J.nq_sub; qc_w = (J.qpos0 + 32 * qs) >> 6; kc0 = J.kpos0 >> 6; kt = J.kt_lo; nt = J.kt_hi - J.kt_lo + 1; qk0 = J.qpos0 - J.kpos0;
        if (MODE == 2) {
            for (int e = tid; e < 1280; e += NTHR) { const int hs = e >= 640 ? 1 : 0, idx = e - hs * 640, rel = idx - 63, c = (rel > 256 ? 256 : rel) + 256;
                ((LAS float*)(lds + OFF_TBL))[e] = J.tbl[hs * 513 + c] * LOG2E; }
        }
        const bf16_t* qp = J.q + (size_t)((active ? 32 * qs : 0) + r32) * ZP + half * 64 + 8 * hi;
#pragma unroll
        for (int d0 = 0; d0 < 4; ++d0) qr[d0] = *(const bf16x8*)(qp + 16 * d0);
        load_tile(J, kt, srow, sch, r0, r1, r2, r3);
        if (MODE == 1 && tid < 128) cumv = J.cum[(size_t)(tid >> 6) * J.cum_hs + kt * 64 + (tid & 63)];
        store_tile<MODE>(J, kt, 0, srow, sch, r0, r1, r2, r3, lds, fk, fv, own_lo);
        if (MODE == 1 && tid < 128) ((LAS float*)(lds + OFF_CUM))[tid] = cumv;
        if (nt > 1) { load_tile(J, kt + 1, srow, sch, r0, r1, r2, r3); if (MODE == 1 && tid < 128) cumv = J.cum[(size_t)(tid >> 6) * J.cum_hs + (kt + 1) * 64 + (tid & 63)]; }
    }
    f32x16 o[NDB];
#pragma unroll
    for (int d = 0; d < NDB; ++d)
#pragma unroll
        for (int i = 0; i < 16; ++i) o[d][i] = 0.f;
    float m_ref = 0.f, l_run = 0.f; bool first = true;
    __syncthreads();
    const int b16 = (lane >> 4) & 1, q4 = (lane & 15) >> 2, p4 = lane & 3;
    const int vcol0 = (MODE == 0) ? 0 : 64 * half;
    for (int it = 0; it < nt; ++kt) {
        {
        const int buf = it & 1; const bool more = it + 1 < nt;
        {
            if (it + 2 < nt) { load_tile(J, kt + 2, srow, sch, n0, n1, n2, n3); if (MODE == 1 && tid < 128) cumn = J.cum[(size_t)(tid >> 6) * J.cum_hs + (kt + 2) * 64 + (tid & 63)]; }
        }
        const int kc = kc0 + kt;
        const bool vis = active && kc <= qc_w && (MODE != 2 || kc >= qc_w - 8);
        if (vis) {
            const LAS unsigned char* Kb = lds + OFF_K + buf * KT_B + r32 * KP + half * 128 + hi * 16;
            const int qk = qk0 + 32 * qs + r32 - kt * 64 - 4 * hi;
            bf16x8 kf[8];
#pragma unroll
            for (int d0 = 0; d0 < 4; ++d0) { kf[2 * d0] = *(const LAS bf16x8*)(Kb + d0 * 32); kf[2 * d0 + 1] = *(const LAS bf16x8*)(Kb + 32 * KP + d0 * 32); }
            f32x16 p0, p1;
            if (MODE == 0) {
                if (kc < qc_w) {
                    const float base = fmaf(-slope2, (float)qk, -m_ref);
#pragma unroll
                    for (int i = 0; i < 16; ++i) { const float ci = (float)((i & 3) + 8 * (i >> 2)); p0[i] = fmaf(slope2, ci, base); p1[i] = fmaf(slope2, ci + 32.f, base); }
                } else {
                    const float qrel = (float)qk, nm = -m_ref;
#pragma unroll
                    for (int i = 0; i < 16; ++i) { const float ci = (float)((i & 3) + 8 * (i >> 2)); p0[i] = fmaf(-slope2, fabsf(qrel - ci), nm); p1[i] = fmaf(-slope2, fabsf(qrel - 32.f - ci), nm); }
                }
            } else if (MODE == 1) {
                const LAS float* ct = (const LAS float*)(lds + OFF_CUM) + buf * 128 + half * 64 + 4 * hi; const float nm = -m_ref;
#pragma unroll
                for (int g = 0; g < 4; ++g) { const f32x4 c0 = *(const LAS f32x4*)(ct + 8 * g), c1 = *(const LAS f32x4*)(ct + 32 + 8 * g);
#pragma unroll
                    for (int e = 0; e < 4; ++e) { p0[4 * g + e] = nm - c0[e]; p1[4 * g + e] = nm - c1[e]; } }
            } else {
                const LAS float* tb = (const LAS float*)(lds + OFF_TBL) + half * 640 + (qk + 63 - 59);
#pragma unroll
                for (int i = 0; i < 16; ++i) { const int ci = (i & 3) + 8 * (i >> 2); p0[i] = tb[59 - ci] - m_ref; p1[i] = tb[59 - 32 - ci] - m_ref; }
            }
            __builtin_amdgcn_sched_barrier(0);
#pragma unroll
            for (int d0 = 0; d0 < 4; ++d0) { p0 = MFMA32(kf[2 * d0], qr[d0], p0); p1 = MFMA32(kf[2 * d0 + 1], qr[d0], p1); }
            const LAS unsigned char* Vb = lds + OFF_V + buf * VT_B + (4 * hi + q4) * VP + (vcol0 + 16 * b16 + 4 * p4) * 2;
            s16x4 vr[2][NDB][2];
#pragma unroll
            for (int d = 0; d < NDB; ++d) { vr[0][d][0] = vtr(Vb + d * 64); vr[0][d][1] = vtr(Vb + d * 64 + 8 * VP); }
            __builtin_amdgcn_sched_barrier(0);
            if (MODE == 1 && kc == qc_w) {
#pragma unroll
                for (int i = 0; i < 16; ++i) { const int kin = (i & 3) + 8 * (i >> 2) + 4 * hi; if (kin > qin) p0[i] = -INFINITY; if (kin + 32 > qin) p1[i] = -INFINITY; }
            }
            float mx = fmaxf(fmaxf(p0[0], p1[0]), p0[1]);
#pragma unroll
            for (int i = 2; i < 16; i += 2) mx = fmaxf(fmaxf(mx, p0[i]), p0[i + 1]);
#pragma unroll
            for (int i = 1; i < 16; i += 2) mx = fmaxf(fmaxf(mx, p1[i]), p1[i + 1 < 16 ? i + 1 : i]);
            { auto rr = __builtin_amdgcn_permlane32_swap(__float_as_uint(mx), __float_as_uint(mx), false, false); mx = fmaxf(__uint_as_float(rr[0]), __uint_as_float(rr[1])); }
            if (first || __any(mx > 8.f)) {
                const float dl = first ? mx : fmaxf(mx, 0.f), f = first ? 1.f : __builtin_amdgcn_exp2f(-dl);
                m_ref += dl; l_run *= f;
#pragma unroll
                for (int i = 0; i < 16; ++i) { p0[i] -= dl; p1[i] -= dl; }
#pragma unroll
                for (int d = 0; d < NDB; ++d)
#pragma unroll
                    for (int i = 0; i < 16; ++i) o[d][i] *= f;
                first = false;
            }
            float ls = 0.f;
#pragma unroll
            for (int i = 0; i < 16; ++i) { p0[i] = __builtin_amdgcn_exp2f(p0[i]); p1[i] = __builtin_amdgcn_exp2f(p1[i]); ls += p0[i] + p1[i]; }
            l_run += ls;
            bf16x8 pf[4];
            { u32x4 t;
              t.x = pk2(p0[0], p0[1]); t.y = pk2(p0[2], p0[3]); t.z = pk2(p0[4], p0[5]); t.w = pk2(p0[6], p0[7]); pf[0] = __builtin_bit_cast(bf16x8, t);
              t.x = pk2(p0[8], p0[9]); t.y = pk2(p0[10], p0[11]); t.z = pk2(p0[12], p0[13]); t.w = pk2(p0[14], p0[15]); pf[1] = __builtin_bit_cast(bf16x8, t);
              t.x = pk2(p1[0], p1[1]); t.y = pk2(p1[2], p1[3]); t.z = pk2(p1[4], p1[5]); t.w = pk2(p1[6], p1[7]); pf[2] = __builtin_bit_cast(bf16x8, t);
              t.x = pk2(p1[8], p1[9]); t.y = pk2(p1[10], p1[11]); t.z = pk2(p1[12], p1[13]); t.w = pk2(p1[14], p1[15]); pf[3] = __builtin_bit_cast(bf16x8, t); }
#pragma unroll
            for (int ks = 0; ks < 4; ++ks) {
                if (ks < 3) {
#pragma unroll
                    for (int d = 0; d < NDB; ++d) { const LAS unsigned char* a = Vb + (16 * (ks + 1)) * VP + d * 64; vr[(ks + 1) & 1][d][0] = vtr(a); vr[(ks + 1) & 1][d][1] = vtr(a + 8 * VP); }
                }
                __builtin_amdgcn_sched_barrier(0);
#pragma unroll
                for (int d = 0; d < NDB; ++d) {
                    const bf16x8 vf = __builtin_shufflevector(vr[ks & 1][d][0], vr[ks & 1][d][1], 0, 1, 2, 3, 4, 5, 6, 7);
                    o[d] = MFMA32(vf, pf[ks], o[d]);
                }
                __builtin_amdgcn_sched_barrier(0);
            }
        }
        if (more) {
            store_tile<MODE>(J, kt + 1, buf ^ 1, srow, sch, r0, r1, r2, r3, lds, fk, fv, own_lo); if (MODE == 1 && tid < 128) ((LAS float*)(lds + OFF_CUM))[(buf ^ 1) * 128 + tid] = cumv;
        }
        __syncthreads();
        }
        ++it; ++kt;
        if (it >= nt) break;
        {
        const int buf = it & 1; const bool more = it + 1 < nt;
        {
            if (it + 2 < nt) { load_tile(J, kt + 2, srow, sch, r0, r1, r2, r3); if (MODE == 1 && tid < 128) cumv = J.cum[(size_t)(tid >> 6) * J.cum_hs + (kt + 2) * 64 + (tid & 63)]; }
        }
        const int kc = kc0 + kt;
        const bool vis = active && kc <= qc_w && (MODE != 2 || kc >= qc_w - 8);
        if (vis) {
            const LAS unsigned char* Kb = lds + OFF_K + buf * KT_B + r32 * KP + half * 128 + hi * 16;
            const int qk = qk0 + 32 * qs + r32 - kt * 64 - 4 * hi;
            bf16x8 kf[8];
#pragma unroll
            for (int d0 = 0; d0 < 4; ++d0) { kf[2 * d0] = *(const LAS bf16x8*)(Kb + d0 * 32); kf[2 * d0 + 1] = *(const LAS bf16x8*)(Kb + 32 * KP + d0 * 32); }
            f32x16 p0, p1;
            if (MODE == 0) {
                if (kc < qc_w) {
                    const float base = fmaf(-slope2, (float)qk, -m_ref);
#pragma unroll
                    for (int i = 0; i < 16; ++i) { const float ci = (float)((i & 3) + 8 * (i >> 2)); p0[i] = fmaf(slope2, ci, base); p1[i] = fmaf(slope2, ci + 32.f, base); }
                } else {
                    const float qrel = (float)qk, nm = -m_ref;
#pragma unroll
                    for (int i = 0; i < 16; ++i) { const float ci = (float)((i & 3) + 8 * (i >> 2)); p0[i] = fmaf(-slope2, fabsf(qrel - ci), nm); p1[i] = fmaf(-slope2, fabsf(qrel - 32.f - ci), nm); }
                }
            } else if (MODE == 1) {
                const LAS float* ct = (const LAS float*)(lds + OFF_CUM) + buf * 128 + half * 64 + 4 * hi; const float nm = -m_ref;
#pragma unroll
                for (int g = 0; g < 4; ++g) { const f32x4 c0 = *(const LAS f32x4*)(ct + 8 * g), c1 = *(const LAS f32x4*)(ct + 32 + 8 * g);
#pragma unroll
                    for (int e = 0; e < 4; ++e) { p0[4 * g + e] = nm - c0[e]; p1[4 * g + e] = nm - c1[e]; } }
            } else {
                const LAS float* tb = (const LAS float*)(lds + OFF_TBL) + half * 640 + (qk + 63 - 59);
#pragma unroll
                for (int i = 0; i < 16; ++i) { const int ci = (i & 3) + 8 * (i >> 2); p0[i] = tb[59 - ci] - m_ref; p1[i] = tb[59 - 32 - ci] - m_ref; }
            }
            __builtin_amdgcn_sched_barrier(0);
#pragma unroll
            for (int d0 = 0; d0 < 4; ++d0) { p0 = MFMA32(kf[2 * d0], qr[d0], p0); p1 = MFMA32(kf[2 * d0 + 1], qr[d0], p1); }
            const LAS unsigned char* Vb = lds + OFF_V + buf * VT_B + (4 * hi + q4) * VP + (vcol0 + 16 * b16 + 4 * p4) * 2;
            s16x4 vr[2][NDB][2];
#pragma unroll
            for (int d = 0; d < NDB; ++d) { vr[0][d][0] = vtr(Vb + d * 64); vr[0][d][1] = vtr(Vb + d * 64 + 8 * VP); }
            __builtin_amdgcn_sched_barrier(0);
            if (MODE == 1 && kc == qc_w) {
#pragma unroll
                for (int i = 0; i < 16; ++i) { const int kin = (i & 3) + 8 * (i >> 2) + 4 * hi; if (kin > qin) p0[i] = -INFINITY; if (kin + 32 > qin) p1[i] = -INFINITY; }
            }
            float mx = fmaxf(fmaxf(p0[0], p1[0]), p0[1]);
#pragma unroll
            for (int i = 2; i < 16; i += 2) mx = fmaxf(fmaxf(mx, p0[i]), p0[i + 1]);
#pragma unroll
            for (int i = 1; i < 16; i += 2) mx = fmaxf(fmaxf(mx, p1[i]), p1[i + 1 < 16 ? i + 1 : i]);
            { auto rr = __builtin_amdgcn_permlane32_swap(__float_as_uint(mx), __float_as_uint(mx), false, false); mx = fmaxf(__uint_as_float(rr[0]), __uint_as_float(rr[1])); }
            if (first || __any(mx > 8.f)) {
                const float dl = first ? mx : fmaxf(mx, 0.f), f = first ? 1.f : __builtin_amdgcn_exp2f(-dl);
                m_ref += dl; l_run *= f;
#pragma unroll
                for (int i = 0; i < 16; ++i) { p0[i] -= dl; p1[i] -= dl; }
#pragma unroll
                for (int d = 0; d < NDB; ++d)
#pragma unroll
                    for (int i = 0; i < 16; ++i) o[d][i] *= f;
                first = false;
            }
            float ls = 0.f;
#pragma unroll
            for (int i = 0; i < 16; ++i) { p0[i] = __builtin_amdgcn_exp2f(p0[i]); p1[i] = __builtin_amdgcn_exp2f(p1[i]); ls += p0[i] + p1[i]; }
            l_run += ls;
            bf16x8 pf[4];
            { u32x4 t;
              t.x = pk2(p0[0], p0[1]); t.y = pk2(p0[2], p0[3]); t.z = pk2(p0[4], p0[5]); t.w = pk2(p0[6], p0[7]); pf[0] = __builtin_bit_cast(bf16x8, t);
              t.x = pk2(p0[8], p0[9]); t.y = pk2(p0[10], p0[11]); t.z = pk2(p0[12], p0[13]); t.w = pk2(p0[14], p0[15]); pf[1] = __builtin_bit_cast(bf16x8, t);
              t.x = pk2(p1[0], p1[1]); t.y = pk2(p1[2], p1[3]); t.z = pk2(p1[4], p1[5]); t.w = pk2(p1[6], p1[7]); pf[2] = __builtin_bit_cast(bf16x8, t);
              t.x = pk2(p1[8], p1[9]); t.y = pk2(p1[10], p1[11]); t.z = pk2(p1[12], p1[13]); t.w = pk2(p1[14], p1[15]); pf[3] = __builtin_bit_cast(bf16x8, t); }
#pragma unroll
            for (int ks = 0; ks < 4; ++ks) {
                if (ks < 3) {
#pragma unroll
                    for (int d = 0; d < NDB; ++d) { const LAS unsigned char* a = Vb + (16 * (ks + 1)) * VP + d * 64; vr[(ks + 1) & 1][d][0] = vtr(a); vr[(ks + 1) & 1][d][1] = vtr(a + 8 * VP); }
                }
                __builtin_amdgcn_sched_barrier(0);
#pragma unroll
                for (int d = 0; d < NDB; ++d) {
                    const bf16x8 vf = __builtin_shufflevector(vr[ks & 1][d][0], vr[ks & 1][d][1], 0, 1, 2, 3, 4, 5, 6, 7);
                    o[d] = MFMA32(vf, pf[ks], o[d]);
                }
                __builtin_amdgcn_sched_barrier(0);
            }
        }
        if (more) {
            store_tile<MODE>(J, kt + 1, buf ^ 1, srow, sch, n0, n1, n2, n3, lds, fk, fv, own_lo); if (MODE == 1 && tid < 128) ((LAS float*)(lds + OFF_CUM))[(buf ^ 1) * 128 + tid] = cumn;
        }
        __syncthreads();
        }
        ++it;
    }
    const float l_tot = l_run + __shfl_xor(l_run, 32);
    const float inv = active ? 1.f / l_tot : 0.f;
    if (MODE != 0) {
        if (active) {
            const Job J = make_job<MODE>(slot);
            bf16_t* op = J.o + (size_t)(32 * qs + r32) * DM + half * 64 + 4 * hi;
#pragma unroll
            for (int d = 0; d < NDB; ++d)
#pragma unroll
                for (int g = 0; g < 4; ++g) { u32x2 w; w.x = pk2(o[d][4 * g] * inv, o[d][4 * g + 1] * inv); w.y = pk2(o[d][4 * g + 2] * inv, o[d][4 * g + 3] * inv);
                    *(u32x2*)(op + 32 * d + 8 * g) = w; }
        }
    } else {
        LAS float* ex = (LAS float*)lds + qs * 4096 + lane;
        if (active && half == 1) {
#pragma unroll
            for (int d = 0; d < NDB; ++d)
#pragma unroll
                for (int i = 0; i < 16; ++i) ex[(d * 16 + i) * 64] = o[d][i] * inv;
        }
        __syncthreads();
        if (active && half == 0) {
            const Job J = make_job<MODE>(slot);
            ArgsP a = fresh_args();
            const float lam = expf(wave_sum(a->in[I_LQ1][lane] * a->in[I_LK1][lane])) - expf(wave_sum(a->in[I_LQ2][lane] * a->in[I_LK2][lane])) + 0.2f;
            float ss = 0.f;
#pragma unroll
            for (int d = 0; d < NDB; ++d)
#pragma unroll
                for (int i = 0; i < 16; ++i) { const float v = o[d][i] * inv - lam * ex[(d * 16 + i) * 64]; o[d][i] = v; ss += v * v; }
            ss += __shfl_xor(ss, 32);
            const float rs = rsqrtf(ss * (1.f / 128.f) + EPS) * 0.8f;
            bf16_t* op = J.o + (size_t)(32 * qs + r32) * DM + 4 * hi;
#pragma unroll
            for (int d = 0; d < NDB; ++d)
#pragma unroll
                for (int g = 0; g < 4; ++g) { const f32x4 gg = *(const f32x4*)(J.subg + 32 * d + 8 * g + 4 * hi);
                    u32x2 w; w.x = pk2(o[d][4 * g] * rs * gg[0], o[d][4 * g + 1] * rs * gg[1]); w.y = pk2(o[d][4 * g + 2] * rs * gg[2], o[d][4 * g + 3] * rs * gg[3]);
                    *(u32x2*)(op + 32 * d + 8 * g) = w; }
        }
    }
}
}

#define LDS_WAIT() asm volatile("s_waitcnt lgkmcnt(0)" ::: "memory")
DI void transpose_item(const float* W, int ldw, int K, int nblk, bf16_t* WT, LAS float* scr, int item, int lane) {
    const int kb = item / nblk, nb = item - kb * nblk, k0 = 64 * kb, n0 = 32 * nb;
#pragma unroll 8
    for (int i = 0; i < 32; ++i) { const int kk = 2 * i + (lane >> 5); scr[kk * 33 + (lane & 31)] = W[(size_t)(k0 + kk) * ldw + n0 + (lane & 31)]; }
    LDS_WAIT();
    const int c = lane & 7;
#pragma unroll
    for (int j = 0; j < 4; ++j) { const int n = (lane >> 3) + 8 * j; const LAS float* s = scr + (8 * c) * 33 + n;
        u32x4 o; o.x = pk2(s[0 * 33], s[1 * 33]); o.y = pk2(s[2 * 33], s[3 * 33]); o.z = pk2(s[4 * 33], s[5 * 33]); o.w = pk2(s[6 * 33], s[7 * 33]);
        *(u32x4*)(WT + (size_t)(n0 + n) * K + k0 + 8 * c) = o; }
    LDS_WAIT();
}
DI float log_sigmoid(float x) { return fminf(x, 0.f) - log1pf(expf(-fabsf(x))); }

DI void prologue_phase(LAS unsigned char* lds, ArgsP a, int tid, int lane, int wave) {
    unsigned char* ws = a->ws;
    const int gw = launder((int)blockIdx.x) * NWAVES + wave, NGW = launder((int)gridDim.x) * NWAVES;
    {
        LAS float* scr = (LAS float*)(lds + wave * 8448);
        constexpr int I_IN = 16 * 96, I_O = 16 * 32, I_UP = 16 * 128, I_DN = 64 * 32;
        constexpr int NITEMS = 2 * I_IN + 2 * I_O + 2 * I_UP + 2 * I_DN;
        for (int it = gw; it < NITEMS; it += NGW) {
            int r = it;
            if (r < I_IN) { transpose_item(a->in[I_WINE], 3080, 1024, 96, (bf16_t*)(ws + WS_WINE), scr, r, lane); continue; } r -= I_IN;
            if (r < I_IN) { transpose_item(a->in[I_WINO], 3072, 1024, 96, (bf16_t*)(ws + WS_WINO), scr, r, lane); continue; } r -= I_IN;
            if (r < I_O) { transpose_item(a->in[I_WOUTE], 1024, 1024, 32, (bf16_t*)(ws + WS_WOUTE), scr, r, lane); continue; } r -= I_O;
            if (r < I_O) { transpose_item(a->in[I_WOUTO], 1024, 1024, 32, (bf16_t*)(ws + WS_WOUTO), scr, r, lane); continue; } r -= I_O;
            if (r < 2 * I_UP) { const int l = r / I_UP; transpose_item(a->in[I_WUP] + (size_t)l * 1024 * 4096, 4096, 1024, 128, (bf16_t*)(ws + (l ? WS_WUP1 : WS_WUP0)), scr, r - l * I_UP, lane); continue; } r -= 2 * I_UP;
            { const int l = r / I_DN; transpose_item(a->in[I_WDN] + (size_t)l * 4096 * 1024, 1024, 4096, 32, (bf16_t*)(ws + (l ? WS_WDN1 : WS_WDN0)), scr, r - l * I_DN, lane); }
        }
    }
    LAS float* wf = (LAS float*)(lds + 98304);
    __syncthreads();
    for (int e = tid; e < 8192; e += NTHR) { const int k = e >> 3, o = e & 7; wf[o * 1024 + k] = a->in[I_WINE][(size_t)k * 3080 + 3072 + o]; }
    __syncthreads();
    const float* gp = a->in[I_GPM]; bf16_t* xn = (bf16_t*)(ws + WS_XN);
    f32x4 g[4];
#pragma unroll
    for (int j = 0; j < 4; ++j) g[j] = ((const f32x4*)gp)[lane + 64 * j];
    for (int m = gw; m < MT; m += NGW) {
        const float* xr = m < MP ? a->in[I_XP] + (size_t)m * DM : a->in[I_XS] + (size_t)(m - MP) * DM;
        f32x4 v[4]; float ss = 0.f;
#pragma unroll
        for (int j = 0; j < 4; ++j) { v[j] = ((const f32x4*)xr)[lane + 64 * j]; ss += (v[j].x * v[j].x + v[j].y * v[j].y) + (v[j].z * v[j].z + v[j].w * v[j].w); }
        const float rstd = rsqrtf(wave_sum(ss) * (1.f / DM) + EPS);
#pragma unroll
        for (int j = 0; j < 4; ++j) { v[j] = v[j] * rstd * g[j]; u32x2 w; w.x = pk2(v[j].x, v[j].y); w.y = pk2(v[j].z, v[j].w); ((u32x2*)(xn + (size_t)m * DM))[lane + 64 * j] = w; }
        float mine = 0.f;
#pragma unroll
        for (int o = 0; o < 8; ++o) { float acc = 0.f;
#pragma unroll
            for (int j = 0; j < 4; ++j) { const f32x4 w = *(const LAS f32x4*)(wf + o * 1024 + 4 * (lane + 64 * j)); acc += (v[j].x * w.x + v[j].y * w.y) + (v[j].z * w.z + v[j].w * w.w); }
            acc = wave_sum(acc); if (lane == o) mine = acc; }
        if (lane < 8) { const float lf = log_sigmoid(mine + a->in[I_BF][lane]);
            if (m < MP) a->out[O_PBL + (size_t)m * 8 + lane] = lf; else a->out[O_SBL + (size_t)(m - MP) * 8 + lane] = lf; }
    }
}

template <int N> DI void scan_seq_n(const float* src0, const float* src1, int split, float* dst, int lane) {
    const int i0 = lane * N;
    float v[N];
#pragma unroll
    for (int i = 0; i < N; ++i) { const int idx = i0 + i; v[i] = idx >= split ? src1[(size_t)(idx - split) * 8] : src0[(size_t)idx * 8]; }
    float tot = 0.f;
#pragma unroll
    for (int i = 0; i < N; ++i) tot += v[i];
    float x = tot;
#pragma unroll
    for (int o = 1; o < 64; o <<= 1) { const float t = __shfl_up(x, o); if (lane >= o) x += t; }
    float run = x - tot;
#pragma unroll
    for (int i = 0; i < N; ++i) { run += v[i]; dst[i0 + i] = run * LOG2E; }
}
DI void scan_seq(ArgsP a, int seq, int lane) {
    float* cump = (float*)(a->ws + WS_CUMP); float* cums = (float*)(a->ws + WS_CUMS);
    const bool smp = seq >= 32; const int s = smp ? seq - 32 : seq, b = s >> 3, h = s & 7;
    if (!smp) scan_seq_n<64>(a->out + O_PBL + (size_t)b * 4096 * 8 + h, nullptr, 1 << 30, cump + (size_t)(b * 8 + h) * 4096, lane);
    else scan_seq_n<17>(a->in[I_CBL] + (size_t)b * 1024 * 8 + h, a->out + O_SBL + (size_t)b * 64 * 8 + h, 1024, cums + (size_t)(b * 8 + h) * 1088, lane);
}

constexpr int RW = 3;
DI void rows_phase(ArgsP a, const float* gpost, const float* gnext, const float* part, int nparts, int lane, int wave, bool x_from_input = false, float scl = 1.f) {
    const bf16_t* Y = (const bf16_t*)(a->ws + WS_Y); bf16_t* xn = (bf16_t*)(a->ws + WS_XN); float* X = a->out;
    const int gw = launder((int)blockIdx.x) * NWAVES + wave, NGW = launder((int)gridDim.x) * NWAVES;
    f32x4 gp[4], gn[4];
#pragma unroll
    for (int j = 0; j < 4; ++j) { gp[j] = ((const f32x4*)gpost)[lane + 64 * j]; gn[j] = gnext ? ((const f32x4*)gnext)[lane + 64 * j] : (f32x4){0.f, 0.f, 0.f, 0.f}; }
    for (int m0 = gw; m0 < MT; m0 += RW * NGW) {
        f32x4 y[RW][4], x[RW][4];
#pragma unroll
        for (int r = 0; r < RW; ++r) {
            const int m = m0 + r * NGW;
            if (m < MT) {
#pragma unroll
                for (int j = 0; j < 4; ++j) {
                    if (m < MP) { const u32x2 w = ((const u32x2*)(Y + (size_t)m * DM))[lane + 64 * j];
                        y[r][j].x = __uint_as_float(w.x << 16); y[r][j].y = __uint_as_float(w.x & 0xffff0000u); y[r][j].z = __uint_as_float(w.y << 16); y[r][j].w = __uint_as_float(w.y & 0xffff0000u); }
                    else { y[r][j] = ((const f32x4*)(part + (size_t)(m - MP) * DM))[lane + 64 * j];
                        for (int p = 1; p < nparts; ++p) y[r][j] = y[r][j] + ((const f32x4*)(part + ((size_t)p * MS + (m - MP)) * DM))[lane + 64 * j]; }
                    x[r][j] = ((const f32x4*)(x_from_input ? (m < MP ? a->in[I_XP] + (size_t)m * DM : a->in[I_XS] + (size_t)(m - MP) * DM) : X + (size_t)m * DM))[lane + 64 * j];
                }
            }
        }
#pragma unroll
        for (int r = 0; r < RW; ++r) {
            const int m = m0 + r * NGW;
            if (m < MT) {
                float ss = 0.f;
#pragma unroll
                for (int j = 0; j < 4; ++j) ss += (y[r][j].x * y[r][j].x + y[r][j].y * y[r][j].y) + (y[r][j].z * y[r][j].z + y[r][j].w * y[r][j].w);
                const float rstd = rsqrtf(wave_sum(ss) * (1.f / DM) + EPS);
                float s2 = 0.f;
#pragma unroll
                for (int j = 0; j < 4; ++j) { x[r][j] = x[r][j] + y[r][j] * (rstd * scl) * gp[j];
                    ((f32x4*)(X + (size_t)m * DM))[lane + 64 * j] = x[r][j]; s2 += (x[r][j].x * x[r][j].x + x[r][j].y * x[r][j].y) + (x[r][j].z * x[r][j].z + x[r][j].w * x[r][j].w); }
                if (gnext) {
                    const float r2 = rsqrtf(wave_sum(s2) * (1.f / DM) + EPS);
#pragma unroll
                    for (int j = 0; j < 4; ++j) { const f32x4 h = x[r][j] * r2 * gn[j];
                        u32x2 w; w.x = pk2(h.x, h.y); w.y = pk2(h.z, h.w); ((u32x2*)(xn + (size_t)m * DM))[lane + 64 * j] = w; }
                }
            }
        }
    }
}

DI void sgemm_sample(const bf16_t* A, int K, const bf16_t* Wt, float* P, int gw, int NGW, int lane) {
    const int r32 = lane & 31, hi = lane >> 5, nks = K >> 9, nunits = 16 * 16 * nks;
    for (int u = gw; u < nunits; u += NGW) {
        const int ks = u % nks, t = u / nks, cb = t & 15, rb = t >> 4;
        const bf16_t* ap = A + (size_t)(rb * 32 + r32) * K + ks * 512 + 8 * hi;
        const bf16_t* bp0 = Wt + (size_t)(cb * 64 + r32) * K + ks * 512 + 8 * hi; const bf16_t* bp1 = bp0 + (size_t)32 * K;
        f32x16 c0, c1;
#pragma unroll
        for (int i = 0; i < 16; ++i) { c0[i] = 0.f; c1[i] = 0.f; }
        bf16x8 a[4], b0[4], b1[4];
#pragma unroll
        for (int j = 0; j < 4; ++j) { a[j] = *(const bf16x8*)(ap + 16 * j); b0[j] = *(const bf16x8*)(bp0 + 16 * j); b1[j] = *(const bf16x8*)(bp1 + 16 * j); }
#pragma unroll
        for (int g = 0; g < 8; ++g) {
            bf16x8 na[4], nb0[4], nb1[4];
            if (g < 7) {
#pragma unroll
                for (int j = 0; j < 4; ++j) { na[j] = *(const bf16x8*)(ap + 64 * (g + 1) + 16 * j); nb0[j] = *(const bf16x8*)(bp0 + 64 * (g + 1) + 16 * j); nb1[j] = *(const bf16x8*)(bp1 + 64 * (g + 1) + 16 * j); }
            }
#pragma unroll
            for (int j = 0; j < 4; ++j) { c0 = __builtin_amdgcn_mfma_f32_32x32x16_bf16(a[j], b0[j], c0, 0, 0, 0); c1 = __builtin_amdgcn_mfma_f32_32x32x16_bf16(a[j], b1[j], c1, 0, 0, 0); }
            if (g < 7) {
#pragma unroll
                for (int j = 0; j < 4; ++j) { a[j] = na[j]; b0[j] = nb0[j]; b1[j] = nb1[j]; }
            }
        }
        float* pp = P + ((size_t)ks * MS + rb * 32 + 4 * hi) * DM + cb * 64 + r32;
#pragma unroll
        for (int i = 0; i < 16; ++i) { const int row = (i & 3) + 8 * (i >> 2); pp[(size_t)row * DM] = c0[i]; pp[(size_t)row * DM + 32] = c1[i]; }
    }
}

constexpr int CTL_QUEUE = 16384;
DI void attn_even_phase(LAS unsigned char* lds) {
    const int bx = launder((int)blockIdx.x), G = launder((int)gridDim.x);
    const bool grouped = (G & 15) == 0;
    const int g = grouped ? (bx & 15) : 0, per_q = grouped ? 68 : 16 * 68;
    ArgsP a = fresh_args();
    unsigned* cnt = (unsigned*)(a->ws + CTL_QUEUE + g * 256);
    volatile LAS int* slot_w = (volatile LAS int*)(lds + 131072 + 128);
    for (;;) {
        __syncthreads();
        if (threadIdx.x == 0) slot_w[0] = (int)__hip_atomic_fetch_add(cnt, 1u, __ATOMIC_RELAXED, __HIP_MEMORY_SCOPE_AGENT);
        __syncthreads();
        int i = slot_w[0];
        if (i >= per_q) break;
        const int gg = grouped ? g : i / 68; i = grouped ? i : i % 68;
        int mode, s;
        if (i < 4) { const int q = gg * 4 + i; mode = q >> 5; s = 512 + (q & 31); }
        else { const int k = i - 4, u = 31 - (k >> 1); mode = k & 1; s = u >= 16 ? (((31 - u) << 4) | gg) : 256 + ((u << 4) | gg); }
        if (mode == 0) att::attn_unit<0>(lds, s); else att::attn_unit<1>(lds, s);
    }
}
DI void attn_odd_phase(LAS unsigned char* lds) {
    const int bx = launder((int)blockIdx.x), G = launder((int)gridDim.x);
    if (G == 256) {
        for (int i = 0; i < 6; ++i) {
            const int s = i == 0 ? (bx < 64 ? 1024 + bx : -1) : i <= 3 ? bx + 256 * (i - 1) : i == 4 ? (bx >= 64 ? 704 + bx : -1) : (bx >= 64 && bx < 128 ? 896 + bx : -1);
            if (s >= 0) att::attn_unit<2>(lds, s);
        }
    } else
    for (int s = bx; s < 1088; s += G) att::attn_unit<2>(lds, s);
}

typedef unsigned short bf16;
#define XB_TMO      128
#define XB_XCNT(j)  (256  + 64 * (j))
#define XB_XSUB(j)  (1280 + 64 * (j))
#define XB_XGEN(j)  (2304 + 64 * (j))
#define XB_TOP      3328
#define XB_TOPGEN   3392
#define XCD_BAR_WORDS 3456
#define XB_SPIN_CAP (1u << 18)

__device__ __forceinline__ unsigned xb_ld(unsigned* p)              { return __hip_atomic_load(p, __ATOMIC_RELAXED, __HIP_MEMORY_SCOPE_AGENT); }
__device__ __forceinline__ unsigned xb_add(unsigned* p, unsigned v) { return __hip_atomic_fetch_add(p, v, __ATOMIC_RELAXED, __HIP_MEMORY_SCOPE_AGENT); }
__device__ __forceinline__ unsigned xb_xcc_id() { return (unsigned)__builtin_amdgcn_s_getreg((3 << 11) | 20) & 0xFu; }
#define XB_SPIN(cond, bar) do { unsigned _sp = 0; while (cond) { __builtin_amdgcn_s_sleep(1); \
    if ((++_sp & 255u) == 0u) { if (xb_ld(&(bar)[XB_TMO])) break; if (_sp > XB_SPIN_CAP) { atomicAdd(&(bar)[XB_TMO], 1u); break; } } } } while (0)

struct XcdBarrier {
    unsigned* bar; unsigned x;
    volatile LAS unsigned* st;
};

__device__ __forceinline__ XcdBarrier xcd_barrier_post(unsigned* bar, volatile LAS unsigned* st) {
    XcdBarrier b; b.bar = bar; b.x = xb_xcc_id(); b.st = st;
    if (threadIdx.x == 0) (void)xb_add(&bar[XB_XCNT(b.x)], 1u);
    return b;
}
__device__ __forceinline__ void xcd_barrier_complete(unsigned* bar, unsigned x, unsigned& nloc, unsigned& nx) {
    const unsigned G = gridDim.x * gridDim.y * gridDim.z;
    unsigned sum, cnt, mine, sp = 0u;
    for (;;) {
        sum = 0u; cnt = 0u; mine = 0u;
#pragma unroll
        for (unsigned j = 0; j < 16; ++j) { const unsigned c = xb_ld(&bar[XB_XCNT(j)]); sum += c; cnt += (c > 0u) ? 1u : 0u; mine = (j == x) ? c : mine; }
        if (sum == G) break;
        __builtin_amdgcn_s_sleep(1);
        if ((++sp & 255u) == 0u) { if (xb_ld(&bar[XB_TMO])) break; if (sp > XB_SPIN_CAP) { atomicAdd(&bar[XB_TMO], 1u); break; } }
    }
    nloc = mine > 0u ? mine : 1u; nx = cnt > 0u ? cnt : 1u;
}

__device__ __forceinline__ void xcd_barrier(const XcdBarrier& b) {
    asm volatile("s_waitcnt vmcnt(0)" ::: "memory");
    __syncthreads();
    if (threadIdx.x == 0) {
        unsigned* bar = b.bar;
        __builtin_amdgcn_s_waitcnt(0);
        unsigned nloc = b.st[0], nx = b.st[1];
        if (nloc == 0u) { xcd_barrier_complete(bar, b.x, nloc, nx); b.st[0] = nloc; b.st[1] = nx; }
        const unsigned old = xb_add(&bar[XB_XSUB(b.x)], 1u);
        const unsigned gen = old / nloc;
        if (old + 1u == (gen + 1u) * nloc) {
            __builtin_amdgcn_fence(__ATOMIC_RELEASE, "agent");
            asm volatile("s_waitcnt vmcnt(0)" ::: "memory");
            const unsigned og = xb_add(&bar[XB_TOP], 1u);
            const unsigned tg = og / nx;
            if (og + 1u == (tg + 1u) * nx) xb_add(&bar[XB_TOPGEN], 1u);
            else XB_SPIN(xb_ld(&bar[XB_TOPGEN]) == tg, bar);
            __builtin_amdgcn_fence(__ATOMIC_ACQUIRE, "agent");
            xb_add(&bar[XB_XGEN(b.x)], 1u);
            asm volatile("s_waitcnt vmcnt(0)" ::: "memory");
        } else {
            XB_SPIN(xb_ld(&bar[XB_XGEN(b.x)]) == gen, bar);
            __builtin_amdgcn_fence(__ATOMIC_ACQUIRE, "agent");
            asm volatile("s_waitcnt vmcnt(0)" ::: "memory");
        }
    }
    __syncthreads();
}

template <int PH_LO, int PH_HI>
__global__ void __launch_bounds__(NTHR, 2) fwd_kernel(Args a_unused) {
    extern __shared__ __attribute__((aligned(16))) unsigned char lds_raw[];
    LAS unsigned char* lds = (LAS unsigned char*)lds_raw;
    cg::grid_group grid = cg::this_grid();
    constexpr bool ONE = (PH_HI - PH_LO) > 1;
    if (ONE) {
        { int t0 = threadIdx.x; if (t0 < 64) ((LAS unsigned*)(lds + 131072))[t0] = 0u; }
        __syncthreads();
        ArgsP a0 = fresh_args();
        (void)xcd_barrier_post((unsigned*)a0->ws, (volatile LAS unsigned*)(lds + 131072 + 32));
    }
#define IN(k) (PH_LO <= (k) && (k) < PH_HI)
#ifndef T_DUP
#define T_DUP (-1)
#endif
#define REPS(k) for (int rep_ = 0; rep_ < ((k) == T_DUP ? 2 : 1); ++rep_)
#define SEAM(k) do { if (IN(k) && IN((k) + 1)) { if (ab_never()) grid.sync(); { ArgsP ab = fresh_args(); XcdBarrier bb; bb.bar = (unsigned*)ab->ws; bb.x = xb_xcc_id(); bb.st = (volatile LAS unsigned*)(lds + 131072 + 32); xcd_barrier(bb); } } } while (0)
#define PHASE_ARGS int tid = threadIdx.x; asm volatile("" : "+v"(tid)); const int lane = tid & 63, wave = __builtin_amdgcn_readfirstlane(tid >> 6); (void)lane; (void)wave; ArgsP a = fresh_args(); unsigned char* ws = a->ws; (void)ws; const int bx_ = launder((int)blockIdx.x), G_ = launder((int)gridDim.x); (void)bx_; (void)G_
    if (IN(0)) REPS(0) { PHASE_ARGS; prologue_phase(lds, a, tid, lane, wave); __syncthreads(); }
    SEAM(0);
#pragma unroll
    for (int l = 0; l < 2; ++l) {
        const int p = l * 7;
        if (IN(p + 1)) REPS(p + 1) {
            PHASE_ARGS;
            if (l == 0) {
                if (bx_ >= 64 && bx_ < 76) scan_seq(a, (bx_ - 64) * 8 + wave, lane);
                else if (G_ < 76 && bx_ == 0) { for (int q = wave; q < 96; q += NWAVES) scan_seq(a, q, lane); }
                __syncthreads();
                pg8::Gemm g{(const bf16_t*)(ws + WS_XN), (const bf16_t*)(ws + WS_WINE), MT, 3072, DM}; pg8::StaticOrder S; S.init(MT, 3072, G_, bx_);
                EpiX<2> E{(bf16_t*)(ws + WS_Z), ZP, a->out};
                pg8::gemm_phase<EpiX<2>, pg8::StaticOrder, true, true>(lds, g, S, E);
            } else {
                pg8::Gemm g{(const bf16_t*)(ws + WS_XN), (const bf16_t*)(ws + WS_WINO), MT, 3072, DM}; pg8::StaticOrder S; S.init(MT, 3072, G_, bx_);
                EpiX<3> E{(bf16_t*)(ws + WS_Z), ZP, a->out};
                pg8::gemm_phase<EpiX<3>, pg8::StaticOrder, true, true>(lds, g, S, E);
            }
        }
        SEAM(p + 1);
        if (IN(p + 2)) REPS(p + 2) {
#ifndef T_NO_EVEN
            if (l == 0) attn_even_phase(lds);
#endif
#ifndef T_NO_ODD
            if (l == 1) attn_odd_phase(lds);
#endif
            __syncthreads(); }
        SEAM(p + 2);
        if (IN(p + 3)) REPS(p + 3) {
            PHASE_ARGS;
            sgemm_sample((const bf16_t*)(ws + WS_ATT) + (size_t)MP * DM, DM, (const bf16_t*)(ws + (l == 0 ? WS_WOUTE : WS_WOUTO)), (float*)(ws + WS_PART_OUT), bx_ * NWAVES + wave, G_ * NWAVES, lane);
            __syncthreads();
            pg8::Gemm g{(const bf16_t*)(ws + WS_ATT), (const bf16_t*)(ws + (l == 0 ? WS_WOUTE : WS_WOUTO)), MP, DM, DM}; pg8::StaticOrder S; S.init(MP, DM, G_, bx_);
            EpiX<0> E{(bf16_t*)(ws + WS_Y), DM, nullptr};
            pg8::gemm_phase<EpiX<0>, pg8::StaticOrder, true, true>(lds, g, S, E);
        }
        SEAM(p + 3);
        if (IN(p + 4)) REPS(p + 4) { PHASE_ARGS; rows_phase(a, a->in[I_GQM] + l * DM, a->in[I_GPF] + l * DM, (const float*)(ws + WS_PART_OUT), 2, lane, wave, l == 0, 1.f); }
        SEAM(p + 4);
        if (IN(p + 5)) REPS(p + 5) {
            PHASE_ARGS;
            pg8::Gemm g{(const bf16_t*)(ws + WS_XN), (const bf16_t*)(ws + (l ? WS_WUP1 : WS_WUP0)), MT, FF, DM}; pg8::StaticOrder S; S.init(MT, FF, G_, bx_);
            EpiX<1> E{(bf16_t*)(ws + WS_H), FF, nullptr};
            pg8::gemm_phase<EpiX<1>, pg8::StaticOrder, true, true>(lds, g, S, E);
        }
        SEAM(p + 5);
        if (IN(p + 6)) REPS(p + 6) {
            PHASE_ARGS;
            sgemm_sample((const bf16_t*)(ws + WS_H) + (size_t)MP * FF, FF, (const bf16_t*)(ws + (l ? WS_WDN1 : WS_WDN0)), (float*)(ws + WS_PART_DN), bx_ * NWAVES + wave, G_ * NWAVES, lane);
            __syncthreads();
            pg8::Gemm g{(const bf16_t*)(ws + WS_H), (const bf16_t*)(ws + (l ? WS_WDN1 : WS_WDN0)), MP, DM, FF}; pg8::StaticOrder S; S.init(MP, DM, G_, bx_);
            EpiX<0> E{(bf16_t*)(ws + WS_Y), DM, nullptr};
            pg8::gemm_phase<EpiX<0>, pg8::StaticOrder, true, true>(lds, g, S, E);
        }
        SEAM(p + 6);
        if (IN(p + 7)) REPS(p + 7) { PHASE_ARGS; rows_phase(a, a->in[I_GQF] + l * DM, l == 0 ? a->in[I_GPM] + DM : nullptr, (const float*)(ws + WS_PART_DN), 8, lane, wave); }
        SEAM(p + 7);
    }
#undef IN
#undef SEAM
}

#if MK_ONE_LAUNCH
#define KFN (fwd_kernel<0, 15>)
#else
#define KFN (fwd_kernel<0, 1>)
typedef void (*kfn_t)(Args);
static kfn_t kfns[15] = {fwd_kernel<0, 1>, fwd_kernel<1, 2>, fwd_kernel<2, 3>, fwd_kernel<3, 4>, fwd_kernel<4, 5>, fwd_kernel<5, 6>, fwd_kernel<6, 7>, fwd_kernel<7, 8>,
                         fwd_kernel<8, 9>, fwd_kernel<9, 10>, fwd_kernel<10, 11>, fwd_kernel<11, 12>, fwd_kernel<12, 13>, fwd_kernel<13, 14>, fwd_kernel<14, 15>};
#endif
extern "C" void kernel_launch(void* const* d_in, const int* in_sizes, int n_in, void* d_out, int out_size, void* d_ws, size_t ws_size, hipStream_t stream) {
    static int grid = 0;
    if (grid == 0) {
        if (n_in != N_IN || (size_t)out_size != O_END || ws_size < WS_END) { fprintf(stderr, "kernel_launch: unexpected shapes (n_in %d out %d ws %zu)\n", n_in, out_size, ws_size); grid = -1; return; }
        int dev = 0, cus = 0, per_cu = 0;
        (void)hipGetDevice(&dev); (void)hipDeviceGetAttribute(&cus, hipDeviceAttributeMultiprocessorCount, dev);
        if (hipFuncSetAttribute((const void*)KFN, hipFuncAttributeMaxDynamicSharedMemorySize, LDS_BYTES) != hipSuccess) { fprintf(stderr, "kernel_launch: hipFuncSetAttribute failed\n"); grid = -1; return; }
#if !MK_ONE_LAUNCH
        for (int k = 1; k < 15; ++k) (void)hipFuncSetAttribute((const void*)kfns[k], hipFuncAttributeMaxDynamicSharedMemorySize, LDS_BYTES);
#endif
        (void)hipOccupancyMaxActiveBlocksPerMultiprocessor(&per_cu, (const void*)KFN, NTHR, LDS_BYTES);
        if (per_cu < 1) per_cu = 1;
        (void)hipGetLastError();
        grid = cus * per_cu;
        fprintf(stderr, "kernel_launch: grid %d (cus %d x %d)\n", grid, cus, per_cu);
    }
    if (grid < 0) return;
    Args a{};
    for (int i = 0; i < N_IN; ++i) a.in[i] = (const float*)d_in[i];
    a.out = (float*)d_out; a.ws = (unsigned char*)d_ws;
#if MK_ONE_LAUNCH
    if (hipMemsetAsync(d_ws, 0, 32768, stream) != hipSuccess) { fprintf(stderr, "kernel_launch: memset failed\n"); return; }
    a.ph_lo = 0; a.ph_hi = 15;
    void* args[] = {&a};
    hipError_t e = hipLaunchCooperativeKernel((const void*)KFN, dim3(grid), dim3(NTHR), args, LDS_BYTES, stream);
    if (e != hipSuccess) fprintf(stderr, "cooperative launch failed: %s (grid %d)\n", hipGetErrorString(e), grid);
#else
    for (int k = 0; k < 15; ++k) { a.ph_lo = k; a.ph_hi = k + 1; hipLaunchKernelGGL(kfns[k], dim3(grid), dim3(NTHR), LDS_BYTES, stream, a); }
#endif
}
```

```cpp
#include <hip/hip_runtime.h>
#include <hip/hip_cooperative_groups.h>
#include <cstdio>
#include <cstdint>
namespace cg = cooperative_groups;
#ifndef MK_ONE_LAUNCH
#define MK_ONE_LAUNCH 1
#endif
namespace pg8 {
#define PG8_LAS __attribute__((address_space(3)))
typedef unsigned short bf16_t;
typedef short bf16x8 __attribute__((ext_vector_type(8)));
typedef float f32x4 __attribute__((ext_vector_type(4)));
typedef unsigned u32x4 __attribute__((ext_vector_type(4)));
constexpr int BM = 256, BK = 64, HALF = 128, HTB = HALF * BK * 2  , STAGE_BYTES = 8 * HTB, NXCD = 8, WGM = 8;

__host__ __device__ __forceinline__ int lds_byte(int r, int c) { const int st = (r >> 4) * 2 + (c >> 5), rr = r & 15, cc = c & 31, ob = rr * 64 + cc * 2; return st * 1024 + (ob ^ (((ob >> 9) & 1) << 5)); }
__host__ __device__ __forceinline__ void stage_rc(int b, int& R, int& C) { const int st = b / 1024, sb = b % 1024, swz = sb ^ (((sb >> 9) & 1) << 5); R = (st >> 1) * 16 + swz / 64; C = (st & 1) * 32 + (swz % 64) / 2; }
__host__ __device__ __forceinline__ int perm32(int rho) { const int n = rho >> 4, i = rho & 15; return 8 * (i >> 2) + 4 * n + (i & 3); }

struct Unit { int pm, pn; };
struct Gemm { const bf16_t* A; const bf16_t* Bt; int M, N, K; };

struct StaticOrder {
    int nM, nN, nwg, G, c;
    __host__ __device__ void init(int M, int N, int G_, int c_) { nM = M / BM; nN = N / BM; nwg = nM * nN; G = G_; c = c_; }
    __host__ __device__ bool next(int i, Unit& u) const {
        const long L = (long)i * G + c; if (L >= nwg) return false;
        int wgid = (int)L; { const int q = nwg / NXCD, r = nwg % NXCD, xcd = wgid % NXCD, off = wgid / NXCD; wgid = (xcd < r ? xcd * (q + 1) : r * (q + 1) + (xcd - r) * q) + off; }
        const int nig = WGM * nN, gid = wgid / nig, fm = gid * WGM, gsz = (nM - fm) < WGM ? (nM - fm) : WGM;
        u.pm = fm + ((wgid % nig) % gsz); u.pn = (wgid % nig) / gsz; return true;
    }
    __device__ __forceinline__ void a_ready(const Unit&) const {}
    __device__ __forceinline__ void done(const Unit&) const {}
};

__device__ __forceinline__ unsigned cvt_pk_bf16(float lo, float hi) { unsigned r; asm volatile("v_cvt_pk_bf16_f32 %0, %1, %2" : "=v"(r) : "v"(lo), "v"(hi)); return r; }
typedef float f32x2 __attribute__((ext_vector_type(2)));
template <class Epi, class Sched, bool ALIGN_EPI = false, bool SP2 = false>
__device__ __forceinline__ void gemm_phase(PG8_LAS unsigned char* lds, const Gemm g, const Sched& S, const Epi& E) {
    int tid_l = threadIdx.x; asm volatile("" : "+v"(tid_l));
    const int tid = tid_l, wid = __builtin_amdgcn_readfirstlane(tid >> 6), lane = tid & 63, wr = wid >> 2, wc = wid & 3, fr = lane & 15, fq = lane >> 4;
    const int K = g.K, nt = K / BK;
    unsigned voffA[2], voffB[2];
#pragma unroll
    for (int i = 0; i < 2; ++i) { int R, C; stage_rc(tid * 16 + i * 8192, R, C); const int Rb = Epi::PERM ? ((R & ~31) + perm32(R & 31)) : R;
        voffA[i] = (unsigned)(R * K + C) * 2u; voffB[i] = (unsigned)(Rb * K + C) * 2u; }
    const size_t kstep = (size_t)(BK * 2);
    const size_t hstep = (size_t)HALF * K * 2;
    const size_t tstep = 2 * hstep;
    const unsigned ldsw = (unsigned)wid * 1024u;
    const int aoff = lds_byte(wr * 64 + fr, fq * 8), boff = lds_byte(wc * 32 + fr, fq * 8);
#define PG8_SA(b, h) (((b) * 2 + (h)) * HTB)
#define PG8_SB(b, h) ((4 + (b) * 2 + (h)) * HTB)
#define PG8_STAGE(bufoff, gbase, voff) do { _Pragma("unroll") for (int _i = 0; _i < 2; ++_i) \
        __builtin_amdgcn_global_load_lds((const unsigned*)((const char*)(gbase) + (voff)[_i]), (PG8_LAS unsigned*)(lds + (bufoff) + ldsw + _i * 8192), 16, 0, 0); } while (0)
#define PG8_LDA(dst, b, h) do { _Pragma("unroll") for (int m = 0; m < 4; ++m) _Pragma("unroll") for (int k = 0; k < 2; ++k) dst[m][k] = *(const PG8_LAS bf16x8*)(lds + PG8_SA(b, h) + aoff + m * 2048 + k * 1024); } while (0)
#define PG8_LDB(dst, b, h) do { _Pragma("unroll") for (int n = 0; n < 2; ++n) _Pragma("unroll") for (int k = 0; k < 2; ++k) dst[n][k] = *(const PG8_LAS bf16x8*)(lds + PG8_SB(b, h) + boff + n * 2048 + k * 1024); } while (0)
#define PG8_MMA(ai, bj, At, Bt) do { __builtin_amdgcn_s_setprio(1); _Pragma("unroll") for (int m = 0; m < 4; ++m) _Pragma("unroll") for (int n = 0; n < 2; ++n) _Pragma("unroll") for (int k = 0; k < 2; ++k) \
        acc[ai][bj][m][n] = __builtin_amdgcn_mfma_f32_16x16x32_bf16(Bt[n][k], At[m][k], acc[ai][bj][m][n], 0, 0, 0); __builtin_amdgcn_s_setprio(0); } while (0)
#define PG8_WAIT_V(n) asm volatile("s_waitcnt vmcnt(" #n ")" ::: "memory")
#define PG8_WAIT_L(n) asm volatile("s_waitcnt lgkmcnt(" #n ")" ::: "memory")
#define PG8_BAR __builtin_amdgcn_s_barrier()
#define PG8_SCHED __builtin_amdgcn_sched_barrier(0)
    Unit cur, nxt; int ui = 0;
    if (!S.next(0, cur)) return;
    f32x4 acc[2][2][4][2];
#pragma unroll
    for (int a = 0; a < 2; ++a)
#pragma unroll
        for (int b = 0; b < 2; ++b)
#pragma unroll
            for (int m = 0; m < 4; ++m)
#pragma unroll
                for (int n = 0; n < 2; ++n) acc[a][b][m][n] = (f32x4){0.f, 0.f, 0.f, 0.f};
    bf16x8 At[4][2], B0[2][2], B1[2][2];
    const char* cA = (const char*)g.A + (size_t)cur.pm * tstep; const char* cB = (const char*)g.Bt + (size_t)cur.pn * tstep;
    S.a_ready(cur);
    if constexpr (SP2) {
        PG8_STAGE(PG8_SB(0, 0), cB, voffB); PG8_STAGE(PG8_SB(0, 1), cB + hstep, voffB); PG8_STAGE(PG8_SA(0, 0), cA, voffA); PG8_STAGE(PG8_SA(0, 1), cA + hstep, voffA);
        if (wr == 1) PG8_BAR;
        PG8_WAIT_V(2); PG8_BAR;
        PG8_STAGE(PG8_SB(1, 0), cB + kstep, voffB); PG8_STAGE(PG8_SA(1, 0), cA + kstep, voffA); PG8_STAGE(PG8_SB(1, 1), cB + hstep + kstep, voffB);
        PG8_WAIT_V(6); PG8_BAR;
    } else {
        PG8_STAGE(PG8_SB(0, 0), cB, voffB); PG8_STAGE(PG8_SA(0, 0), cA, voffA); PG8_STAGE(PG8_SB(0, 1), cB + hstep, voffB); PG8_STAGE(PG8_SA(0, 1), cA + hstep, voffA);
        if (wr == 1) PG8_BAR;
        PG8_WAIT_V(4); PG8_BAR;
        PG8_STAGE(PG8_SB(1, 0), cB + kstep, voffB); PG8_STAGE(PG8_SA(1, 0), cA + kstep, voffA); PG8_STAGE(PG8_SB(1, 1), cB + hstep + kstep, voffB);
        PG8_WAIT_V(6); PG8_BAR;
    }
    for (;;) {
        const bool has_next = S.next(ui + 1, nxt);
        const char* nA = has_next ? (const char*)g.A + (size_t)nxt.pm * tstep : cA; const char* nB = has_next ? (const char*)g.Bt + (size_t)nxt.pn * tstep : cB;
        for (int t = 0; t < nt; t += 2) {
            const bool last = (t == nt - 2);
            const char* a1 = cA + (size_t)(t + 1) * kstep;
            const char* a2 = last ? nA : cA + (size_t)(t + 2) * kstep; const char* b2 = last ? nB : cB + (size_t)(t + 2) * kstep;
            const char* a3 = a2 + kstep; const char* b3 = b2 + kstep;
            if (last && has_next) S.a_ready(nxt);
            if constexpr (SP2) {
            PG8_LDB(B0, 0, 0); PG8_LDB(B1, 0, 1); PG8_SCHED; PG8_LDA(At, 0, 0); PG8_STAGE(PG8_SA(1, 1), a1 + hstep, voffA);
            PG8_WAIT_V(8); PG8_WAIT_L(0); PG8_BAR; PG8_MMA(0, 0, At, B0); PG8_MMA(0, 1, At, B1); PG8_BAR; PG8_SCHED;
            PG8_LDA(At, 0, 1); PG8_STAGE(PG8_SB(0, 0), b2, voffB); PG8_STAGE(PG8_SB(0, 1), b2 + hstep, voffB); PG8_STAGE(PG8_SA(0, 0), a2, voffA);
            PG8_WAIT_V(8); PG8_WAIT_L(0); PG8_BAR; PG8_MMA(1, 0, At, B0); PG8_MMA(1, 1, At, B1); PG8_BAR; PG8_SCHED;
            PG8_LDB(B0, 1, 0); PG8_LDB(B1, 1, 1); PG8_SCHED; PG8_LDA(At, 1, 0); PG8_STAGE(PG8_SA(0, 1), a2 + hstep, voffA);
            PG8_WAIT_V(8); PG8_WAIT_L(0); PG8_BAR; PG8_MMA(0, 0, At, B0); PG8_MMA(0, 1, At, B1); PG8_BAR; PG8_SCHED;
            PG8_LDA(At, 1, 1); PG8_STAGE(PG8_SB(1, 0), b3, voffB); PG8_STAGE(PG8_SB(1, 1), b3 + hstep, voffB); PG8_STAGE(PG8_SA(1, 0), a3, voffA);
            PG8_WAIT_V(8); PG8_WAIT_L(0); PG8_BAR; PG8_MMA(1, 0, At, B0); PG8_MMA(1, 1, At, B1); PG8_BAR; PG8_SCHED;
            } else {
            PG8_LDB(B0, 0, 0); PG8_SCHED; PG8_LDA(At, 0, 0); PG8_STAGE(PG8_SA(1, 1), a1 + hstep, voffA);
            PG8_WAIT_L(8); PG8_BAR; PG8_WAIT_L(0); PG8_MMA(0, 0, At, B0); PG8_BAR; PG8_SCHED;
            PG8_LDB(B1, 0, 1); PG8_STAGE(PG8_SB(0, 0), b2, voffB);
            PG8_BAR; PG8_WAIT_L(0); PG8_MMA(0, 1, At, B1); PG8_BAR;
            PG8_LDA(At, 0, 1); PG8_STAGE(PG8_SA(0, 0), a2, voffA);
            PG8_BAR; PG8_WAIT_L(0); PG8_MMA(1, 0, At, B0); PG8_BAR; PG8_SCHED;
            PG8_STAGE(PG8_SB(0, 1), b2 + hstep, voffB);
            PG8_WAIT_V(6); PG8_BAR; PG8_MMA(1, 1, At, B1); PG8_BAR;
            PG8_LDB(B0, 1, 0); PG8_SCHED; PG8_LDA(At, 1, 0); PG8_STAGE(PG8_SA(0, 1), a2 + hstep, voffA);
            PG8_WAIT_L(8); PG8_BAR; PG8_WAIT_L(0); PG8_MMA(0, 0, At, B0); PG8_BAR; PG8_SCHED;
            PG8_LDB(B1, 1, 1); PG8_STAGE(PG8_SB(1, 0), b3, voffB);
            PG8_BAR; PG8_WAIT_L(0); PG8_MMA(0, 1, At, B1); PG8_BAR;
            PG8_LDA(At, 1, 1); PG8_STAGE(PG8_SA(1, 0), a3, voffA);
            PG8_BAR; PG8_WAIT_L(0); PG8_MMA(1, 0, At, B0); PG8_BAR; PG8_SCHED;
            PG8_STAGE(PG8_SB(1, 1), b3 + hstep, voffB);
            PG8_WAIT_V(6); PG8_BAR; PG8_MMA(1, 1, At, B1); PG8_BAR;
            }
        }
        if constexpr (ALIGN_EPI) { if (wr == 0) PG8_BAR; }
        if constexpr (!Epi::AFTER_DRAIN) { E(acc, cur, wr, wc, fr, fq); S.done(cur); }
        if (!has_next) break;
#pragma unroll
        for (int a = 0; a < 2; ++a)
#pragma unroll
            for (int b = 0; b < 2; ++b)
#pragma unroll
                for (int m = 0; m < 4; ++m)
#pragma unroll
                    for (int n = 0; n < 2; ++n) acc[a][b][m][n] = (f32x4){0.f, 0.f, 0.f, 0.f};
        cur = nxt; cA = nA; cB = nB; ++ui;
        if constexpr (ALIGN_EPI) { if (wr == 1) PG8_BAR; }
    }
    PG8_WAIT_V(0);
    if constexpr (!ALIGN_EPI) { if (wr == 0) PG8_BAR; }
    PG8_BAR;
    if constexpr (Epi::AFTER_DRAIN) { E.fused(acc, cur, wr, wc, fr, fq, lds, wid, lane); S.done(cur); }
#undef PG8_SA
#undef PG8_SB
#undef PG8_STAGE
#undef PG8_LDA
#undef PG8_LDB
#undef PG8_MMA
#undef PG8_WAIT_V
#undef PG8_WAIT_L
#undef PG8_BAR
#undef PG8_SCHED
}
}

typedef unsigned short bf16_t;
typedef short bf16x8 __attribute__((ext_vector_type(8)));
typedef short s16x4 __attribute__((ext_vector_type(4)));
typedef float f32x4 __attribute__((ext_vector_type(4)));
typedef float f32x2 __attribute__((ext_vector_type(2)));
typedef float f32x16 __attribute__((ext_vector_type(16)));
typedef unsigned u32x4 __attribute__((ext_vector_type(4)));
typedef unsigned u32x2 __attribute__((ext_vector_type(2)));
#define LAS __attribute__((address_space(3)))
#define DI __device__ __forceinline__

constexpr int DM = 1024, FF = 4096, MP = 16384, MS = 512, MT = MP + MS, SEQ = 4096, PAST = 1024, DSEQ = 64;
constexpr int ZP = 3072;
constexpr float LOG2E = 1.4426950408889634f;
constexpr float C2 = 0.125f * LOG2E;
constexpr float EPS = 1e-6f;
constexpr size_t O_YP = 0, O_YS = O_YP + (size_t)MP * DM, O_PAK = O_YS + (size_t)MS * DM, O_PAV = O_PAK + (size_t)MP * 512, O_PBK = O_PAV + (size_t)MP * 512,
                 O_PBV = O_PBK + (size_t)MP * 512, O_PBL = O_PBV + (size_t)MP * 512, O_PCK = O_PBL + (size_t)MP * 8, O_PCV = O_PCK + (size_t)4 * 512 * 1024,
                 O_SAK = O_PCV + (size_t)4 * 512 * 1024, O_SAV = O_SAK + (size_t)MS * 512, O_SBK = O_SAV + (size_t)MS * 512, O_SBV = O_SBK + (size_t)MS * 512,
                 O_SBL = O_SBV + (size_t)MS * 512, O_SCK = O_SBL + (size_t)MS * 8, O_SCV = O_SCK + (size_t)8 * 512 * 1024, O_END = O_SCV + (size_t)8 * 512 * 1024;
static_assert(O_END == 64622592, "output size");
constexpr size_t MiB = 1u << 20;
constexpr size_t WS_WINE = 1 * MiB, WS_WOUTE = 7 * MiB, WS_WUP0 = 9 * MiB, WS_WDN0 = 17 * MiB, WS_WINO = 25 * MiB, WS_WOUTO = 31 * MiB, WS_WUP1 = 33 * MiB, WS_WDN1 = 41 * MiB;
constexpr size_t WS_PART_DN = 1 * MiB;
constexpr size_t WS_PART_OUT = 116 * MiB;
constexpr size_t WS_XN = 49 * MiB, WS_Y = 82 * MiB, WS_CUMP = 115 * MiB, WS_CUMS = WS_CUMP + 524288, WS_Z = 116 * MiB, WS_ATT = 215 * MiB, WS_H = 116 * MiB, WS_END = 248 * MiB;
enum { I_XP = 0, I_XS, I_CAK, I_CAV, I_CBK, I_CBV, I_CBL, I_CCK, I_CCV, I_WINE, I_BF, I_LQ1, I_LK1, I_LQ2, I_LK2, I_SUBG, I_WOUTE, I_WINO, I_REL, I_WOUTO,
       I_GPM, I_GQM, I_GPF, I_GQF, I_WUP, I_WDN, N_IN };
constexpr int NWAVES = 8, NTHR = 512;
constexpr int LDS_BYTES = 147456;

struct Args { const float* in[N_IN]; float* out; unsigned char* ws; int ph_lo, ph_hi; };
typedef const __attribute__((address_space(4))) Args* ArgsP;
DI int launder(int v) { asm volatile("" : "+s"(v)); return v; }
DI bool ab_never();
DI ArgsP fresh_args() { ArgsP p = (ArgsP)__builtin_amdgcn_kernarg_segment_ptr(); asm volatile("" : "+s"(p)); return p; }

DI float wave_sum(float v) {
#pragma unroll
    for (int o = 1; o < 64; o <<= 1) v += __shfl_xor(v, o);
    return v;
}
DI unsigned pk2(float lo, float hi) { typedef __bf16 b2 __attribute__((ext_vector_type(2))); f32x2 v = {lo, hi}; b2 b = __builtin_convertvector(v, b2); return __builtin_bit_cast(unsigned, b); }
DI float bf2f(unsigned short h) { return __uint_as_float(((unsigned)h) << 16); }

DI bool ab_never() { return fresh_args()->ph_lo == 0x7fffffff; }

template <int MODE> struct EpiX {
    static constexpr bool PERM = true, AFTER_DRAIN = false;
    bf16_t* O; int ldc; float* out;
    __device__ __forceinline__ void operator()(const pg8::f32x4 (&acc)[2][2][4][2], const pg8::Unit& u, int wr, int wc, int fr, int fq) const {
        const unsigned loff = (unsigned)(fr * ldc + 8 * fq) * 2u;
        char* ub = (char*)O + ((size_t)(u.pm * 256 + wr * 64) * ldc + u.pn * 256 + wc * 32) * 2;
        float sc = 1.f; char* fb = nullptr; unsigned floff = 0; int fpitch = 0; bool smp3 = false;
        if (MODE == 2) {
            const int seg = u.pn >> 1; fpitch = 512; floff = (unsigned)(fr * 512 + 8 * fq) * 4u;
            if (seg == 0 || seg == 3) sc = C2;
            else {
                if (u.pm >= 64) {
                    const size_t off = seg == 1 ? O_SAK : seg == 2 ? O_SAV : seg == 4 ? O_SBK : O_SBV;
                    fb = (char*)(out + off + (size_t)((u.pm - 64) * 256 + wr * 64) * 512 + (u.pn & 1) * 256 + wc * 32);
                }
            }
        } else if (MODE == 3) {
            const int seg = u.pn >> 2; fpitch = 1024; floff = (unsigned)(fr * 1024 + 8 * fq) * 4u;
            if (seg == 0) sc = C2;
            else if (u.pm >= 64) { smp3 = true; fb = (char*)(out + (seg == 1 ? O_SCK : O_SCV) + (size_t)(((u.pm - 64) * 4 + wr) * 512 + 448) * 1024 + (u.pn & 3) * 256 + wc * 32); }
            else if ((u.pm & 15) >= 14) fb = (char*)(out + (seg == 1 ? O_PCK : O_PCV) + (size_t)((u.pm >> 4) * 512 + ((u.pm & 15) - 14) * 256 + wr * 64) * 1024 + (u.pn & 3) * 256 + wc * 32);
        }
#pragma unroll
        for (int ai = 0; ai < 2; ++ai)
#pragma unroll
            for (int m = 0; m < 4; ++m) {
                char* rb = ub + (size_t)(ai * 128 + m * 16) * ldc * 2;
                char* frb = nullptr;
                if (MODE >= 2 && fb) frb = fb + (size_t)((MODE == 3 && smp3) ? (ai * 1024 + m * 16) : (ai * 128 + m * 16)) * fpitch * 4;
#pragma unroll
                for (int bj = 0; bj < 2; ++bj) {
                    pg8::f32x4 v0 = acc[ai][bj][m][0], v1 = acc[ai][bj][m][1];
                    if (MODE >= 2 && frb) { *(pg8::f32x4*)(frb + bj * 512 + floff) = v0; *(pg8::f32x4*)(frb + bj * 512 + 16 + floff) = v1; }
                    if (MODE == 1) {
#pragma unroll
                        for (int e = 0; e < 4; ++e) { float a = fmaxf(v0[e], 0.f), b = fmaxf(v1[e], 0.f); v0[e] = a * a; v1[e] = b * b; }
                    }
                    if (MODE >= 2) { v0 = v0 * sc; v1 = v1 * sc; }
                    pg8::u32x4 w; w.x = pg8::cvt_pk_bf16(v0[0], v0[1]); w.y = pg8::cvt_pk_bf16(v0[2], v0[3]); w.z = pg8::cvt_pk_bf16(v1[0], v1[1]); w.w = pg8::cvt_pk_bf16(v1[2], v1[3]);
                    *(pg8::u32x4*)(rb + bj * 256 + loff) = w;
                }
                asm volatile("" ::: "memory");
            }
    }
};

namespace att {
constexpr int KP = 272, VP = 320;
constexpr int KT_B = 64 * KP, VT_B = 64 * VP;
constexpr int OFF_K = 0, OFF_V = 2 * KT_B, OFF_CUM = 2 * KT_B + 2 * VT_B  , OFF_TBL = OFF_CUM + 1024, OFF_END = OFF_TBL + 2 * 640 * 4;
static_assert(OFF_END <= 131072 && 65536 <= OFF_CUM, "attention LDS map");
struct Job {
    const bf16_t* q;
    const float* kc; const float* vc; int cpitch; int nc;
    const bf16_t* kz; const bf16_t* vz;
    int kt_lo, kt_hi, qpos0, kpos0, nq_sub;
    const float* cum; int cum_hs;
    const float* tbl;
    bf16_t* o;
    float slope2; const float* subg;
};
#define MFMA32(a, b, c) __builtin_amdgcn_mfma_f32_32x32x16_bf16((a), (b), (c), 0, 0, 0)
DI u32x4 pack8(const f32x4 a, const f32x4 b) { u32x4 r; r.x = pk2(a[0], a[1]); r.y = pk2(a[2], a[3]); r.z = pk2(b[0], b[1]); r.w = pk2(b[2], b[3]); return r; }
DI s16x4 vtr(const LAS unsigned char* p) { typedef short v4 __attribute__((ext_vector_type(4))); return __builtin_bit_cast(s16x4, __builtin_amdgcn_ds_read_tr16_b64_v4i16((LAS v4*)p)); }

DI void load_tile(const Job& J, int kt, int srow, int sch, u32x4& r0, u32x4& r1, u32x4& r2, u32x4& r3) {
    if (kt >= J.nc) {
        const size_t o0 = (size_t)((kt - J.nc) * 64 + srow) * ZP + sch * 8, o1 = o0 + (size_t)32 * ZP;
        r0 = *(const u32x4*)(J.kz + o0); r1 = *(const u32x4*)(J.kz + o1); r2 = *(const u32x4*)(J.vz + o0); r3 = *(const u32x4*)(J.vz + o1);
    }
}
template <int MODE> DI void store_tile(const Job& J, int kt, int buf, int srow, int sch, u32x4& r0, u32x4& r1, u32x4& r2, u32x4& r3, LAS unsigned char* lds, float* fk = nullptr, float* fv = nullptr, int own_lo = -4) {
    if (kt < J.nc) {
        const size_t o0 = (size_t)(kt * 64 + srow) * J.cpitch + sch * 8, o1 = o0 + (size_t)32 * J.cpitch;
        const f32x4 ka = *(const f32x4*)(J.kc + o0), kb_ = *(const f32x4*)(J.kc + o0 + 4), kc_ = *(const f32x4*)(J.kc + o1), kd = *(const f32x4*)(J.kc + o1 + 4);
        const f32x4 va = *(const f32x4*)(J.vc + o0), vb_ = *(const f32x4*)(J.vc + o0 + 4), vc_ = *(const f32x4*)(J.vc + o1), vd = *(const f32x4*)(J.vc + o1 + 4);
        if (MODE == 2 && fk && kt >= 1) {
            const size_t d0 = (size_t)(kt * 64 + srow) * 1024 + sch * 8, d1 = d0 + (size_t)32 * 1024;
            *(f32x4*)(fk + d0) = ka; *(f32x4*)(fk + d0 + 4) = kb_; *(f32x4*)(fk + d1) = kc_; *(f32x4*)(fk + d1 + 4) = kd;
            *(f32x4*)(fv + d0) = va; *(f32x4*)(fv + d0 + 4) = vb_; *(f32x4*)(fv + d1) = vc_; *(f32x4*)(fv + d1 + 4) = vd;
        }
        r0 = pack8(ka, kb_); r1 = pack8(kc_, kd); r2 = pack8(va, vb_); r3 = pack8(vc_, vd);
    }
    if (MODE < 2 && fk && (unsigned)(kt - own_lo) < 2u) {
        const size_t o0 = (size_t)(kt * 64 + srow) * 512 + sch * 8, o1 = o0 + (size_t)32 * 512;
#define BF_LO(w) __uint_as_float((w) << 16)
#define BF_HI(w) __uint_as_float((w) & 0xffff0000u)
#define ST8(p, r) do { *(f32x4*)(p) = (f32x4){BF_LO(r.x), BF_HI(r.x), BF_LO(r.y), BF_HI(r.y)}; *(f32x4*)((p) + 4) = (f32x4){BF_LO(r.z), BF_HI(r.z), BF_LO(r.w), BF_HI(r.w)}; } while (0)
        ST8(fk + o0, r0); ST8(fk + o1, r1); ST8(fv + o0, r2); ST8(fv + o1, r3);
#undef ST8
#undef BF_LO
#undef BF_HI
    }
    LAS unsigned char* kb = lds + OFF_K + buf * KT_B + srow * KP + sch * 16; LAS unsigned char* vb = lds + OFF_V + buf * VT_B + srow * VP + sch * 16;
    *(LAS u32x4*)kb = r0; *(LAS u32x4*)(kb + 32 * KP) = r1; *(LAS u32x4*)vb = r2; *(LAS u32x4*)(vb + 32 * VP) = r3;
}

template <int MODE> DI Job make_job(int s_) {
    const int s = launder(s_);
    ArgsP a = fresh_args(); Job J{};
    const bf16_t* z = (const bf16_t*)(a->ws + WS_Z); bf16_t* attb = (bf16_t*)(a->ws + WS_ATT);
    if (MODE < 2) {
        const int qcol = MODE == 0 ? 0 : 1536, kcol = MODE == 0 ? 512 : 2048, vcol = MODE == 0 ? 1024 : 2560, ocol = MODE == 0 ? 0 : 512;
        if (s < 512) {
            const int j = s & 255, u = (s >> 8) ? (j >> 4) : 31 - (j >> 4), bh = j & 15, b = bh >> 2, hh = bh & 3;
            const size_t row0 = (size_t)b * SEQ + 128 * u, rb = (size_t)b * SEQ;
            J.nc = 0; J.kt_lo = 0; J.kt_hi = 2 * u + 1; J.qpos0 = 128 * u; J.kpos0 = 0; J.nq_sub = 4;
            J.q = z + row0 * ZP + qcol + hh * 128; J.kz = z + rb * ZP + kcol + hh * 128; J.vz = z + rb * ZP + vcol + hh * 128; J.o = attb + row0 * DM + ocol + hh * 128;
            J.slope2 = exp2f(-2.f * (float)(hh + 1)) * LOG2E;
            J.cum = (const float*)(a->ws + WS_CUMP) + (size_t)(b * 8 + 2 * hh) * 4096; J.cum_hs = 4096;
        } else {
            const int jj = s - 512, b = jj >> 2, hh = jj & 3; const size_t row0 = (size_t)MP + b * DSEQ;
            J.nc = 16; J.cpitch = 512; J.kt_lo = 0; J.kt_hi = 16; J.qpos0 = PAST; J.kpos0 = 0; J.nq_sub = 2;
            J.q = z + row0 * ZP + qcol + hh * 128; J.kz = z + row0 * ZP + kcol + hh * 128; J.vz = z + row0 * ZP + vcol + hh * 128; J.o = attb + row0 * DM + ocol + hh * 128;
            J.kc = a->in[MODE == 0 ? I_CAK : I_CBK] + (size_t)b * PAST * 512 + hh * 128; J.vc = a->in[MODE == 0 ? I_CAV : I_CBV] + (size_t)b * PAST * 512 + hh * 128;
            J.slope2 = exp2f(-2.f * (float)(hh + 1)) * LOG2E;
            J.cum = (const float*)(a->ws + WS_CUMS) + (size_t)(b * 8 + 2 * hh) * 1088; J.cum_hs = 1088;
        }
        J.subg = a->in[I_SUBG];
    } else {
        if (s < 1024) {
            const int bh = s & 31, b = bh >> 3, hp = bh & 7, u = s >> 5; const size_t row0 = (size_t)b * SEQ + 128 * u, rb = (size_t)b * SEQ;
            J.q = z + row0 * ZP + hp * 128; J.kz = z + rb * ZP + 1024 + hp * 128; J.vz = z + rb * ZP + 2048 + hp * 128; J.o = attb + row0 * DM + hp * 128;
            J.nc = 0; J.kt_lo = 2 * u - 8 > 0 ? 2 * u - 8 : 0; J.kt_hi = 2 * u + 1; J.qpos0 = 128 * u; J.kpos0 = 0; J.nq_sub = 4; J.tbl = a->in[I_REL] + (size_t)(2 * hp) * 513;
        } else {
            const int id = s - 1024, b = id >> 3, hp = id & 7; const size_t row0 = (size_t)MP + b * DSEQ;
            J.q = z + row0 * ZP + hp * 128; J.kz = z + row0 * ZP + 1024 + hp * 128; J.vz = z + row0 * ZP + 2048 + hp * 128; J.o = attb + row0 * DM + hp * 128;
            J.kc = a->in[I_CCK] + (size_t)b * 512 * 1024 + hp * 128; J.vc = a->in[I_CCV] + (size_t)b * 512 * 1024 + hp * 128; J.cpitch = 1024; J.nc = 8;
            J.kt_lo = 0; J.kt_hi = 8; J.qpos0 = PAST; J.kpos0 = 512; J.nq_sub = 2; J.tbl = a->in[I_REL] + (size_t)(2 * hp) * 513;
        }
    }
    return J;
}

template <int MODE>
DI void attn_unit(LAS unsigned char* lds, const int slot) {
    constexpr int NDB = (MODE == 0) ? 4 : 2;
    int tid_l = threadIdx.x; asm volatile("" : "+v"(tid_l));
    const int tid = tid_l, lane = tid & 63, wid = __builtin_amdgcn_readfirstlane(tid >> 6);
    const int qs = wid >> 1, half = wid & 1, r32 = lane & 31, hi = lane >> 5;
    const int srow = tid >> 4, sch = tid & 15;
    const int qin = (32 * qs + r32) & 63;
    bool active; int qc_w, kc0, kt, nt, qk0;
    bf16x8 qr[4];
    u32x4 r0 = {0u, 0u, 0u, 0u}, r1 = r0, r2 = r0, r3 = r0, n0 = r0, n1 = r0, n2 = r0, n3 = r0; float cumv = 0.f, cumn = 0.f;
    __syncthreads();
    Job J = make_job<MODE>(slot);
    float* fk = nullptr; float* fv = nullptr; int own_lo = -4;
    if (MODE == 2 && slot >= 1024) {
        const int id = slot - 1024; ArgsP a = fresh_args();
        const size_t off = (size_t)(id >> 3) * 512 * 1024 + (id & 7) * 128;
        fk = a->out + O_SCK + off - (size_t)64 * 1024; fv = a->out + O_SCV + off - (size_t)64 * 1024;
    }
    if (MODE < 2 && slot < 512) {
        const int j = slot & 255, u = (slot >> 8) ? (j >> 4) : 31 - (j >> 4), bh = j & 15; ArgsP a = fresh_args();
        const size_t off = (size_t)(bh >> 2) * SEQ * 512 + (bh & 3) * 128;
        fk = a->out + (MODE == 0 ? O_PAK : O_PBK) + off; fv = a->out + (MODE == 0 ? O_PAV : O_PBV) + off; own_lo = 2 * u;
    }
    const float slope2 = J.slope2;
    {
        active = qs < J.nq_sub; qc_w = (J.qpos0 + 32 * qs) >> 6; kc0 = J.kpos0 >> 6; kt = J.kt_lo; nt = J.kt_hi - J.kt_lo + 1; qk0 = J.qpos0 - J.kpos0;
        if (MODE == 2) {
            for (int e = tid; e < 1280; e += NTHR) { const int hs = e >= 640 ? 1 : 0, idx = e - hs * 640, rel = idx - 63, c = (rel > 256 ? 256 : rel) + 256;
                ((LAS float*)(lds + OFF_TBL))[e] = J.tbl[hs * 513 + c] * LOG2E; }
        }
        const bf16_t* qp = J.q + (size_t)((active ? 32 * qs : 0) + r32) * ZP + half * 64 + 8 * hi;
#pragma unroll
        for (int d0 = 0; d0 < 4; ++d0) qr[d0] = *(const bf16x8*)(qp + 16 * d0);
        load_tile(J, kt, srow, sch, r0, r1, r2, r3);
        if (MODE == 1 && tid < 128) cumv = J.cum[(size_t)(tid >> 6) * J.cum_hs + kt * 64 + (tid & 63)];
        store_tile<MODE>(J, kt, 0, srow, sch, r0, r1, r2, r3, lds, fk, fv, own_lo);
        if (MODE == 1 && tid < 128) ((LAS float*)(lds + OFF_CUM))[tid] = cumv;
        if (nt > 1) { load_tile(J, kt + 1, srow, sch, r0, r1, r2, r3); if (MODE == 1 && tid < 128) cumv = J.cum[(size_t)(tid >> 6) * J.cum_hs + (kt + 1) * 64 + (tid & 63)]; }
    }
    f32x16 o[NDB];
#pragma unroll
    for (int d = 0; d < NDB; ++d)
#pragma unroll
        for (int i = 0; i < 16; ++i) o[d][i] = 0.f;
    float m_ref = 0.f, l_run = 0.f; bool first = true;
    __syncthreads();
    const int b16 = (lane >> 4) & 1, q4 = (lane & 15) >> 2, p4 = lane & 3;
    const int vcol0 = (MODE == 0) ? 0 : 64 * half;
    for (int it = 0; it < nt; ++kt) {
        {
        const int buf = it & 1; const bool more = it + 1 < nt;
        {
            if (it + 2 < nt) { load_tile(J, kt + 2, srow, sch, n0, n1, n2, n3); if (MODE == 1 && tid < 128) cumn = J.cum[(size_t)(tid >> 6) * J.cum_hs + (kt + 2) * 64 + (tid & 63)]; }
        }
        const int kc = kc0 + kt;
        const bool vis = active && kc <= qc_w && (MODE != 2 || kc >= qc_w - 8);
        if (vis) {
            const LAS unsigned char* Kb = lds + OFF_K + buf * KT_B + r32 * KP + half * 128 + hi * 16;
            const int qk = qk0 + 32 * qs + r32 - kt * 64 - 4 * hi;
            bf16x8 kf[8];
#pragma unroll
            for (int d0 = 0; d0 < 4; ++d0) { kf[2 * d0] = *(const LAS bf16x8*)(Kb + d0 * 32); kf[2 * d0 + 1] = *(const LAS bf16x8*)(Kb + 32 * KP + d0 * 32); }
            f32x16 p0, p1;
            if (MODE == 0) {
                if (kc < qc_w) {
                    const float base = fmaf(-slope2, (float)qk, -m_ref);
#pragma unroll
                    for (int i = 0; i < 16; ++i) { const float ci = (float)((i & 3) + 8 * (i >> 2)); p0[i] = fmaf(slope2, ci, base); p1[i] = fmaf(slope2, ci + 32.f, base); }
                } else {
                    const float qrel = (float)qk, nm = -m_ref;
#pragma unroll
                    for (int i = 0; i < 16; ++i) { const float ci = (float)((i & 3) + 8 * (i >> 2)); p0[i] = fmaf(-slope2, fabsf(qrel - ci), nm); p1[i] = fmaf(-slope2, fabsf(qrel - 32.f - ci), nm); }
                }
            } else if (MODE == 1) {
                const LAS float* ct = (const LAS float*)(lds + OFF_CUM) + buf * 128 + half * 64 + 4 * hi; const float nm = -m_ref;
#pragma unroll
                for (int g = 0; g < 4; ++g) { const f32x4 c0 = *(const LAS f32x4*)(ct + 8 * g), c1 = *(const LAS f32x4*)(ct + 32 + 8 * g);
#pragma unroll
                    for (int e = 0; e < 4; ++e) { p0[4 * g + e] = nm - c0[e]; p1[4 * g + e] = nm - c1[e]; } }
            } else {
                const LAS float* tb = (const LAS float*)(lds + OFF_TBL) + half * 640 + (qk + 63 - 59);
#pragma unroll
                for (int i = 0; i < 16; ++i) { const int ci = (i & 3) + 8 * (i >> 2); p0[i] = tb[59 - ci] - m_ref; p1[i] = tb[59 - 32 - ci] - m_ref; }
            }
            __builtin_amdgcn_sched_barrier(0);
#pragma unroll
            for (int d0 = 0; d0 < 4; ++d0) { p0 = MFMA32(kf[2 * d0], qr[d0], p0); p1 = MFMA32(kf[2 * d0 + 1], qr[d0], p1); }
            const LAS unsigned char* Vb = lds + OFF_V + buf * VT_B + (4 * hi + q4) * VP + (vcol0 + 16 * b16 + 4 * p4) * 2;
            s16x4 vr[2][NDB][2];
#pragma unroll
            for (int d = 0; d < NDB; ++d) { vr[0][d][0] = vtr(Vb + d * 64); vr[0][d][1] = vtr(Vb + d * 64 + 8 * VP); }
            __builtin_amdgcn_sched_barrier(0);
            if (MODE == 1 && kc == qc_w) {
#pragma unroll
                for (int i = 0; i < 16; ++i) { const int kin = (i & 3) + 8 * (i >> 2) + 4 * hi; if (kin > qin) p0[i] = -INFINITY; if (kin + 32 > qin) p1[i] = -INFINITY; }
            }
            float mx = fmaxf(fmaxf(p0[0], p1[0]), p0[1]);
#pragma unroll
            for (int i = 2; i < 16; i += 2) mx = fmaxf(fmaxf(mx, p0[i]), p0[i + 1]);
#pragma unroll
            for (int i = 1; i < 16; i += 2) mx = fmaxf(fmaxf(mx, p1[i]), p1[i + 1 < 16 ? i + 1 : i]);
            { auto rr = __builtin_amdgcn_permlane32_swap(__float_as_uint(mx), __float_as_uint(mx), false, false); mx = fmaxf(__uint_as_float(rr[0]), __uint_as_float(rr[1])); }
            if (first || __any(mx > 8.f)) {
                const float dl = first ? mx : fmaxf(mx, 0.f), f = first ? 1.f : __builtin_amdgcn_exp2f(-dl);
                m_ref += dl; l_run *= f;
#pragma unroll
                for (int i = 0; i < 16; ++i) { p0[i] -= dl; p1[i] -= dl; }
#pragma unroll
                for (int d = 0; d < NDB; ++d)
#pragma unroll
                    for (int i = 0; i < 16; ++i) o[d][i] *= f;
                first = false;
            }
            float ls = 0.f;
#pragma unroll
            for (int i = 0; i < 16; ++i) { p0[i] = __builtin_amdgcn_exp2f(p0[i]); p1[i] = __builtin_amdgcn_exp2f(p1[i]); ls += p0[i] + p1[i]; }
            l_run += ls;
            bf16x8 pf[4];
            { u32x4 t;
              t.x = pk2(p0[0], p0[1]); t.y = pk2(p0[2], p0[3]); t.z = pk2(p0[4], p0[5]); t.w = pk2(p0[6], p0[7]); pf[0] = __builtin_bit_cast(bf16x8, t);
              t.x = pk2(p0[8], p0[9]); t.y = pk2(p0[10], p0[11]); t.z = pk2(p0[12], p0[13]); t.w = pk2(p0[14], p0[15]); pf[1] = __builtin_bit_cast(bf16x8, t);
              t.x = pk2(p1[0], p1[1]); t.y = pk2(p1[2], p1[3]); t.z = pk2(p1[4], p1[5]); t.w = pk2(p1[6], p1[7]); pf[2] = __builtin_bit_cast(bf16x8, t);
              t.x = pk2(p1[8], p1[9]); t.y = pk2(p1[10], p1[11]); t.z = pk2(p1[12], p1[13]); t.w = pk2(p1[14], p1[15]); pf[3] = __builtin_bit_cast(bf16x8, t); }
#pragma unroll
            for (int ks = 0; ks < 4; ++ks) {
                if (ks < 3) {
#pragma unroll
                    for (int d = 0; d < NDB; ++d) { const LAS unsigned char* a = Vb + (16 * (ks + 1)) * VP + d * 64; vr[(ks + 1) & 1][d][0] = vtr(a); vr[(ks + 1) & 1][d][1] = vtr(a + 8 * VP); }
                }
                __builtin_amdgcn_sched_barrier(0);
#pragma unroll
                for (int d = 0; d < NDB; ++d) {
                    const bf16x8 vf = __builtin_shufflevector(vr[ks & 1][d][0], vr[ks & 1][d][1], 0, 1, 2, 3, 4, 5, 6, 7);
                    o[d] = MFMA32(vf, pf[ks], o[d]);
                }
                __builtin_amdgcn_sched_barrier(0);
            }
        }
        if (more) {
            store_tile<MODE>(J, kt + 1, buf ^ 1, srow, sch, r0, r1, r2, r3, lds, fk, fv, own_lo); if (MODE == 1 && tid < 128) ((LAS float*)(lds + OFF_CUM))[(buf ^ 1) * 128 + tid] = cumv;
        }
        __syncthreads();
        }
        ++it; ++kt;
        if (it >= nt) break;
        {
        const int buf = it & 1; const bool more = it + 1 < nt;
        {
            if (it + 2 < nt) { load_tile(J, kt + 2, srow, sch, r0, r1, r2, r3); if (MODE == 1 && tid < 128) cumv = J.cum[(size_t)(tid >> 6) * J.cum_hs + (kt + 2) * 64 + (tid & 63)]; }
        }
        const int kc = kc0 + kt;
        const bool vis = active && kc <= qc_w && (MODE != 2 || kc >= qc_w - 8);
        if (vis) {
            const LAS unsigned char* Kb = lds + OFF_K + buf * KT_B + r32 * KP + half * 128 + hi * 16;
            const int qk = qk0 + 32 * qs + r32 - kt * 64 - 4 * hi;
            bf16x8 kf[8];
#pragma unroll
            for (int d0 = 0; d0 < 4; ++d0) { kf[2 * d0] = *(const LAS bf16x8*)(Kb + d0 * 32); kf[2 * d0 + 1] = *(const LAS bf16x8*)(Kb + 32 * KP + d0 * 32); }
            f32x16 p0, p1;
            if (MODE == 0) {
                if (kc < qc_w) {
                    const float base = fmaf(-slope2, (float)qk, -m_ref);
#pragma unroll
                    for (int i = 0; i < 16; ++i) { const float ci = (float)((i & 3) + 8 * (i >> 2)); p0[i] = fmaf(slope2, ci, base); p1[i] = fmaf(slope2, ci + 32.f, base); }
                } else {
                    const float qrel = (float)qk, nm = -m_ref;
#pragma unroll
                    for (int i = 0; i < 16; ++i) { const float ci = (float)((i & 3) + 8 * (i >> 2)); p0[i] = fmaf(-slope2, fabsf(qrel - ci), nm); p1[i] = fmaf(-slope2, fabsf(qrel - 32.f - ci), nm); }
                }
            } else if (MODE == 1) {
                const LAS float* ct = (const LAS float*)(lds + OFF_CUM) + buf * 128 + half * 64 + 4 * hi; const float nm = -m_ref;
#pragma unroll
                for (int g = 0; g < 4; ++g) { const f32x4 c0 = *(const LAS f32x4*)(ct + 8 * g), c1 = *(const LAS f32x4*)(ct + 32 + 8 * g);
#pragma unroll
                    for (int e = 0; e < 4; ++e) { p0[4 * g + e] = nm - c0[e]; p1[4 * g + e] = nm - c1[e]; } }
            } else {
                const LAS float* tb = (const LAS float*)(lds + OFF_TBL) + half * 640 + (qk + 63 - 59);
#pragma unroll
                for (int i = 0; i < 16; ++i) { const int ci = (i & 3) + 8 * (i >> 2); p0[i] = tb[59 - ci] - m_ref; p1[i] = tb[59 - 32 - ci] - m_ref; }
            }
            __builtin_amdgcn_sched_barrier(0);
#pragma unroll
            for (int d0 = 0; d0 < 4; ++d0) { p0 = MFMA32(kf[2 * d0], qr[d0], p0); p1 = MFMA32(kf[2 * d0 + 1], qr[d0], p1); }
            const LAS unsigned char* Vb = lds + OFF_V + buf * VT_B + (4 * hi + q4) * VP + (vcol0 + 16 * b16 + 4 * p4) * 2;
            s16x4 vr[2][NDB][2];
#pragma unroll
            for (int d = 0; d < NDB; ++d) { vr[0][d][0] = vtr(Vb + d * 64); vr[0][d][1] = vtr(Vb + d * 64 + 8 * VP); }
            __builtin_amdgcn_sched_barrier(0);
            if (MODE == 1 && kc == qc_w) {
#pragma unroll
                for (int i = 0; i < 16; ++i) { const int kin = (i & 3) + 8 * (i >> 2) + 4 * hi; if (kin > qin) p0[i] = -INFINITY; if (kin + 32 > qin) p1[i] = -INFINITY; }
            }
            float mx = fmaxf(fmaxf(p0[0], p1[0]), p0[1]);
#pragma unroll
            for (int i = 2; i < 16; i += 2) mx = fmaxf(fmaxf(mx, p0[i]), p0[i + 1]);
#pragma unroll
            for (int i = 1; i < 16; i += 2) mx = fmaxf(fmaxf(mx, p1[i]), p1[i + 1 < 16 ? i + 1 : i]);
            { auto rr = __builtin_amdgcn_permlane32_swap(__float_as_uint(mx), __float_as_uint(mx), false, false); mx = fmaxf(__uint_as_float(rr[0]), __uint_as_float(rr[1])); }
            if (first || __any(mx > 8.f)) {
                const float dl = first ? mx : fmaxf(mx, 0.f), f = first ? 1.f : __builtin_amdgcn_exp2f(-dl);
                m_ref += dl; l_run *= f;
#pragma unroll
                for (int i = 0; i < 16; ++i) { p0[i] -= dl; p1[i] -= dl; }
#pragma unroll
                for (int d = 0; d < NDB; ++d)
#pragma unroll
                    for (int i = 0; i < 16; ++i) o[d][i] *= f;
                first = false;
            }
            float ls = 0.f;
#pragma unroll
            for (int i = 0; i < 16; ++i) { p0[i] = __builtin_amdgcn_exp2f(p0[i]); p1[i] = __builtin_amdgcn_exp2f(p1[i]); ls += p0[i] + p1[i]; }
            l_run += ls;
            bf16x8 pf[4];
            { u32x4 t;
              t.x = pk2(p0[0], p0[1]); t.y = pk2(p0[2], p0[3]); t.z = pk2(p0[4], p0[5]); t.w = pk2(p0[6], p0[7]); pf[0] = __builtin_bit_cast(bf16x8, t);
              t.x = pk2(p0[8], p0[9]); t.y = pk2(p0[10], p0[11]); t.z = pk2(p0[12], p0[13]); t.w = pk2(p0[14], p0[15]); pf[1] = __builtin_bit_cast(bf16x8, t);
              t.x = pk2(p1[0], p1[1]); t.y = pk2(p1[2], p1[3]); t.z = pk2(p1[4], p1[5]); t.w = pk2(p1[6], p1[7]); pf[2] = __builtin_bit_cast(bf16x8, t);
              t.x = pk2(p1[8], p1[9]); t.y = pk2(p1[10], p1[11]); t.z = pk2(p1[12], p1[13]); t.w = pk2(p1[14], p1[15]); pf[3] = __builtin_bit_cast(bf16x8, t); }
#pragma unroll
            for (int ks = 0; ks < 4; ++ks) {
                if (ks < 3) {
#pragma unroll
                    for (int d = 0; d < NDB; ++d) { const LAS unsigned char* a = Vb + (16 * (ks + 1)) * VP + d * 64; vr[(ks + 1) & 1][d][0] = vtr(a); vr[(ks + 1) & 1][d][1] = vtr(a + 8 * VP); }
                }
                __builtin_amdgcn_sched_barrier(0);
#pragma unroll
                for (int d = 0; d < NDB; ++d) {
                    const bf16x8 vf = __builtin_shufflevector(vr[ks & 1][d][0], vr[ks & 1][d][1], 0, 1, 2, 3, 4, 5, 6, 7);
                    o[d] = MFMA32(vf, pf[ks], o[d]);
                }
                __builtin_amdgcn_sched_barrier(0);
            }
        }
        if (more) {
            store_tile<MODE>(J, kt + 1, buf ^ 1, srow, sch, n0, n1, n2, n3, lds, fk, fv, own_lo); if (MODE == 1 && tid < 128) ((LAS float*)(lds + OFF_CUM))[(buf ^ 1) * 128 + tid] = cumn;
        }
        __syncthreads();
        }
        ++it;
    }
    const float l_tot = l_run + __shfl_xor(l_run, 32);
    const float inv = active ? 1.f / l_tot : 0.f;
    if (MODE != 0) {
        if (active) {
            const Job J = make_job<MODE>(slot);
            bf16_t* op = J.o + (size_t)(32 * qs + r32) * DM + half * 64 + 4 * hi;
#pragma unroll
            for (int d = 0; d < NDB; ++d)
#pragma unroll
                for (int g = 0; g < 4; ++g) { u32x2 w; w.x = pk2(o[d][4 * g] * inv, o[d][4 * g + 1] * inv); w.y = pk2(o[d][4 * g + 2] * inv, o[d][4 * g + 3] * inv);
                    *(u32x2*)(op + 32 * d + 8 * g) = w; }
        }
    } else {
        LAS float* ex = (LAS float*)lds + qs * 4096 + lane;
        if (active && half == 1) {
#pragma unroll
            for (int d = 0; d < NDB; ++d)
#pragma unroll
                for (int i = 0; i < 16; ++i) ex[(d * 16 + i) * 64] = o[d][i] * inv;
        }
        __syncthreads();
        if (active && half == 0) {
            const Job J = make_job<MODE>(slot);
            ArgsP a = fresh_args();
            const float lam = expf(wave_sum(a->in[I_LQ1][lane] * a->in[I_LK1][lane])) - expf(wave_sum(a->in[I_LQ2][lane] * a->in[I_LK2][lane])) + 0.2f;
            float ss = 0.f;
#pragma unroll
            for (int d = 0; d < NDB; ++d)
#pragma unroll
                for (int i = 0; i < 16; ++i) { const float v = o[d][i] * inv - lam * ex[(d * 16 + i) * 64]; o[d][i] = v; ss += v * v; }
            ss += __shfl_xor(ss, 32);
            const float rs = rsqrtf(ss * (1.f / 128.f) + EPS) * 0.8f;
            bf16_t* op = J.o + (size_t)(32 * qs + r32) * DM + 4 * hi;
#pragma unroll
            for (int d = 0; d < NDB; ++d)
#pragma unroll
                for (int g = 0; g < 4; ++g) { const f32x4 gg = *(const f32x4*)(J.subg + 32 * d + 8 * g + 4 * hi);
                    u32x2 w; w.x = pk2(o[d][4 * g] * rs * gg[0], o[d][4 * g + 1] * rs * gg[1]); w.y = pk2(o[d][4 * g + 2] * rs * gg[2], o[d][4 * g + 3] * rs * gg[3]);
                    *(u32x2*)(op + 32 * d + 8 * g) = w; }
        }
    }
}
}

#define LDS_WAIT() asm volatile("s_waitcnt lgkmcnt(0)" ::: "memory")
DI void transpose_item(const float* W, int ldw, int K, int nblk, bf16_t* WT, LAS float* scr, int item, int lane) {
    const int kb = item / nblk, nb = item - kb * nblk, k0 = 64 * kb, n0 = 32 * nb;
    float wv[32];
#pragma unroll
    for (int i = 0; i < 32; ++i) wv[i] = W[(size_t)(k0 + 2 * i + (lane >> 5)) * ldw + n0 + (lane & 31)];
#pragma unroll
    for (int i = 0; i < 32; ++i) scr[(2 * i + (lane >> 5)) * 33 + (lane & 31)] = wv[i];
    LDS_WAIT();
    const int c = lane & 7;
#pragma unroll
    for (int j = 0; j < 4; ++j) { const int n = (lane >> 3) + 8 * j; const LAS float* s = scr + (8 * c) * 33 + n;
        u32x4 o; o.x = pk2(s[0 * 33], s[1 * 33]); o.y = pk2(s[2 * 33], s[3 * 33]); o.z = pk2(s[4 * 33], s[5 * 33]); o.w = pk2(s[6 * 33], s[7 * 33]);
        *(u32x4*)(WT + (size_t)(n0 + n) * K + k0 + 8 * c) = o; }
    LDS_WAIT();
}
DI float log_sigmoid(float x) { return fminf(x, 0.f) - log1pf(expf(-fabsf(x))); }

DI void prologue_phase(LAS unsigned char* lds, ArgsP a, int tid, int lane, int wave) {
    unsigned char* ws = a->ws;
    const int gw = launder((int)blockIdx.x) * NWAVES + wave, NGW = launder((int)gridDim.x) * NWAVES;
    {
        LAS float* scr = (LAS float*)(lds + wave * 8448);
        constexpr int I_IN = 16 * 96, I_O = 16 * 32, I_UP = 16 * 128, I_DN = 64 * 32;
        constexpr int NITEMS = 2 * I_IN + 2 * I_O + 2 * I_UP + 2 * I_DN;
        for (int it = gw; it < NITEMS; it += NGW) {
            int r = it;
            if (r < I_IN) { transpose_item(a->in[I_WINE], 3080, 1024, 96, (bf16_t*)(ws + WS_WINE), scr, r, lane); continue; } r -= I_IN;
            if (r < I_IN) { transpose_item(a->in[I_WINO], 3072, 1024, 96, (bf16_t*)(ws + WS_WINO), scr, r, lane); continue; } r -= I_IN;
            if (r < I_O) { transpose_item(a->in[I_WOUTE], 1024, 1024, 32, (bf16_t*)(ws + WS_WOUTE), scr, r, lane); continue; } r -= I_O;
            if (r < I_O) { transpose_item(a->in[I_WOUTO], 1024, 1024, 32, (bf16_t*)(ws + WS_WOUTO), scr, r, lane); continue; } r -= I_O;
            if (r < 2 * I_UP) { const int l = r / I_UP; transpose_item(a->in[I_WUP] + (size_t)l * 1024 * 4096, 4096, 1024, 128, (bf16_t*)(ws + (l ? WS_WUP1 : WS_WUP0)), scr, r - l * I_UP, lane); continue; } r -= 2 * I_UP;
            { const int l = r / I_DN; transpose_item(a->in[I_WDN] + (size_t)l * 4096 * 1024, 1024, 4096, 32, (bf16_t*)(ws + (l ? WS_WDN1 : WS_WDN0)), scr, r - l * I_DN, lane); }
        }
    }
    LAS float* wf = (LAS float*)(lds + 98304);
    __syncthreads();
    for (int e = tid; e < 8192; e += NTHR) { const int k = e >> 3, o = e & 7; wf[o * 1024 + k] = a->in[I_WINE][(size_t)k * 3080 + 3072 + o]; }
    __syncthreads();
    const float* gp = a->in[I_GPM]; bf16_t* xn = (bf16_t*)(ws + WS_XN);
    f32x4 g[4];
#pragma unroll
    for (int j = 0; j < 4; ++j) g[j] = ((const f32x4*)gp)[lane + 64 * j];
    for (int m = gw; m < MT; m += NGW) {
        const float* xr = m < MP ? a->in[I_XP] + (size_t)m * DM : a->in[I_XS] + (size_t)(m - MP) * DM;
        f32x4 v[4]; float ss = 0.f;
#pragma unroll
        for (int j = 0; j < 4; ++j) { v[j] = ((const f32x4*)xr)[lane + 64 * j]; ss += (v[j].x * v[j].x + v[j].y * v[j].y) + (v[j].z * v[j].z + v[j].w * v[j].w); }
        const float rstd = rsqrtf(wave_sum(ss) * (1.f / DM) + EPS);
#pragma unroll
        for (int j = 0; j < 4; ++j) { v[j] = v[j] * rstd * g[j]; u32x2 w; w.x = pk2(v[j].x, v[j].y); w.y = pk2(v[j].z, v[j].w); ((u32x2*)(xn + (size_t)m * DM))[lane + 64 * j] = w; }
        float mine = 0.f;
#pragma unroll
        for (int o = 0; o < 8; ++o) { float acc = 0.f;
#pragma unroll
            for (int j = 0; j < 4; ++j) { const f32x4 w = *(const LAS f32x4*)(wf + o * 1024 + 4 * (lane + 64 * j)); acc += (v[j].x * w.x + v[j].y * w.y) + (v[j].z * w.z + v[j].w * w.w); }
            acc = wave_sum(acc); if (lane == o) mine = acc; }
        if (lane < 8) { const float lf = log_sigmoid(mine + a->in[I_BF][lane]);
            if (m < MP) a->out[O_PBL + (size_t)m * 8 + lane] = lf; else a->out[O_SBL + (size_t)(m - MP) * 8 + lane] = lf; }
    }
}

template <int N> DI void scan_seq_n(const float* src0, const float* src1, int split, float* dst, int lane) {
    const int i0 = lane * N;
    float v[N];
#pragma unroll
    for (int i = 0; i < N; ++i) { const int idx = i0 + i; v[i] = idx >= split ? src1[(size_t)(idx - split) * 8] : src0[(size_t)idx * 8]; }
    float tot = 0.f;
#pragma unroll
    for (int i = 0; i < N; ++i) tot += v[i];
    float x = tot;
#pragma unroll
    for (int o = 1; o < 64; o <<= 1) { const float t = __shfl_up(x, o); if (lane >= o) x += t; }
    float run = x - tot;
#pragma unroll
    for (int i = 0; i < N; ++i) { run += v[i]; dst[i0 + i] = run * LOG2E; }
}
DI void scan_seq(ArgsP a, int seq, int lane) {
    float* cump = (float*)(a->ws + WS_CUMP); float* cums = (float*)(a->ws + WS_CUMS);
    const bool smp = seq >= 32; const int s = smp ? seq - 32 : seq, b = s >> 3, h = s & 7;
    if (!smp) scan_seq_n<64>(a->out + O_PBL + (size_t)b * 4096 * 8 + h, nullptr, 1 << 30, cump + (size_t)(b * 8 + h) * 4096, lane);
    else scan_seq_n<17>(a->in[I_CBL] + (size_t)b * 1024 * 8 + h, a->out + O_SBL + (size_t)b * 64 * 8 + h, 1024, cums + (size_t)(b * 8 + h) * 1088, lane);
}

constexpr int RW = 3;
DI void rows_phase(ArgsP a, const float* gpost, const float* gnext, const float* part, int nparts, int lane, int wave, bool x_from_input = false, float scl = 1.f) {
    const bf16_t* Y = (const bf16_t*)(a->ws + WS_Y); bf16_t* xn = (bf16_t*)(a->ws + WS_XN); float* X = a->out;
    const int gw = launder((int)blockIdx.x) * NWAVES + wave, NGW = launder((int)gridDim.x) * NWAVES;
    f32x4 gp[4], gn[4];
#pragma unroll
    for (int j = 0; j < 4; ++j) { gp[j] = ((const f32x4*)gpost)[lane + 64 * j]; gn[j] = gnext ? ((const f32x4*)gnext)[lane + 64 * j] : (f32x4){0.f, 0.f, 0.f, 0.f}; }
    for (int m0 = gw; m0 < MT; m0 += RW * NGW) {
        f32x4 y[RW][4], x[RW][4];
#pragma unroll
        for (int r = 0; r < RW; ++r) {
            const int m = m0 + r * NGW;
            if (m < MT) {
#pragma unroll
                for (int j = 0; j < 4; ++j) {
                    if (m < MP) { const u32x2 w = ((const u32x2*)(Y + (size_t)m * DM))[lane + 64 * j];
                        y[r][j].x = __uint_as_float(w.x << 16); y[r][j].y = __uint_as_float(w.x & 0xffff0000u); y[r][j].z = __uint_as_float(w.y << 16); y[r][j].w = __uint_as_float(w.y & 0xffff0000u); }
                    else { f32x4 t[8];
#pragma unroll
                        for (int p = 0; p < 8; ++p) t[p] = p < nparts ? ((const f32x4*)(part + ((size_t)p * MS + (m - MP)) * DM))[lane + 64 * j] : (f32x4){0.f, 0.f, 0.f, 0.f};
                        y[r][j] = ((t[0] + t[1]) + (t[2] + t[3])) + ((t[4] + t[5]) + (t[6] + t[7])); }
                    x[r][j] = ((const f32x4*)(x_from_input ? (m < MP ? a->in[I_XP] + (size_t)m * DM : a->in[I_XS] + (size_t)(m - MP) * DM) : X + (size_t)m * DM))[lane + 64 * j];
                }
            }
        }
#pragma unroll
        for (int r = 0; r < RW; ++r) {
            const int m = m0 + r * NGW;
            if (m < MT) {
                float ss = 0.f;
#pragma unroll
                for (int j = 0; j < 4; ++j) ss += (y[r][j].x * y[r][j].x + y[r][j].y * y[r][j].y) + (y[r][j].z * y[r][j].z + y[r][j].w * y[r][j].w);
                const float rstd = rsqrtf(wave_sum(ss) * (1.f / DM) + EPS);
                float s2 = 0.f;
#pragma unroll
                for (int j = 0; j < 4; ++j) { x[r][j] = x[r][j] + y[r][j] * (rstd * scl) * gp[j];
                    ((f32x4*)(X + (size_t)m * DM))[lane + 64 * j] = x[r][j]; s2 += (x[r][j].x * x[r][j].x + x[r][j].y * x[r][j].y) + (x[r][j].z * x[r][j].z + x[r][j].w * x[r][j].w); }
                if (gnext) {
                    const float r2 = rsqrtf(wave_sum(s2) * (1.f / DM) + EPS);
#pragma unroll
                    for (int j = 0; j < 4; ++j) { const f32x4 h = x[r][j] * r2 * gn[j];
                        u32x2 w; w.x = pk2(h.x, h.y); w.y = pk2(h.z, h.w); ((u32x2*)(xn + (size_t)m * DM))[lane + 64 * j] = w; }
                }
            }
        }
    }
}

DI void sgemm_sample(const bf16_t* A, int K, const bf16_t* Wt, float* P, int gw, int NGW, int lane) {
    const int r32 = lane & 31, hi = lane >> 5, nks = K >> 9, nunits = 16 * 16 * nks;
    for (int u = gw; u < nunits; u += NGW) {
        const int ks = u % nks, t = u / nks, cb = t & 15, rb = t >> 4;
        const bf16_t* ap = A + (size_t)(rb * 32 + r32) * K + ks * 512 + 8 * hi;
        const bf16_t* bp0 = Wt + (size_t)(cb * 64 + r32) * K + ks * 512 + 8 * hi; const bf16_t* bp1 = bp0 + (size_t)32 * K;
        f32x16 c0, c1;
#pragma unroll
        for (int i = 0; i < 16; ++i) { c0[i] = 0.f; c1[i] = 0.f; }
        bf16x8 a[4], b0[4], b1[4];
#pragma unroll
        for (int j = 0; j < 4; ++j) { a[j] = *(const bf16x8*)(ap + 16 * j); b0[j] = *(const bf16x8*)(bp0 + 16 * j); b1[j] = *(const bf16x8*)(bp1 + 16 * j); }
#pragma unroll
        for (int g = 0; g < 8; ++g) {
            bf16x8 na[4], nb0[4], nb1[4];
            if (g < 7) {
#pragma unroll
                for (int j = 0; j < 4; ++j) { na[j] = *(const bf16x8*)(ap + 64 * (g + 1) + 16 * j); nb0[j] = *(const bf16x8*)(bp0 + 64 * (g + 1) + 16 * j); nb1[j] = *(const bf16x8*)(bp1 + 64 * (g + 1) + 16 * j); }
            }
#pragma unroll
            for (int j = 0; j < 4; ++j) { c0 = __builtin_amdgcn_mfma_f32_32x32x16_bf16(a[j], b0[j], c0, 0, 0, 0); c1 = __builtin_amdgcn_mfma_f32_32x32x16_bf16(a[j], b1[j], c1, 0, 0, 0); }
            if (g < 7) {
#pragma unroll
                for (int j = 0; j < 4; ++j) { a[j] = na[j]; b0[j] = nb0[j]; b1[j] = nb1[j]; }
            }
        }
        float* pp = P + ((size_t)ks * MS + rb * 32 + 4 * hi) * DM + cb * 64 + r32;
#pragma unroll
        for (int i = 0; i < 16; ++i) { const int row = (i & 3) + 8 * (i >> 2); pp[(size_t)row * DM] = c0[i]; pp[(size_t)row * DM + 32] = c1[i]; }
    }
}

constexpr int CTL_QUEUE = 16384;
DI void attn_even_phase(LAS unsigned char* lds) {
    const int bx = launder((int)blockIdx.x), G = launder((int)gridDim.x);
    const bool grouped = (G & 15) == 0;
    const int g = grouped ? (bx & 15) : 0, per_q = grouped ? 68 : 16 * 68;
    ArgsP a = fresh_args();
    unsigned* cnt = (unsigned*)(a->ws + CTL_QUEUE + g * 256);
    volatile LAS int* slot_w = (volatile LAS int*)(lds + 131072 + 128);
    for (;;) {
        __syncthreads();
        if (threadIdx.x == 0) slot_w[0] = (int)__hip_atomic_fetch_add(cnt, 1u, __ATOMIC_RELAXED, __HIP_MEMORY_SCOPE_AGENT);
        __syncthreads();
        int i = slot_w[0];
        if (i >= per_q) break;
        const int gg = grouped ? g : i / 68; i = grouped ? i : i % 68;
        int mode, s;
        if (i < 4) { const int q = gg * 4 + i; mode = q >> 5; s = 512 + (q & 31); }
        else { const int k = i - 4, u = 31 - (k >> 1); mode = k & 1; s = u >= 16 ? (((31 - u) << 4) | gg) : 256 + ((u << 4) | gg); }
        if (mode == 0) att::attn_unit<0>(lds, s); else att::attn_unit<1>(lds, s);
    }
}
DI void attn_odd_phase(LAS unsigned char* lds) {
    const int bx = launder((int)blockIdx.x), G = launder((int)gridDim.x);
    if (G == 256) {
        for (int i = 0; i < 6; ++i) {
            const int s = i == 0 ? (bx < 64 ? 1024 + bx : -1) : i <= 3 ? bx + 256 * (i - 1) : i == 4 ? (bx >= 64 ? 704 + bx : -1) : (bx >= 64 && bx < 128 ? 896 + bx : -1);
            if (s >= 0) att::attn_unit<2>(lds, s);
        }
    } else
    for (int s = bx; s < 1088; s += G) att::attn_unit<2>(lds, s);
}

typedef unsigned short bf16;
#define XB_TMO      128
#define XB_XCNT(j)  (256  + 64 * (j))
#define XB_XSUB(j)  (1280 + 64 * (j))
#define XB_XGEN(j)  (2304 + 64 * (j))
#define XB_TOP      3328
#define XB_TOPGEN   3392
#define XCD_BAR_WORDS 3456
#define XB_SPIN_CAP (1u << 18)

__device__ __forceinline__ unsigned xb_ld(unsigned* p)              { return __hip_atomic_load(p, __ATOMIC_RELAXED, __HIP_MEMORY_SCOPE_AGENT); }
__device__ __forceinline__ unsigned xb_add(unsigned* p, unsigned v) { return __hip_atomic_fetch_add(p, v, __ATOMIC_RELAXED, __HIP_MEMORY_SCOPE_AGENT); }
__device__ __forceinline__ unsigned xb_xcc_id() { return (unsigned)__builtin_amdgcn_s_getreg((3 << 11) | 20) & 0xFu; }
#define XB_SPIN(cond, bar) do { unsigned _sp = 0; while (cond) { __builtin_amdgcn_s_sleep(1); \
    if ((++_sp & 255u) == 0u) { if (xb_ld(&(bar)[XB_TMO])) break; if (_sp > XB_SPIN_CAP) { atomicAdd(&(bar)[XB_TMO], 1u); break; } } } } while (0)

struct XcdBarrier {
    unsigned* bar; unsigned x;
    volatile LAS unsigned* st;
};

__device__ __forceinline__ XcdBarrier xcd_barrier_post(unsigned* bar, volatile LAS unsigned* st) {
    XcdBarrier b; b.bar = bar; b.x = xb_xcc_id(); b.st = st;
    if (threadIdx.x == 0) (void)xb_add(&bar[XB_XCNT(b.x)], 1u);
    return b;
}
__device__ __forceinline__ void xcd_barrier_complete(unsigned* bar, unsigned x, unsigned& nloc, unsigned& nx) {
    const unsigned G = gridDim.x * gridDim.y * gridDim.z;
    unsigned sum, cnt, mine, sp = 0u;
    for (;;) {
        sum = 0u; cnt = 0u; mine = 0u;
#pragma unroll
        for (unsigned j = 0; j < 16; ++j) { const unsigned c = xb_ld(&bar[XB_XCNT(j)]); sum += c; cnt += (c > 0u) ? 1u : 0u; mine = (j == x) ? c : mine; }
        if (sum == G) break;
        __builtin_amdgcn_s_sleep(1);
        if ((++sp & 255u) == 0u) { if (xb_ld(&bar[XB_TMO])) break; if (sp > XB_SPIN_CAP) { atomicAdd(&bar[XB_TMO], 1u); break; } }
    }
    nloc = mine > 0u ? mine : 1u; nx = cnt > 0u ? cnt : 1u;
}

__device__ __forceinline__ void xcd_barrier(const XcdBarrier& b) {
    asm volatile("s_waitcnt vmcnt(0)" ::: "memory");
    __syncthreads();
    if (threadIdx.x == 0) {
        unsigned* bar = b.bar;
        __builtin_amdgcn_s_waitcnt(0);
        unsigned nloc = b.st[0], nx = b.st[1];
        if (nloc == 0u) { xcd_barrier_complete(bar, b.x, nloc, nx); b.st[0] = nloc; b.st[1] = nx; }
        const unsigned old = xb_add(&bar[XB_XSUB(b.x)], 1u);
        const unsigned gen = old / nloc;
        if (old + 1u == (gen + 1u) * nloc) {
            __builtin_amdgcn_fence(__ATOMIC_RELEASE, "agent");
            asm volatile("s_waitcnt vmcnt(0)" ::: "memory");
            const unsigned og = xb_add(&bar[XB_TOP], 1u);
            const unsigned tg = og / nx;
            if (og + 1u == (tg + 1u) * nx) xb_add(&bar[XB_TOPGEN], 1u);
            else XB_SPIN(xb_ld(&bar[XB_TOPGEN]) == tg, bar);
            __builtin_amdgcn_fence(__ATOMIC_ACQUIRE, "agent");
            xb_add(&bar[XB_XGEN(b.x)], 1u);
            asm volatile("s_waitcnt vmcnt(0)" ::: "memory");
        } else {
            XB_SPIN(xb_ld(&bar[XB_XGEN(b.x)]) == gen, bar);
            __builtin_amdgcn_fence(__ATOMIC_ACQUIRE, "agent");
            asm volatile("s_waitcnt vmcnt(0)" ::: "memory");
        }
    }
    __syncthreads();
}

template <int PH_LO, int PH_HI>
__global__ void __launch_bounds__(NTHR, 2) fwd_kernel(Args a_unused) {
    extern __shared__ __attribute__((aligned(16))) unsigned char lds_raw[];
    LAS unsigned char* lds = (LAS unsigned char*)lds_raw;
    cg::grid_group grid = cg::this_grid();
    constexpr bool ONE = (PH_HI - PH_LO) > 1;
    if (ONE) {
        { int t0 = threadIdx.x; if (t0 < 64) ((LAS unsigned*)(lds + 131072))[t0] = 0u; }
        __syncthreads();
        ArgsP a0 = fresh_args();
        (void)xcd_barrier_post((unsigned*)a0->ws, (volatile LAS unsigned*)(lds + 131072 + 32));
    }
#define IN(k) (PH_LO <= (k) && (k) < PH_HI)
#ifndef T_DUP
#define T_DUP (-1)
#endif
#define REPS(k) for (int rep_ = 0; rep_ < ((k) == T_DUP ? 2 : 1); ++rep_)
#define SEAM(k) do { if (IN(k) && IN((k) + 1)) { if (ab_never()) grid.sync(); { ArgsP ab = fresh_args(); XcdBarrier bb; bb.bar = (unsigned*)ab->ws; bb.x = xb_xcc_id(); bb.st = (volatile LAS unsigned*)(lds + 131072 + 32); xcd_barrier(bb); } } } while (0)
#define PHASE_ARGS int tid = threadIdx.x; asm volatile("" : "+v"(tid)); const int lane = tid & 63, wave = __builtin_amdgcn_readfirstlane(tid >> 6); (void)lane; (void)wave; ArgsP a = fresh_args(); unsigned char* ws = a->ws; (void)ws; const int bx_ = launder((int)blockIdx.x), G_ = launder((int)gridDim.x); (void)bx_; (void)G_
    if (IN(0)) REPS(0) { PHASE_ARGS; prologue_phase(lds, a, tid, lane, wave); __syncthreads(); }
    SEAM(0);
#pragma unroll
    for (int l = 0; l < 2; ++l) {
        const int p = l * 7;
        if (IN(p + 1)) REPS(p + 1) {
            PHASE_ARGS;
            if (l == 0) {
                if (bx_ >= 64 && bx_ < 76) scan_seq(a, (bx_ - 64) * 8 + wave, lane);
                else if (G_ < 76 && bx_ == 0) { for (int q = wave; q < 96; q += NWAVES) scan_seq(a, q, lane); }
                __syncthreads();
                pg8::Gemm g{(const bf16_t*)(ws + WS_XN), (const bf16_t*)(ws + WS_WINE), MT, 3072, DM}; pg8::StaticOrder S; S.init(MT, 3072, G_, bx_);
                EpiX<2> E{(bf16_t*)(ws + WS_Z), ZP, a->out};
                pg8::gemm_phase<EpiX<2>, pg8::StaticOrder, true, true>(lds, g, S, E);
            } else {
                pg8::Gemm g{(const bf16_t*)(ws + WS_XN), (const bf16_t*)(ws + WS_WINO), MT, 3072, DM}; pg8::StaticOrder S; S.init(MT, 3072, G_, bx_);
                EpiX<3> E{(bf16_t*)(ws + WS_Z), ZP, a->out};
                pg8::gemm_phase<EpiX<3>, pg8::StaticOrder, true, true>(lds, g, S, E);
            }
        }
        SEAM(p + 1);
        if (IN(p + 2)) REPS(p + 2) {
#ifndef T_NO_EVEN
            if (l == 0) attn_even_phase(lds);
#endif
#ifndef T_NO_ODD
            if (l == 1) attn_odd_phase(lds);
#endif
            __syncthreads(); }
        SEAM(p + 2);
        if (IN(p + 3)) REPS(p + 3) {
            PHASE_ARGS;
            sgemm_sample((const bf16_t*)(ws + WS_ATT) + (size_t)MP * DM, DM, (const bf16_t*)(ws + (l == 0 ? WS_WOUTE : WS_WOUTO)), (float*)(ws + WS_PART_OUT), bx_ * NWAVES + wave, G_ * NWAVES, lane);
            __syncthreads();
            pg8::Gemm g{(const bf16_t*)(ws + WS_ATT), (const bf16_t*)(ws + (l == 0 ? WS_WOUTE : WS_WOUTO)), MP, DM, DM}; pg8::StaticOrder S; S.init(MP, DM, G_, bx_);
            EpiX<0> E{(bf16_t*)(ws + WS_Y), DM, nullptr};
            pg8::gemm_phase<EpiX<0>, pg8::StaticOrder, true, true>(lds, g, S, E);
        }
        SEAM(p + 3);
        if (IN(p + 4)) REPS(p + 4) { PHASE_ARGS; rows_phase(a, a->in[I_GQM] + l * DM, a->in[I_GPF] + l * DM, (const float*)(ws + WS_PART_OUT), 2, lane, wave, l == 0, 1.f); }
        SEAM(p + 4);
        if (IN(p + 5)) REPS(p + 5) {
            PHASE_ARGS;
            pg8::Gemm g{(const bf16_t*)(ws + WS_XN), (const bf16_t*)(ws + (l ? WS_WUP1 : WS_WUP0)), MT, FF, DM}; pg8::StaticOrder S; S.init(MT, FF, G_, bx_);
            EpiX<1> E{(bf16_t*)(ws + WS_H), FF, nullptr};
            pg8::gemm_phase<EpiX<1>, pg8::StaticOrder, true, true>(lds, g, S, E);
        }
        SEAM(p + 5);
        if (IN(p + 6)) REPS(p + 6) {
            PHASE_ARGS;
            sgemm_sample((const bf16_t*)(ws + WS_H) + (size_t)MP * FF, FF, (const bf16_t*)(ws + (l ? WS_WDN1 : WS_WDN0)), (float*)(ws + WS_PART_DN), bx_ * NWAVES + wave, G_ * NWAVES, lane);
            __syncthreads();
            pg8::Gemm g{(const bf16_t*)(ws + WS_H), (const bf16_t*)(ws + (l ? WS_WDN1 : WS_WDN0)), MP, DM, FF}; pg8::StaticOrder S; S.init(MP, DM, G_, bx_);
            EpiX<0> E{(bf16_t*)(ws + WS_Y), DM, nullptr};
            pg8::gemm_phase<EpiX<0>, pg8::StaticOrder, true, true>(lds, g, S, E);
        }
        SEAM(p + 6);
        if (IN(p + 7)) REPS(p + 7) { PHASE_ARGS; rows_phase(a, a->in[I_GQF] + l * DM, l == 0 ? a->in[I_GPM] + DM : nullptr, (const float*)(ws + WS_PART_DN), 8, lane, wave); }
        SEAM(p + 7);
    }
#undef IN
#undef SEAM
}

#if MK_ONE_LAUNCH
#define KFN (fwd_kernel<0, 15>)
#else
#define KFN (fwd_kernel<0, 1>)
typedef void (*kfn_t)(Args);
static kfn_t kfns[15] = {fwd_kernel<0, 1>, fwd_kernel<1, 2>, fwd_kernel<2, 3>, fwd_kernel<3, 4>, fwd_kernel<4, 5>, fwd_kernel<5, 6>, fwd_kernel<6, 7>, fwd_kernel<7, 8>,
                         fwd_kernel<8, 9>, fwd_kernel<9, 10>, fwd_kernel<10, 11>, fwd_kernel<11, 12>, fwd_kernel<12, 13>, fwd_kernel<13, 14>, fwd_kernel<14, 15>};
#endif
extern "C" void kernel_launch(void* const* d_in, const int* in_sizes, int n_in, void* d_out, int out_size, void* d_ws, size_t ws_size, hipStream_t stream) {
    static int grid = 0;
    if (grid == 0) {
        if (n_in != N_IN || (size_t)out_size != O_END || ws_size < WS_END) { fprintf(stderr, "kernel_launch: unexpected shapes (n_in %d out %d ws %zu)\n", n_in, out_size, ws_size); grid = -1; return; }
        int dev = 0, cus = 0, per_cu = 0;
        (void)hipGetDevice(&dev); (void)hipDeviceGetAttribute(&cus, hipDeviceAttributeMultiprocessorCount, dev);
        if (hipFuncSetAttribute((const void*)KFN, hipFuncAttributeMaxDynamicSharedMemorySize, LDS_BYTES) != hipSuccess) { fprintf(stderr, "kernel_launch: hipFuncSetAttribute failed\n"); grid = -1; return; }
#if !MK_ONE_LAUNCH
        for (int k = 1; k < 15; ++k) (void)hipFuncSetAttribute((const void*)kfns[k], hipFuncAttributeMaxDynamicSharedMemorySize, LDS_BYTES);
#endif
        (void)hipOccupancyMaxActiveBlocksPerMultiprocessor(&per_cu, (const void*)KFN, NTHR, LDS_BYTES);
        if (per_cu < 1) per_cu = 1;
        (void)hipGetLastError();
        grid = cus * per_cu;
        fprintf(stderr, "kernel_launch: grid %d (cus %d x %d)\n", grid, cus, per_cu);
    }
    if (grid < 0) return;
    Args a{};
    for (int i = 0; i < N_IN; ++i) a.in[i] = (const float*)d_in[i];
    a.out = (float*)d_out; a.ws = (unsigned char*)d_ws;
#if MK_ONE_LAUNCH
    if (hipMemsetAsync(d_ws, 0, 32768, stream) != hipSuccess) { fprintf(stderr, "kernel_launch: memset failed\n"); return; }
    a.ph_lo = 0; a.ph_hi = 15;
    void* args[] = {&a};
    hipError_t e = hipLaunchCooperativeKernel((const void*)KFN, dim3(grid), dim3(NTHR), args, LDS_BYTES, stream);
    if (e != hipSuccess) fprintf(stderr, "cooperative launch failed: %s (grid %d)\n", hipGetErrorString(e), grid);
#else
    for (int k = 0; k < 15; ++k) { a.ph_lo = k; a.ph_hi = k + 1; hipLaunchKernelGGL(kfns[k], dim3(grid), dim3(NTHR), LDS_BYTES, stream, a); }
#endif
}
```

```cpp
#include <hip/hip_runtime.h>
#include <hip/hip_cooperative_groups.h>
#include <cstdio>
#include <cstdint>
namespace cg = cooperative_groups;
#ifndef MK_ONE_LAUNCH
#define MK_ONE_LAUNCH 1
#endif
namespace pg8 {
#define PG8_LAS __attribute__((address_space(3)))
typedef unsigned short bf16_t;
typedef short bf16x8 __attribute__((ext_vector_type(8)));
typedef float f32x4 __attribute__((ext_vector_type(4)));
typedef unsigned u32x4 __attribute__((ext_vector_type(4)));
constexpr int BM = 256, BK = 64, HALF = 128, HTB = HALF * BK * 2  , STAGE_BYTES = 8 * HTB, NXCD = 8, WGM = 8;

__host__ __device__ __forceinline__ int lds_byte(int r, int c) { const int st = (r >> 4) * 2 + (c >> 5), rr = r & 15, cc = c & 31, ob = rr * 64 + cc * 2; return st * 1024 + (ob ^ (((ob >> 9) & 1) << 5)); }
__host__ __device__ __forceinline__ void stage_rc(int b, int& R, int& C) { const int st = b / 1024, sb = b % 1024, swz = sb ^ (((sb >> 9) & 1) << 5); R = (st >> 1) * 16 + swz / 64; C = (st & 1) * 32 + (swz % 64) / 2; }
__host__ __device__ __forceinline__ int perm32(int rho) { const int n = rho >> 4, i = rho & 15; return 8 * (i >> 2) + 4 * n + (i & 3); }

struct Unit { int pm, pn; };
struct Gemm { const bf16_t* A; const bf16_t* Bt; int M, N, K; };

struct StaticOrder {
    int nM, nN, nwg, G, c;
    __host__ __device__ void init(int M, int N, int G_, int c_) { nM = M / BM; nN = N / BM; nwg = nM * nN; G = G_; c = c_; }
    __host__ __device__ bool next(int i, Unit& u) const {
        const long L = (long)i * G + c; if (L >= nwg) return false;
        int wgid = (int)L; { const int q = nwg / NXCD, r = nwg % NXCD, xcd = wgid % NXCD, off = wgid / NXCD; wgid = (xcd < r ? xcd * (q + 1) : r * (q + 1) + (xcd - r) * q) + off; }
        const int nig = WGM * nN, gid = wgid / nig, fm = gid * WGM, gsz = (nM - fm) < WGM ? (nM - fm) : WGM;
        u.pm = fm + ((wgid % nig) % gsz); u.pn = (wgid % nig) / gsz; return true;
    }
    __device__ __forceinline__ void a_ready(const Unit&) const {}
    __device__ __forceinline__ void done(const Unit&) const {}
};

__device__ __forceinline__ unsigned cvt_pk_bf16(float lo, float hi) { unsigned r; asm volatile("v_cvt_pk_bf16_f32 %0, %1, %2" : "=v"(r) : "v"(lo), "v"(hi)); return r; }
typedef float f32x2 __attribute__((ext_vector_type(2)));
template <class Epi, class Sched, bool ALIGN_EPI = false, bool SP2 = false>
__device__ __forceinline__ void gemm_phase(PG8_LAS unsigned char* lds, const Gemm g, const Sched& S, const Epi& E) {
    int tid_l = threadIdx.x; asm volatile("" : "+v"(tid_l));
    const int tid = tid_l, wid = __builtin_amdgcn_readfirstlane(tid >> 6), lane = tid & 63, wr = wid >> 2, wc = wid & 3, fr = lane & 15, fq = lane >> 4;
    const int K = g.K, nt = K / BK;
    unsigned voffA[2], voffB[2];
#pragma unroll
    for (int i = 0; i < 2; ++i) { int R, C; stage_rc(tid * 16 + i * 8192, R, C); const int Rb = Epi::PERM ? ((R & ~31) + perm32(R & 31)) : R;
        voffA[i] = (unsigned)(R * K + C) * 2u; voffB[i] = (unsigned)(Rb * K + C) * 2u; }
    const size_t kstep = (size_t)(BK * 2);
    const size_t hstep = (size_t)HALF * K * 2;
    const size_t tstep = 2 * hstep;
    const unsigned ldsw = (unsigned)wid * 1024u;
    const int aoff = lds_byte(wr * 64 + fr, fq * 8), boff = lds_byte(wc * 32 + fr, fq * 8);
#define PG8_SA(b, h) (((b) * 2 + (h)) * HTB)
#define PG8_SB(b, h) ((4 + (b) * 2 + (h)) * HTB)
#define PG8_STAGE(bufoff, gbase, voff) do { _Pragma("unroll") for (int _i = 0; _i < 2; ++_i) \
        __builtin_amdgcn_global_load_lds((const unsigned*)((const char*)(gbase) + (voff)[_i]), (PG8_LAS unsigned*)(lds + (bufoff) + ldsw + _i * 8192), 16, 0, 0); } while (0)
#define PG8_LDA(dst, b, h) do { _Pragma("unroll") for (int m = 0; m < 4; ++m) _Pragma("unroll") for (int k = 0; k < 2; ++k) dst[m][k] = *(const PG8_LAS bf16x8*)(lds + PG8_SA(b, h) + aoff + m * 2048 + k * 1024); } while (0)
#define PG8_LDB(dst, b, h) do { _Pragma("unroll") for (int n = 0; n < 2; ++n) _Pragma("unroll") for (int k = 0; k < 2; ++k) dst[n][k] = *(const PG8_LAS bf16x8*)(lds + PG8_SB(b, h) + boff + n * 2048 + k * 1024); } while (0)
#define PG8_MMA(ai, bj, At, Bt) do { __builtin_amdgcn_s_setprio(1); _Pragma("unroll") for (int m = 0; m < 4; ++m) _Pragma("unroll") for (int n = 0; n < 2; ++n) _Pragma("unroll") for (int k = 0; k < 2; ++k) \
        acc[ai][bj][m][n] = __builtin_amdgcn_mfma_f32_16x16x32_bf16(Bt[n][k], At[m][k], acc[ai][bj][m][n], 0, 0, 0); __builtin_amdgcn_s_setprio(0); } while (0)
#define PG8_WAIT_V(n) asm volatile("s_waitcnt vmcnt(" #n ")" ::: "memory")
#define PG8_WAIT_L(n) asm volatile("s_waitcnt lgkmcnt(" #n ")" ::: "memory")
#define PG8_BAR __builtin_amdgcn_s_barrier()
#define PG8_SCHED __builtin_amdgcn_sched_barrier(0)
    Unit cur, nxt; int ui = 0;
    if (!S.next(0, cur)) return;
    f32x4 acc[2][2][4][2];
#pragma unroll
    for (int a = 0; a < 2; ++a)
#pragma unroll
        for (int b = 0; b < 2; ++b)
#pragma unroll
            for (int m = 0; m < 4; ++m)
#pragma unroll
                for (int n = 0; n < 2; ++n) acc[a][b][m][n] = (f32x4){0.f, 0.f, 0.f, 0.f};
    bf16x8 At[4][2], B0[2][2], B1[2][2];
    const char* cA = (const char*)g.A + (size_t)cur.pm * tstep; const char* cB = (const char*)g.Bt + (size_t)cur.pn * tstep;
    S.a_ready(cur);
    if constexpr (SP2) {
        PG8_STAGE(PG8_SB(0, 0), cB, voffB); PG8_STAGE(PG8_SB(0, 1), cB + hstep, voffB); PG8_STAGE(PG8_SA(0, 0), cA, voffA); PG8_STAGE(PG8_SA(0, 1), cA + hstep, voffA);
        if (wr == 1) PG8_BAR;
        PG8_WAIT_V(2); PG8_BAR;
        PG8_STAGE(PG8_SB(1, 0), cB + kstep, voffB); PG8_STAGE(PG8_SA(1, 0), cA + kstep, voffA); PG8_STAGE(PG8_SB(1, 1), cB + hstep + kstep, voffB);
        PG8_WAIT_V(6); PG8_BAR;
    } else {
        PG8_STAGE(PG8_SB(0, 0), cB, voffB); PG8_STAGE(PG8_SA(0, 0), cA, voffA); PG8_STAGE(PG8_SB(0, 1), cB + hstep, voffB); PG8_STAGE(PG8_SA(0, 1), cA + hstep, voffA);
        if (wr == 1) PG8_BAR;
        PG8_WAIT_V(4); PG8_BAR;
        PG8_STAGE(PG8_SB(1, 0), cB + kstep, voffB); PG8_STAGE(PG8_SA(1, 0), cA + kstep, voffA); PG8_STAGE(PG8_SB(1, 1), cB + hstep + kstep, voffB);
        PG8_WAIT_V(6); PG8_BAR;
    }
    for (;;) {
        const bool has_next = S.next(ui + 1, nxt);
        const char* nA = has_next ? (const char*)g.A + (size_t)nxt.pm * tstep : cA; const char* nB = has_next ? (const char*)g.Bt + (size_t)nxt.pn * tstep : cB;
        for (int t = 0; t < nt; t += 2) {
            const bool last = (t == nt - 2);
            const char* a1 = cA + (size_t)(t + 1) * kstep;
            const char* a2 = last ? nA : cA + (size_t)(t + 2) * kstep; const char* b2 = last ? nB : cB + (size_t)(t + 2) * kstep;
            const char* a3 = a2 + kstep; const char* b3 = b2 + kstep;
            if (last && has_next) S.a_ready(nxt);
            if constexpr (SP2) {
            PG8_LDB(B0, 0, 0); PG8_LDB(B1, 0, 1); PG8_SCHED; PG8_LDA(At, 0, 0); PG8_STAGE(PG8_SA(1, 1), a1 + hstep, voffA);
            PG8_WAIT_V(8); PG8_WAIT_L(0); PG8_BAR; PG8_MMA(0, 0, At, B0); PG8_MMA(0, 1, At, B1); PG8_BAR; PG8_SCHED;
            PG8_LDA(At, 0, 1); PG8_STAGE(PG8_SB(0, 0), b2, voffB); PG8_STAGE(PG8_SB(0, 1), b2 + hstep, voffB); PG8_STAGE(PG8_SA(0, 0), a2, voffA);
            PG8_WAIT_V(8); PG8_WAIT_L(0); PG8_BAR; PG8_MMA(1, 0, At, B0); PG8_MMA(1, 1, At, B1); PG8_BAR; PG8_SCHED;
            PG8_LDB(B0, 1, 0); PG8_LDB(B1, 1, 1); PG8_SCHED; PG8_LDA(At, 1, 0); PG8_STAGE(PG8_SA(0, 1), a2 + hstep, voffA);
            PG8_WAIT_V(8); PG8_WAIT_L(0); PG8_BAR; PG8_MMA(0, 0, At, B0); PG8_MMA(0, 1, At, B1); PG8_BAR; PG8_SCHED;
            PG8_LDA(At, 1, 1); PG8_STAGE(PG8_SB(1, 0), b3, voffB); PG8_STAGE(PG8_SB(1, 1), b3 + hstep, voffB); PG8_STAGE(PG8_SA(1, 0), a3, voffA);
            PG8_WAIT_V(8); PG8_WAIT_L(0); PG8_BAR; PG8_MMA(1, 0, At, B0); PG8_MMA(1, 1, At, B1); PG8_BAR; PG8_SCHED;
            } else {
            PG8_LDB(B0, 0, 0); PG8_SCHED; PG8_LDA(At, 0, 0); PG8_STAGE(PG8_SA(1, 1), a1 + hstep, voffA);
            PG8_WAIT_L(8); PG8_BAR; PG8_WAIT_L(0); PG8_MMA(0, 0, At, B0); PG8_BAR; PG8_SCHED;
            PG8_LDB(B1, 0, 1); PG8_STAGE(PG8_SB(0, 0), b2, voffB);
            PG8_BAR; PG8_WAIT_L(0); PG8_MMA(0, 1, At, B1); PG8_BAR;
            PG8_LDA(At, 0, 1); PG8_STAGE(PG8_SA(0, 0), a2, voffA);
            PG8_BAR; PG8_WAIT_L(0); PG8_MMA(1, 0, At, B0); PG8_BAR; PG8_SCHED;
            PG8_STAGE(PG8_SB(0, 1), b2 + hstep, voffB);
            PG8_WAIT_V(6); PG8_BAR; PG8_MMA(1, 1, At, B1); PG8_BAR;
            PG8_LDB(B0, 1, 0); PG8_SCHED; PG8_LDA(At, 1, 0); PG8_STAGE(PG8_SA(0, 1), a2 + hstep, voffA);
            PG8_WAIT_L(8); PG8_BAR; PG8_WAIT_L(0); PG8_MMA(0, 0, At, B0); PG8_BAR; PG8_SCHED;
            PG8_LDB(B1, 1, 1); PG8_STAGE(PG8_SB(1, 0), b3, voffB);
            PG8_BAR; PG8_WAIT_L(0); PG8_MMA(0, 1, At, B1); PG8_BAR;
            PG8_LDA(At, 1, 1); PG8_STAGE(PG8_SA(1, 0), a3, voffA);
            PG8_BAR; PG8_WAIT_L(0); PG8_MMA(1, 0, At, B0); PG8_BAR; PG8_SCHED;
            PG8_STAGE(PG8_SB(1, 1), b3 + hstep, voffB);
            PG8_WAIT_V(6); PG8_BAR; PG8_MMA(1, 1, At, B1); PG8_BAR;
            }
        }
        if constexpr (ALIGN_EPI) { if (wr == 0) PG8_BAR; }
        if constexpr (!Epi::AFTER_DRAIN) { E(acc, cur, wr, wc, fr, fq); S.done(cur); }
        if (!has_next) break;
#pragma unroll
        for (int a = 0; a < 2; ++a)
#pragma unroll
            for (int b = 0; b < 2; ++b)
#pragma unroll
                for (int m = 0; m < 4; ++m)
#pragma unroll
                    for (int n = 0; n < 2; ++n) acc[a][b][m][n] = (f32x4){0.f, 0.f, 0.f, 0.f};
        cur = nxt; cA = nA; cB = nB; ++ui;
        if constexpr (ALIGN_EPI) { if (wr == 1) PG8_BAR; }
    }
    PG8_WAIT_V(0);
    if constexpr (!ALIGN_EPI) { if (wr == 0) PG8_BAR; }
    PG8_BAR;
    if constexpr (Epi::AFTER_DRAIN) { E.fused(acc, cur, wr, wc, fr, fq, lds, wid, lane); S.done(cur); }
#undef PG8_SA
#undef PG8_SB
#undef PG8_STAGE
#undef PG8_LDA
#undef PG8_LDB
#undef PG8_MMA
#undef PG8_WAIT_V
#undef PG8_WAIT_L
#undef PG8_BAR
#undef PG8_SCHED
}
}

typedef unsigned short bf16_t;
typedef short bf16x8 __attribute__((ext_vector_type(8)));
typedef short s16x4 __attribute__((ext_vector_type(4)));
typedef float f32x4 __attribute__((ext_vector_type(4)));
typedef float f32x2 __attribute__((ext_vector_type(2)));
typedef float f32x16 __attribute__((ext_vector_type(16)));
typedef unsigned u32x4 __attribute__((ext_vector_type(4)));
typedef unsigned u32x2 __attribute__((ext_vector_type(2)));
#define LAS __attribute__((address_space(3)))
#define DI __device__ __forceinline__

constexpr int DM = 1024, FF = 4096, MP = 16384, MS = 512, MT = MP + MS, SEQ = 4096, PAST = 1024, DSEQ = 64;
constexpr int ZP = 3072;
constexpr float LOG2E = 1.4426950408889634f;
constexpr float C2 = 0.125f * LOG2E;
constexpr float EPS = 1e-6f;
constexpr size_t O_YP = 0, O_YS = O_YP + (size_t)MP * DM, O_PAK = O_YS + (size_t)MS * DM, O_PAV = O_PAK + (size_t)MP * 512, O_PBK = O_PAV + (size_t)MP * 512,
                 O_PBV = O_PBK + (size_t)MP * 512, O_PBL = O_PBV + (size_t)MP * 512, O_PCK = O_PBL + (size_t)MP * 8, O_PCV = O_PCK + (size_t)4 * 512 * 1024,
                 O_SAK = O_PCV + (size_t)4 * 512 * 1024, O_SAV = O_SAK + (size_t)MS * 512, O_SBK = O_SAV + (size_t)MS * 512, O_SBV = O_SBK + (size_t)MS * 512,
                 O_SBL = O_SBV + (size_t)MS * 512, O_SCK = O_SBL + (size_t)MS * 8, O_SCV = O_SCK + (size_t)8 * 512 * 1024, O_END = O_SCV + (size_t)8 * 512 * 1024;
static_assert(O_END == 64622592, "output size");
constexpr size_t MiB = 1u << 20;
constexpr size_t WS_WINE = 1 * MiB, WS_WOUTE = 7 * MiB, WS_WUP0 = 9 * MiB, WS_WDN0 = 17 * MiB, WS_WINO = 25 * MiB, WS_WOUTO = 31 * MiB, WS_WUP1 = 33 * MiB, WS_WDN1 = 41 * MiB;
constexpr size_t WS_PART_DN = 1 * MiB;
constexpr size_t WS_PART_OUT = 116 * MiB;
constexpr size_t WS_XN = 49 * MiB, WS_Y = 82 * MiB, WS_CUMP = 115 * MiB, WS_CUMS = WS_CUMP + 524288, WS_Z = 116 * MiB, WS_ATT = 215 * MiB, WS_H = 116 * MiB, WS_END = 248 * MiB;
enum { I_XP = 0, I_XS, I_CAK, I_CAV, I_CBK, I_CBV, I_CBL, I_CCK, I_CCV, I_WINE, I_BF, I_LQ1, I_LK1, I_LQ2, I_LK2, I_SUBG, I_WOUTE, I_WINO, I_REL, I_WOUTO,
       I_GPM, I_GQM, I_GPF, I_GQF, I_WUP, I_WDN, N_IN };
constexpr int NWAVES = 8, NTHR = 512;
constexpr int LDS_BYTES = 147456;

struct Args { const float* in[N_IN]; float* out; unsigned char* ws; int ph_lo, ph_hi; };
typedef const __attribute__((address_space(4))) Args* ArgsP;
DI int launder(int v) { asm volatile("" : "+s"(v)); return v; }
DI bool ab_never();
DI ArgsP fresh_args() { ArgsP p = (ArgsP)__builtin_amdgcn_kernarg_segment_ptr(); asm volatile("" : "+s"(p)); return p; }

DI float wave_sum(float v) {
#pragma unroll
    for (int o = 1; o < 64; o <<= 1) v += __shfl_xor(v, o);
    return v;
}
DI unsigned pk2(float lo, float hi) { typedef __bf16 b2 __attribute__((ext_vector_type(2))); f32x2 v = {lo, hi}; b2 b = __builtin_convertvector(v, b2); return __builtin_bit_cast(unsigned, b); }
DI float bf2f(unsigned short h) { return __uint_as_float(((unsigned)h) << 16); }

DI bool ab_never() { return fresh_args()->ph_lo == 0x7fffffff; }

template <int MODE> struct EpiX {
    static constexpr bool PERM = true, AFTER_DRAIN = false;
    bf16_t* O; int ldc; float* out;
    __device__ __forceinline__ void operator()(const pg8::f32x4 (&acc)[2][2][4][2], const pg8::Unit& u, int wr, int wc, int fr, int fq) const {
        const unsigned loff = (unsigned)(fr * ldc + 8 * fq) * 2u;
        char* ub = (char*)O + ((size_t)(u.pm * 256 + wr * 64) * ldc + u.pn * 256 + wc * 32) * 2;
        float sc = 1.f; char* fb = nullptr; unsigned floff = 0; int fpitch = 0; bool smp3 = false;
        if (MODE == 2) {
            const int seg = u.pn >> 1; fpitch = 512; floff = (unsigned)(fr * 512 + 8 * fq) * 4u;
            if (seg == 0 || seg == 3) sc = C2;
            else {
                if (u.pm >= 64) {
                    const size_t off = seg == 1 ? O_SAK : seg == 2 ? O_SAV : seg == 4 ? O_SBK : O_SBV;
                    fb = (char*)(out + off + (size_t)((u.pm - 64) * 256 + wr * 64) * 512 + (u.pn & 1) * 256 + wc * 32);
                }
            }
        } else if (MODE == 3) {
            const int seg = u.pn >> 2; fpitch = 1024; floff = (unsigned)(fr * 1024 + 8 * fq) * 4u;
            if (seg == 0) sc = C2;
            else if (u.pm >= 64) { smp3 = true; fb = (char*)(out + (seg == 1 ? O_SCK : O_SCV) + (size_t)(((u.pm - 64) * 4 + wr) * 512 + 448) * 1024 + (u.pn & 3) * 256 + wc * 32); }
            else if ((u.pm & 15) >= 14) fb = (char*)(out + (seg == 1 ? O_PCK : O_PCV) + (size_t)((u.pm >> 4) * 512 + ((u.pm & 15) - 14) * 256 + wr * 64) * 1024 + (u.pn & 3) * 256 + wc * 32);
        }
#pragma unroll
        for (int ai = 0; ai < 2; ++ai)
#pragma unroll
            for (int m = 0; m < 4; ++m) {
                char* rb = ub + (size_t)(ai * 128 + m * 16) * ldc * 2;
                char* frb = nullptr;
                if (MODE >= 2 && fb) frb = fb + (size_t)((MODE == 3 && smp3) ? (ai * 1024 + m * 16) : (ai * 128 + m * 16)) * fpitch * 4;
#pragma unroll
                for (int bj = 0; bj < 2; ++bj) {
                    pg8::f32x4 v0 = acc[ai][bj][m][0], v1 = acc[ai][bj][m][1];
                    if (MODE >= 2 && frb) { *(pg8::f32x4*)(frb + bj * 512 + floff) = v0; *(pg8::f32x4*)(frb + bj * 512 + 16 + floff) = v1; }
                    if (MODE == 1) {
#pragma unroll
                        for (int e = 0; e < 4; ++e) { float a = fmaxf(v0[e], 0.f), b = fmaxf(v1[e], 0.f); v0[e] = a * a; v1[e] = b * b; }
                    }
                    if (MODE >= 2) { v0 = v0 * sc; v1 = v1 * sc; }
                    pg8::u32x4 w; w.x = pg8::cvt_pk_bf16(v0[0], v0[1]); w.y = pg8::cvt_pk_bf16(v0[2], v0[3]); w.z = pg8::cvt_pk_bf16(v1[0], v1[1]); w.w = pg8::cvt_pk_bf16(v1[2], v1[3]);
                    *(pg8::u32x4*)(rb + bj * 256 + loff) = w;
                }
                asm volatile("" ::: "memory");
            }
    }
};

namespace att {
constexpr int KP = 272, VP = 320;
constexpr int KT_B = 64 * KP, VT_B = 64 * VP;
constexpr int OFF_K = 0, OFF_V = 2 * KT_B, OFF_CUM = 2 * KT_B + 2 * VT_B  , OFF_TBL = OFF_CUM + 1024, OFF_END = OFF_TBL + 2 * 640 * 4;
static_assert(OFF_END <= 131072 && 65536 <= OFF_CUM, "attention LDS map");
struct Job {
    const bf16_t* q;
    const float* kc; const float* vc; int cpitch; int nc;
    const bf16_t* kz; const bf16_t* vz;
    int kt_lo, kt_hi, qpos0, kpos0, nq_sub;
    const float* cum; int cum_hs;
    const float* tbl;
    bf16_t* o;
    float slope2; const float* subg;
};
#define MFMA32(a, b, c) __builtin_amdgcn_mfma_f32_32x32x16_bf16((a), (b), (c), 0, 0, 0)
DI u32x4 pack8(const f32x4 a, const f32x4 b) { u32x4 r; r.x = pk2(a[0], a[1]); r.y = pk2(a[2], a[3]); r.z = pk2(b[0], b[1]); r.w = pk2(b[2], b[3]); return r; }
DI s16x4 vtr(const LAS unsigned char* p) { typedef short v4 __attribute__((ext_vector_type(4))); return __builtin_bit_cast(s16x4, __builtin_amdgcn_ds_read_tr16_b64_v4i16((LAS v4*)p)); }

DI void load_tile(const Job& J, int kt, int srow, int sch, u32x4& r0, u32x4& r1, u32x4& r2, u32x4& r3) {
    if (kt >= J.nc) {
        const size_t o0 = (size_t)((kt - J.nc) * 64 + srow) * ZP + sch * 8, o1 = o0 + (size_t)32 * ZP;
        r0 = *(const u32x4*)(J.kz + o0); r1 = *(const u32x4*)(J.kz + o1); r2 = *(const u32x4*)(J.vz + o0); r3 = *(const u32x4*)(J.vz + o1);
    }
}
template <int MODE> DI void store_tile(const Job& J, int kt, int buf, int srow, int sch, u32x4& r0, u32x4& r1, u32x4& r2, u32x4& r3, LAS unsigned char* lds, float* fk = nullptr, float* fv = nullptr, int own_lo = -4) {
    if (kt < J.nc) {
        const size_t o0 = (size_t)(kt * 64 + srow) * J.cpitch + sch * 8, o1 = o0 + (size_t)32 * J.cpitch;
        const f32x4 ka = *(const f32x4*)(J.kc + o0), kb_ = *(const f32x4*)(J.kc + o0 + 4), kc_ = *(const f32x4*)(J.kc + o1), kd = *(const f32x4*)(J.kc + o1 + 4);
        const f32x4 va = *(const f32x4*)(J.vc + o0), vb_ = *(const f32x4*)(J.vc + o0 + 4), vc_ = *(const f32x4*)(J.vc + o1), vd = *(const f32x4*)(J.vc + o1 + 4);
        if (MODE == 2 && fk && kt >= 1) {
            const size_t d0 = (size_t)(kt * 64 + srow) * 1024 + sch * 8, d1 = d0 + (size_t)32 * 1024;
            *(f32x4*)(fk + d0) = ka; *(f32x4*)(fk + d0 + 4) = kb_; *(f32x4*)(fk + d1) = kc_; *(f32x4*)(fk + d1 + 4) = kd;
            *(f32x4*)(fv + d0) = va; *(f32x4*)(fv + d0 + 4) = vb_; *(f32x4*)(fv + d1) = vc_; *(f32x4*)(fv + d1 + 4) = vd;
        }
        r0 = pack8(ka, kb_); r1 = pack8(kc_, kd); r2 = pack8(va, vb_); r3 = pack8(vc_, vd);
    }
    if (MODE < 2 && fk && (unsigned)(kt - own_lo) < 2u) {
        const size_t o0 = (size_t)(kt * 64 + srow) * 512 + sch * 8, o1 = o0 + (size_t)32 * 512;
#define BF_LO(w) __uint_as_float((w) << 16)
#define BF_HI(w) __uint_as_float((w) & 0xffff0000u)
#define ST8(p, r) do { *(f32x4*)(p) = (f32x4){BF_LO(r.x), BF_HI(r.x), BF_LO(r.y), BF_HI(r.y)}; *(f32x4*)((p) + 4) = (f32x4){BF_LO(r.z), BF_HI(r.z), BF_LO(r.w), BF_HI(r.w)}; } while (0)
        ST8(fk + o0, r0); ST8(fk + o1, r1); ST8(fv + o0, r2); ST8(fv + o1, r3);
#undef ST8
#undef BF_LO
#undef BF_HI
    }
    LAS unsigned char* kb = lds + OFF_K + buf * KT_B + srow * KP + sch * 16; LAS unsigned char* vb = lds + OFF_V + buf * VT_B + srow * VP + sch * 16;
    *(LAS u32x4*)kb = r0; *(LAS u32x4*)(kb + 32 * KP) = r1; *(LAS u32x4*)vb = r2; *(LAS u32x4*)(vb + 32 * VP) = r3;
}

template <int MODE> DI Job make_job(int s_) {
    const int s = launder(s_);
    ArgsP a = fresh_args(); Job J{};
    const bf16_t* z = (const bf16_t*)(a->ws + WS_Z); bf16_t* attb = (bf16_t*)(a->ws + WS_ATT);
    if (MODE < 2) {
        const int qcol = MODE == 0 ? 0 : 1536, kcol = MODE == 0 ? 512 : 2048, vcol = MODE == 0 ? 1024 : 2560, ocol = MODE == 0 ? 0 : 512;
        if (s < 512) {
            const int j = s & 255, u = (s >> 8) ? (j >> 4) : 31 - (j >> 4), bh = j & 15, b = bh >> 2, hh = bh & 3;
            const size_t row0 = (size_t)b * SEQ + 128 * u, rb = (size_t)b * SEQ;
            J.nc = 0; J.kt_lo = 0; J.kt_hi = 2 * u + 1; J.qpos0 = 128 * u; J.kpos0 = 0; J.nq_sub = 4;
            J.q = z + row0 * ZP + qcol + hh * 128; J.kz = z + rb * ZP + kcol + hh * 128; J.vz = z + rb * ZP + vcol + hh * 128; J.o = attb + row0 * DM + ocol + hh * 128;
            J.slope2 = exp2f(-2.f * (float)(hh + 1)) * LOG2E;
            J.cum = (const float*)(a->ws + WS_CUMP) + (size_t)(b * 8 + 2 * hh) * 4096; J.cum_hs = 4096;
        } else {
            const int jj = s - 512, b = jj >> 2, hh = jj & 3; const size_t row0 = (size_t)MP + b * DSEQ;
            J.nc = 16; J.cpitch = 512; J.kt_lo = 0; J.kt_hi = 16; J.qpos0 = PAST; J.kpos0 = 0; J.nq_sub = 2;
            J.q = z + row0 * ZP + qcol + hh * 128; J.kz = z + row0 * ZP + kcol + hh * 128; J.vz = z + row0 * ZP + vcol + hh * 128; J.o = attb + row0 * DM + ocol + hh * 128;
            J.kc = a->in[MODE == 0 ? I_CAK : I_CBK] + (size_t)b * PAST * 512 + hh * 128; J.vc = a->in[MODE == 0 ? I_CAV : I_CBV] + (size_t)b * PAST * 512 + hh * 128;
            J.slope2 = exp2f(-2.f * (float)(hh + 1)) * LOG2E;
            J.cum = (const float*)(a->ws + WS_CUMS) + (size_t)(b * 8 + 2 * hh) * 1088; J.cum_hs = 1088;
        }
        J.subg = a->in[I_SUBG];
    } else {
        if (s < 1024) {
            const int bh = s & 31, b = bh >> 3, hp = bh & 7, u = s >> 5; const size_t row0 = (size_t)b * SEQ + 128 * u, rb = (size_t)b * SEQ;
            J.q = z + row0 * ZP + hp * 128; J.kz = z + rb * ZP + 1024 + hp * 128; J.vz = z + rb * ZP + 2048 + hp * 128; J.o = attb + row0 * DM + hp * 128;
            J.nc = 0; J.kt_lo = 2 * u - 8 > 0 ? 2 * u - 8 : 0; J.kt_hi = 2 * u + 1; J.qpos0 = 128 * u; J.kpos0 = 0; J.nq_sub = 4; J.tbl = a->in[I_REL] + (size_t)(2 * hp) * 513;
        } else {
            const int id = s - 1024, b = id >> 3, hp = id & 7; const size_t row0 = (size_t)MP + b * DSEQ;
            J.q = z + row0 * ZP + hp * 128; J.kz = z + row0 * ZP + 1024 + hp * 128; J.vz = z + row0 * ZP + 2048 + hp * 128; J.o = attb + row0 * DM + hp * 128;
            J.kc = a->in[I_CCK] + (size_t)b * 512 * 1024 + hp * 128; J.vc = a->in[I_CCV] + (size_t)b * 512 * 1024 + hp * 128; J.cpitch = 1024; J.nc = 8;
            J.kt_lo = 0; J.kt_hi = 8; J.qpos0 = PAST; J.kpos0 = 512; J.nq_sub = 2; J.tbl = a->in[I_REL] + (size_t)(2 * hp) * 513;
        }
    }
    return J;
}

template <int MODE>
DI void attn_unit(LAS unsigned char* lds, const int slot) {
    constexpr int NDB = (MODE == 0) ? 4 : 2;
    int tid_l = threadIdx.x; asm volatile("" : "+v"(tid_l));
    const int tid = tid_l, lane = tid & 63, wid = __builtin_amdgcn_readfirstlane(tid >> 6);
    const int qs = wid >> 1, half = wid & 1, r32 = lane & 31, hi = lane >> 5;
    const int srow = tid >> 4, sch = tid & 15;
    const int qin = (32 * qs + r32) & 63;
    bool active; int qc_w, kc0, kt, nt, qk0;
    bf16x8 qr[4];
    u32x4 r0 = {0u, 0u, 0u, 0u}, r1 = r0, r2 = r0, r3 = r0, n0 = r0, n1 = r0, n2 = r0, n3 = r0; float cumv = 0.f, cumn = 0.f;
    __syncthreads();
    Job J = make_job<MODE>(slot);
    float* fk = nullptr; float* fv = nullptr; int own_lo = -4;
    if (MODE == 2 && slot >= 1024) {
        const int id = slot - 1024; ArgsP a = fresh_args();
        const size_t off = (size_t)(id >> 3) * 512 * 1024 + (id & 7) * 128;
        fk = a->out + O_SCK + off - (size_t)64 * 1024; fv = a->out + O_SCV + off - (size_t)64 * 1024;
    }
    if (MODE < 2 && slot < 512) {
        const int j = slot & 255, u = (slot >> 8) ? (j >> 4) : 31 - (j >> 4), bh = j & 15; ArgsP a = fresh_args();
        const size_t off = (size_t)(bh >> 2) * SEQ * 512 + (bh & 3) * 128;
        fk = a->out + (MODE == 0 ? O_PAK : O_PBK) + off; fv = a->out + (MODE == 0 ? O_PAV : O_PBV) + off; own_lo = 2 * u;
    }
    const float slope2 = J.slope2;
    {
        active = qs < J.nq_sub; qc_w = (J.qpos0 + 32 * qs) >> 6; kc0 = J.kpos0 >> 6; kt = J.kt_lo; nt = J.kt_hi - J.kt_lo + 1; qk0 = J.qpos0 - J.kpos0;
        if (MODE == 2) {
            for (int e = tid; e < 1280; e += NTHR) { const int hs = e >= 640 ? 1 : 0, idx = e - hs * 640, rel = idx - 63, c = (rel > 256 ? 256 : rel) + 256;
                ((LAS float*)(lds + OFF_TBL))[e] = J.tbl[hs * 513 + c] * LOG2E; }
        }
        const bf16_t* qp = J.q + (size_t)((active ? 32 * qs : 0) + r32) * ZP + half * 64 + 8 * hi;
#pragma unroll
        for (int d0 = 0; d0 < 4; ++d0) qr[d0] = *(const bf16x8*)(qp + 16 * d0);
        load_tile(J, kt, srow, sch, r0, r1, r2, r3);
        if (MODE == 1 && tid < 128) cumv = J.cum[(size_t)(tid >> 6) * J.cum_hs + kt * 64 + (tid & 63)];
        store_tile<MODE>(J, kt, 0, srow, sch, r0, r1, r2, r3, lds, fk, fv, own_lo);
        if (MODE == 1 && tid < 128) ((LAS float*)(lds + OFF_CUM))[tid] = cumv;
        if (nt > 1) { load_tile(J, kt + 1, srow, sch, r0, r1, r2, r3); if (MODE == 1 && tid < 128) cumv = J.cum[(size_t)(tid >> 6) * J.cum_hs + (kt + 1) * 64 + (tid & 63)]; }
    }
    f32x16 o[NDB];
#pragma unroll
    for (int d = 0; d < NDB; ++d)
#pragma unroll
        for (int i = 0; i < 16; ++i) o[d][i] = 0.f;
    float m_ref = 0.f, l_run = 0.f; bool first = true;
    __syncthreads();
    const int b16 = (lane >> 4) & 1, q4 = (lane & 15) >> 2, p4 = lane & 3;
    const int vcol0 = (MODE == 0) ? 0 : 64 * half;
    for (int it = 0; it < nt; ++kt) {
        {
        const int buf = it & 1; const bool more = it + 1 < nt;
        {
            if (it + 2 < nt) { load_tile(J, kt + 2, srow, sch, n0, n1, n2, n3); if (MODE == 1 && tid < 128) cumn = J.cum[(size_t)(tid >> 6) * J.cum_hs + (kt + 2) * 64 + (tid & 63)]; }
        }
        const int kc = kc0 + kt;
        const bool vis = active && kc <= qc_w && (MODE != 2 || kc >= qc_w - 8);
        if (vis) {
            const LAS unsigned char* Kb = lds + OFF_K + buf * KT_B + r32 * KP + half * 128 + hi * 16;
            const int qk = qk0 + 32 * qs + r32 - kt * 64 - 4 * hi;
            bf16x8 kf[8];
#pragma unroll
            for (int d0 = 0; d0 < 4; ++d0) { kf[2 * d0] = *(const LAS bf16x8*)(Kb + d0 * 32); kf[2 * d0 + 1] = *(const LAS bf16x8*)(Kb + 32 * KP + d0 * 32); }
            f32x16 p0, p1;
            if (MODE == 0) {
                if (kc < qc_w) {
                    const float base = fmaf(-slope2, (float)qk, -m_ref);
#pragma unroll
                    for (int i = 0; i < 16; ++i) { const float ci = (float)((i & 3) + 8 * (i >> 2)); p0[i] = fmaf(slope2, ci, base); p1[i] = fmaf(slope2, ci + 32.f, base); }
                } else {
                    const float qrel = (float)qk, nm = -m_ref;
#pragma unroll
                    for (int i = 0; i < 16; ++i) { const float ci = (float)((i & 3) + 8 * (i >> 2)); p0[i] = fmaf(-slope2, fabsf(qrel - ci), nm); p1[i] = fmaf(-slope2, fabsf(qrel - 32.f - ci), nm); }
                }
            } else if (MODE == 1) {
                const LAS float* ct = (const LAS float*)(lds + OFF_CUM) + buf * 128 + half * 64 + 4 * hi; const float nm = -m_ref;
#pragma unroll
                for (int g = 0; g < 4; ++g) { const f32x4 c0 = *(const LAS f32x4*)(ct + 8 * g), c1 = *(const LAS f32x4*)(ct + 32 + 8 * g);
#pragma unroll
                    for (int e = 0; e < 4; ++e) { p0[4 * g + e] = nm - c0[e]; p1[4 * g + e] = nm - c1[e]; } }
            } else {
                const LAS float* tb = (const LAS float*)(lds + OFF_TBL) + half * 640 + (qk + 63 - 59);
#pragma unroll
                for (int i = 0; i < 16; ++i) { const int ci = (i & 3) + 8 * (i >> 2); p0[i] = tb[59 - ci] - m_ref; p1[i] = tb[59 - 32 - ci] - m_ref; }
            }
            __builtin_amdgcn_sched_barrier(0);
#pragma unroll
            for (int d0 = 0; d0 < 4; ++d0) { p0 = MFMA32(kf[2 * d0], qr[d0], p0); p1 = MFMA32(kf[2 * d0 + 1], qr[d0], p1); }
            const LAS unsigned char* Vb = lds + OFF_V + buf * VT_B + (4 * hi + q4) * VP + (vcol0 + 16 * b16 + 4 * p4) * 2;
            s16x4 vr[2][NDB][2];
#pragma unroll
            for (int d = 0; d < NDB; ++d) { vr[0][d][0] = vtr(Vb + d * 64); vr[0][d][1] = vtr(Vb + d * 64 + 8 * VP); }
            __builtin_amdgcn_sched_barrier(0);
            if (MODE == 1 && kc == qc_w) {
#pragma unroll
                for (int i = 0; i < 16; ++i) { const int kin = (i & 3) + 8 * (i >> 2) + 4 * hi; if (kin > qin) p0[i] = -INFINITY; if (kin + 32 > qin) p1[i] = -INFINITY; }
            }
            float mx = fmaxf(fmaxf(p0[0], p1[0]), p0[1]);
#pragma unroll
            for (int i = 2; i < 16; i += 2) mx = fmaxf(fmaxf(mx, p0[i]), p0[i + 1]);
#pragma unroll
            for (int i = 1; i < 16; i += 2) mx = fmaxf(fmaxf(mx, p1[i]), p1[i + 1 < 16 ? i + 1 : i]);
            { auto rr = __builtin_amdgcn_permlane32_swap(__float_as_uint(mx), __float_as_uint(mx), false, false); mx = fmaxf(__uint_as_float(rr[0]), __uint_as_float(rr[1])); }
            if (first || __any(mx > 8.f)) {
                const float dl = first ? mx : fmaxf(mx, 0.f), f = first ? 1.f : __builtin_amdgcn_exp2f(-dl);
                m_ref += dl; l_run *= f;
#pragma unroll
                for (int i = 0; i < 16; ++i) { p0[i] -= dl; p1[i] -= dl; }
#pragma unroll
                for (int d = 0; d < NDB; ++d)
#pragma unroll
                    for (int i = 0; i < 16; ++i) o[d][i] *= f;
                first = false;
            }
            float ls = 0.f;
#pragma unroll
            for (int i = 0; i < 16; ++i) { p0[i] = __builtin_amdgcn_exp2f(p0[i]); p1[i] = __builtin_amdgcn_exp2f(p1[i]); ls += p0[i] + p1[i]; }
            l_run += ls;
            bf16x8 pf[4];
            { u32x4 t;
              t.x = pk2(p0[0], p0[1]); t.y = pk2(p0[2], p0[3]); t.z = pk2(p0[4], p0[5]); t.w = pk2(p0[6], p0[7]); pf[0] = __builtin_bit_cast(bf16x8, t);
              t.x = pk2(p0[8], p0[9]); t.y = pk2(p0[10], p0[11]); t.z = pk2(p0[12], p0[13]); t.w = pk2(p0[14], p0[15]); pf[1] = __builtin_bit_cast(bf16x8, t);
              t.x = pk2(p1[0], p1[1]); t.y = pk2(p1[2], p1[3]); t.z = pk2(p1[4], p1[5]); t.w = pk2(p1[6], p1[7]); pf[2] = __builtin_bit_cast(bf16x8, t);
              t.x = pk2(p1[8], p1[9]); t.y = pk2(p1[10], p1[11]); t.z = pk2(p1[12], p1[13]); t.w = pk2(p1[14], p1[15]); pf[3] = __builtin_bit_cast(bf16x8, t); }
#pragma unroll
            for (int ks = 0; ks < 4; ++ks) {
                if (ks < 3) {
#pragma unroll
                    for (int d = 0; d < NDB; ++d) { const LAS unsigned char* a = Vb + (16 * (ks + 1)) * VP + d * 64; vr[(ks + 1) & 1][d][0] = vtr(a); vr[(ks + 1) & 1][d][1] = vtr(a + 8 * VP); }
                }
                __builtin_amdgcn_sched_barrier(0);
#pragma unroll
                for (int d = 0; d < NDB; ++d) {
                    const bf16x8 vf = __builtin_shufflevector(vr[ks & 1][d][0], vr[ks & 1][d][1], 0, 1, 2, 3, 4, 5, 6, 7);
                    o[d] = MFMA32(vf, pf[ks], o[d]);
                }
                __builtin_amdgcn_sched_barrier(0);
            }
        }
        if (more) {
            store_tile<MODE>(J, kt + 1, buf ^ 1, srow, sch, r0, r1, r2, r3, lds, fk, fv, own_lo); if (MODE == 1 && tid < 128) ((LAS float*)(lds + OFF_CUM))[(buf ^ 1) * 128 + tid] = cumv;
        }
        __syncthreads();
        }
        ++it; ++kt;
        if (it >= nt) break;
        {
        const int buf = it & 1; const bool more = it + 1 < nt;
        {
            if (it + 2 < nt) { load_tile(J, kt + 2, srow, sch, r0, r1, r2, r3); if (MODE == 1 && tid < 128) cumv = J.cum[(size_t)(tid >> 6) * J.cum_hs + (kt + 2) * 64 + (tid & 63)]; }
        }
        const int kc = kc0 + kt;
        const bool vis = active && kc <= qc_w && (MODE != 2 || kc >= qc_w - 8);
        if (vis) {
            const LAS unsigned char* Kb = lds + OFF_K + buf * KT_B + r32 * KP + half * 128 + hi * 16;
            const int qk = qk0 + 32 * qs + r32 - kt * 64 - 4 * hi;
            bf16x8 kf[8];
#pragma unroll
            for (int d0 = 0; d0 < 4; ++d0) { kf[2 * d0] = *(const LAS bf16x8*)(Kb + d0 * 32); kf[2 * d0 + 1] = *(const LAS bf16x8*)(Kb + 32 * KP + d0 * 32); }
            f32x16 p0, p1;
            if (MODE == 0) {
                if (kc < qc_w) {
                    const float base = fmaf(-slope2, (float)qk, -m_ref);
#pragma unroll
                    for (int i = 0; i < 16; ++i) { const float ci = (float)((i & 3) + 8 * (i >> 2)); p0[i] = fmaf(slope2, ci, base); p1[i] = fmaf(slope2, ci + 32.f, base); }
                } else {
                    const float qrel = (float)qk, nm = -m_ref;
#pragma unroll
                    for (int i = 0; i < 16; ++i) { const float ci = (float)((i & 3) + 8 * (i >> 2)); p0[i] = fmaf(-slope2, fabsf(qrel - ci), nm); p1[i] = fmaf(-slope2, fabsf(qrel - 32.f - ci), nm); }
                }
            } else if (MODE == 1) {
                const LAS float* ct = (const LAS float*)(lds + OFF_CUM) + buf * 128 + half * 64 + 4 * hi; const float nm = -m_ref;
#pragma unroll
                for (int g = 0; g < 4; ++g) { const f32x4 c0 = *(const LAS f32x4*)(ct + 8 * g), c1 = *(const LAS f32x4*)(ct + 32 + 8 * g);
#pragma unroll
                    for (int e = 0; e < 4; ++e) { p0[4 * g + e] = nm - c0[e]; p1[4 * g + e] = nm - c1[e]; } }
            } else {
                const LAS float* tb = (const LAS float*)(lds + OFF_TBL) + half * 640 + (qk + 63 - 59);
#pragma unroll
                for (int i = 0; i < 16; ++i) { const int ci = (i & 3) + 8 * (i >> 2); p0[i] = tb[59 - ci] - m_ref; p1[i] = tb[59 - 32 - ci] - m_ref; }
            }
            __builtin_amdgcn_sched_barrier(0);
#pragma unroll
            for (int d0 = 0; d0 < 4; ++d0) { p0 = MFMA32(kf[2 * d0], qr[d0], p0); p1 = MFMA32(kf[2 * d0 + 1], qr[d0], p1); }
            const LAS unsigned char* Vb = lds + OFF_V + buf * VT_B + (4 * hi + q4) * VP + (vcol0 + 16 * b16 + 4 * p4) * 2;
            s16x4 vr[2][NDB][2];
#pragma unroll
            for (int d = 0; d < NDB; ++d) { vr[0][d][0] = vtr(Vb + d * 64); vr[0][d][1] = vtr(Vb + d * 64 + 8 * VP); }
            __builtin_amdgcn_sched_barrier(0);
            if (MODE == 1 && kc == qc_w) {
#pragma unroll
                for (int i = 0; i < 16; ++i) { const int kin = (i & 3) + 8 * (i >> 2) + 4 * hi; if (kin > qin) p0[i] = -INFINITY; if (kin + 32 > qin) p1[i] = -INFINITY; }
            }
            float mx = fmaxf(fmaxf(p0[0], p1[0]), p0[1]);
#pragma unroll
            for (int i = 2; i < 16; i += 2) mx = fmaxf(fmaxf(mx, p0[i]), p0[i + 1]);
#pragma unroll
            for (int i = 1; i < 16; i += 2) mx = fmaxf(fmaxf(mx, p1[i]), p1[i + 1 < 16 ? i + 1 : i]);
            { auto rr = __builtin_amdgcn_permlane32_swap(__float_as_uint(mx), __float_as_uint(mx), false, false); mx = fmaxf(__uint_as_float(rr[0]), __uint_as_float(rr[1])); }
            if (first || __any(mx > 8.f)) {
                const float dl = first ? mx : fmaxf(mx, 0.f), f = first ? 1.f : __builtin_amdgcn_exp2f(-dl);
                m_ref += dl; l_run *= f;
#pragma unroll
                for (int i = 0; i < 16; ++i) { p0[i] -= dl; p1[i] -= dl; }
#pragma unroll
                for (int d = 0; d < NDB; ++d)
#pragma unroll
                    for (int i = 0; i < 16; ++i) o[d][i] *= f;
                first = false;
            }
            float ls = 0.f;
#pragma unroll
            for (int i = 0; i < 16; ++i) { p0[i] = __builtin_amdgcn_exp2f(p0[i]); p1[i] = __builtin_amdgcn_exp2f(p1[i]); ls += p0[i] + p1[i]; }
            l_run += ls;
            bf16x8 pf[4];
            { u32x4 t;
              t.x = pk2(p0[0], p0[1]); t.y = pk2(p0[2], p0[3]); t.z = pk2(p0[4], p0[5]); t.w = pk2(p0[6], p0[7]); pf[0] = __builtin_bit_cast(bf16x8, t);
              t.x = pk2(p0[8], p0[9]); t.y = pk2(p0[10], p0[11]); t.z = pk2(p0[12], p0[13]); t.w = pk2(p0[14], p0[15]); pf[1] = __builtin_bit_cast(bf16x8, t);
              t.x = pk2(p1[0], p1[1]); t.y = pk2(p1[2], p1[3]); t.z = pk2(p1[4], p1[5]); t.w = pk2(p1[6], p1[7]); pf[2] = __builtin_bit_cast(bf16x8, t);
              t.x = pk2(p1[8], p1[9]); t.y = pk2(p1[10], p1[11]); t.z = pk2(p1[12], p1[13]); t.w = pk2(p1[14], p1[15]); pf[3] = __builtin_bit_cast(bf16x8, t); }
#pragma unroll
            for (int ks = 0; ks < 4; ++ks) {
                if (ks < 3) {
#pragma unroll
                    for (int d = 0; d < NDB; ++d) { const LAS unsigned char* a = Vb + (16 * (ks + 1)) * VP + d * 64; vr[(ks + 1) & 1][d][0] = vtr(a); vr[(ks + 1) & 1][d][1] = vtr(a + 8 * VP); }
                }
                __builtin_amdgcn_sched_barrier(0);
#pragma unroll
                for (int d = 0; d < NDB; ++d) {
                    const bf16x8 vf = __builtin_shufflevector(vr[ks & 1][d][0], vr[ks & 1][d][1], 0, 1, 2, 3, 4, 5, 6, 7);
                    o[d] = MFMA32(vf, pf[ks], o[d]);
                }
                __builtin_amdgcn_sched_barrier(0);
            }
        }
        if (more) {
            store_tile<MODE>(J, kt + 1, buf ^ 1, srow, sch, n0, n1, n2, n3, lds, fk, fv, own_lo); if (MODE == 1 && tid < 128) ((LAS float*)(lds + OFF_CUM))[(buf ^ 1) * 128 + tid] = cumn;
        }
        __syncthreads();
        }
        ++it;
    }
    const float l_tot = l_run + __shfl_xor(l_run, 32);
    const float inv = active ? 1.f / l_tot : 0.f;
    if (MODE != 0) {
        if (active) {
            const Job J = make_job<MODE>(slot);
            bf16_t* op = J.o + (size_t)(32 * qs + r32) * DM + half * 64 + 4 * hi;
#pragma unroll
            for (int d = 0; d < NDB; ++d)
#pragma unroll
                for (int g = 0; g < 4; ++g) { u32x2 w; w.x = pk2(o[d][4 * g] * inv, o[d][4 * g + 1] * inv); w.y = pk2(o[d][4 * g + 2] * inv, o[d][4 * g + 3] * inv);
                    *(u32x2*)(op + 32 * d + 8 * g) = w; }
        }
    } else {
        LAS float* ex = (LAS float*)lds + qs * 4096 + lane;
        if (active && half == 1) {
#pragma unroll
            for (int d = 0; d < NDB; ++d)
#pragma unroll
                for (int i = 0; i < 16; ++i) ex[(d * 16 + i) * 64] = o[d][i] * inv;
        }
        __syncthreads();
        if (active && half == 0) {
            const Job J = make_job<MODE>(slot);
            ArgsP a = fresh_args();
            const float lam = expf(wave_sum(a->in[I_LQ1][lane] * a->in[I_LK1][lane])) - expf(wave_sum(a->in[I_LQ2][lane] * a->in[I_LK2][lane])) + 0.2f;
            float ss = 0.f;
#pragma unroll
            for (int d = 0; d < NDB; ++d)
#pragma unroll
                for (int i = 0; i < 16; ++i) { const float v = o[d][i] * inv - lam * ex[(d * 16 + i) * 64]; o[d][i] = v; ss += v * v; }
            ss += __shfl_xor(ss, 32);
            const float rs = rsqrtf(ss * (1.f / 128.f) + EPS) * 0.8f;
            bf16_t* op = J.o + (size_t)(32 * qs + r32) * DM + 4 * hi;
#pragma unroll
            for (int d = 0; d < NDB; ++d)
#pragma unroll
                for (int g = 0; g < 4; ++g) { const f32x4 gg = *(const f32x4*)(J.subg + 32 * d + 8 * g + 4 * hi);
                    u32x2 w; w.x = pk2(o[d][4 * g] * rs * gg[0], o[d][4 * g + 1] * rs * gg[1]); w.y = pk2(o[d][4 * g + 2] * rs * gg[2], o[d][4 * g + 3] * rs * gg[3]);
                    *(u32x2*)(op + 32 * d + 8 * g) = w; }
        }
    }
}
}

#define LDS_WAIT() asm volatile("s_waitcnt lgkmcnt(0)" ::: "memory")
DI void transpose_item(const float* W, int ldw, int K, int nblk, bf16_t* WT, LAS float* scr, int item, int lane) {
    const int kb = item / nblk, nb = item - kb * nblk, k0 = 64 * kb, n0 = 32 * nb;
    float wv[32];
#pragma unroll
    for (int i = 0; i < 32; ++i) wv[i] = W[(size_t)(k0 + 2 * i + (lane >> 5)) * ldw + n0 + (lane & 31)];
#pragma unroll
    for (int i = 0; i < 32; ++i) scr[(2 * i + (lane >> 5)) * 33 + (lane & 31)] = wv[i];
    LDS_WAIT();
    const int c = lane & 7;
#pragma unroll
    for (int j = 0; j < 4; ++j) { const int n = (lane >> 3) + 8 * j; const LAS float* s = scr + (8 * c) * 33 + n;
        u32x4 o; o.x = pk2(s[0 * 33], s[1 * 33]); o.y = pk2(s[2 * 33], s[3 * 33]); o.z = pk2(s[4 * 33], s[5 * 33]); o.w = pk2(s[6 * 33], s[7 * 33]);
        *(u32x4*)(WT + (size_t)(n0 + n) * K + k0 + 8 * c) = o; }
    LDS_WAIT();
}
DI float log_sigmoid(float x) { return fminf(x, 0.f) - log1pf(expf(-fabsf(x))); }

DI void prologue_phase(LAS unsigned char* lds, ArgsP a, int tid, int lane, int wave) {
    unsigned char* ws = a->ws;
    const int gw = launder((int)blockIdx.x) * NWAVES + wave, NGW = launder((int)gridDim.x) * NWAVES;
    {
        LAS float* scr = (LAS float*)(lds + wave * 8448);
        constexpr int I_IN = 16 * 96, I_O = 16 * 32, I_UP = 16 * 128, I_DN = 64 * 32;
        constexpr int NITEMS = 2 * I_IN + 2 * I_O + 2 * I_UP + 2 * I_DN;
        for (int it = gw; it < NITEMS; it += NGW) {
            int r = it;
            if (r < I_IN) { transpose_item(a->in[I_WINE], 3080, 1024, 96, (bf16_t*)(ws + WS_WINE), scr, r, lane); continue; } r -= I_IN;
            if (r < I_IN) { transpose_item(a->in[I_WINO], 3072, 1024, 96, (bf16_t*)(ws + WS_WINO), scr, r, lane); continue; } r -= I_IN;
            if (r < I_O) { transpose_item(a->in[I_WOUTE], 1024, 1024, 32, (bf16_t*)(ws + WS_WOUTE), scr, r, lane); continue; } r -= I_O;
            if (r < I_O) { transpose_item(a->in[I_WOUTO], 1024, 1024, 32, (bf16_t*)(ws + WS_WOUTO), scr, r, lane); continue; } r -= I_O;
            if (r < 2 * I_UP) { const int l = r / I_UP; transpose_item(a->in[I_WUP] + (size_t)l * 1024 * 4096, 4096, 1024, 128, (bf16_t*)(ws + (l ? WS_WUP1 : WS_WUP0)), scr, r - l * I_UP, lane); continue; } r -= 2 * I_UP;
            { const int l = r / I_DN; transpose_item(a->in[I_WDN] + (size_t)l * 4096 * 1024, 1024, 4096, 32, (bf16_t*)(ws + (l ? WS_WDN1 : WS_WDN0)), scr, r - l * I_DN, lane); }
        }
    }
    LAS float* wf = (LAS float*)(lds + 98304);
    __syncthreads();
    for (int e = tid; e < 8192; e += NTHR) { const int k = e >> 3, o = e & 7; wf[o * 1024 + k] = a->in[I_WINE][(size_t)k * 3080 + 3072 + o]; }
    __syncthreads();
    const float* gp = a->in[I_GPM]; bf16_t* xn = (bf16_t*)(ws + WS_XN);
    f32x4 g[4];
#pragma unroll
    for (int j = 0; j < 4; ++j) g[j] = ((const f32x4*)gp)[lane + 64 * j];
    for (int m = gw; m < MT; m += NGW) {
        const float* xr = m < MP ? a->in[I_XP] + (size_t)m * DM : a->in[I_XS] + (size_t)(m - MP) * DM;
        f32x4 v[4]; float ss = 0.f;
#pragma unroll
        for (int j = 0; j < 4; ++j) { v[j] = ((const f32x4*)xr)[lane + 64 * j]; ss += (v[j].x * v[j].x + v[j].y * v[j].y) + (v[j].z * v[j].z + v[j].w * v[j].w); }
        const float rstd = rsqrtf(wave_sum(ss) * (1.f / DM) + EPS);
#pragma unroll
        for (int j = 0; j < 4; ++j) { v[j] = v[j] * rstd * g[j]; u32x2 w; w.x = pk2(v[j].x, v[j].y); w.y = pk2(v[j].z, v[j].w); ((u32x2*)(xn + (size_t)m * DM))[lane + 64 * j] = w; }
        float mine = 0.f;
#pragma unroll
        for (int o = 0; o < 8; ++o) { float acc = 0.f;
#pragma unroll
            for (int j = 0; j < 4; ++j) { const f32x4 w = *(const LAS f32x4*)(wf + o * 1024 + 4 * (lane + 64 * j)); acc += (v[j].x * w.x + v[j].y * w.y) + (v[j].z * w.z + v[j].w * w.w); }
            acc = wave_sum(acc); if (lane == o) mine = acc; }
        if (lane < 8) { const float lf = log_sigmoid(mine + a->in[I_BF][lane]);
            if (m < MP) a->out[O_PBL + (size_t)m * 8 + lane] = lf; else a->out[O_SBL + (size_t)(m - MP) * 8 + lane] = lf; }
    }
}

template <int N> DI void scan_seq_n(const float* src0, const float* src1, int split, float* dst, int lane) {
    const int i0 = lane * N;
    float v[N];
#pragma unroll
    for (int i = 0; i < N; ++i) { const int idx = i0 + i; v[i] = idx >= split ? src1[(size_t)(idx - split) * 8] : src0[(size_t)idx * 8]; }
    float tot = 0.f;
#pragma unroll
    for (int i = 0; i < N; ++i) tot += v[i];
    float x = tot;
#pragma unroll
    for (int o = 1; o < 64; o <<= 1) { const float t = __shfl_up(x, o); if (lane >= o) x += t; }
    float run = x - tot;
#pragma unroll
    for (int i = 0; i < N; ++i) { run += v[i]; dst[i0 + i] = run * LOG2E; }
}
DI void scan_seq(ArgsP a, int seq, int lane) {
    float* cump = (float*)(a->ws + WS_CUMP); float* cums = (float*)(a->ws + WS_CUMS);
    const bool smp = seq >= 32; const int s = smp ? seq - 32 : seq, b = s >> 3, h = s & 7;
    if (!smp) scan_seq_n<64>(a->out + O_PBL + (size_t)b * 4096 * 8 + h, nullptr, 1 << 30, cump + (size_t)(b * 8 + h) * 4096, lane);
    else scan_seq_n<17>(a->in[I_CBL] + (size_t)b * 1024 * 8 + h, a->out + O_SBL + (size_t)b * 64 * 8 + h, 1024, cums + (size_t)(b * 8 + h) * 1088, lane);
}

constexpr int RW = 4;
DI void rows_phase(ArgsP a, const float* gpost, const float* gnext, const float* part, int nparts, int lane, int wave, bool x_from_input = false, float scl = 1.f) {
    const bf16_t* Y = (const bf16_t*)(a->ws + WS_Y); bf16_t* xn = (bf16_t*)(a->ws + WS_XN); float* X = a->out;
    const int gw = launder((int)blockIdx.x) * NWAVES + wave, NGW = launder((int)gridDim.x) * NWAVES;
    f32x4 gp[4], gn[4];
#pragma unroll
    for (int j = 0; j < 4; ++j) { gp[j] = ((const f32x4*)gpost)[lane + 64 * j]; gn[j] = gnext ? ((const f32x4*)gnext)[lane + 64 * j] : (f32x4){0.f, 0.f, 0.f, 0.f}; }
    for (int m0 = gw; m0 < MT; m0 += RW * NGW) {
        f32x4 y[RW][4], x[RW][4];
#pragma unroll
        for (int r = 0; r < RW; ++r) {
            const int m = m0 + r * NGW;
            if (m < MT) {
#pragma unroll
                for (int j = 0; j < 4; ++j) {
                    if (m < MP) { const u32x2 w = ((const u32x2*)(Y + (size_t)m * DM))[lane + 64 * j];
                        y[r][j].x = __uint_as_float(w.x << 16); y[r][j].y = __uint_as_float(w.x & 0xffff0000u); y[r][j].z = __uint_as_float(w.y << 16); y[r][j].w = __uint_as_float(w.y & 0xffff0000u); }
                    else { f32x4 t[8];
#pragma unroll
                        for (int p = 0; p < 8; ++p) t[p] = p < nparts ? ((const f32x4*)(part + ((size_t)p * MS + (m - MP)) * DM))[lane + 64 * j] : (f32x4){0.f, 0.f, 0.f, 0.f};
                        y[r][j] = ((t[0] + t[1]) + (t[2] + t[3])) + ((t[4] + t[5]) + (t[6] + t[7])); }
                    x[r][j] = ((const f32x4*)(x_from_input ? (m < MP ? a->in[I_XP] + (size_t)m * DM : a->in[I_XS] + (size_t)(m - MP) * DM) : X + (size_t)m * DM))[lane + 64 * j];
                }
            }
        }
#pragma unroll
        for (int r = 0; r < RW; ++r) {
            const int m = m0 + r * NGW;
            if (m < MT) {
                float ss = 0.f;
#pragma unroll
                for (int j = 0; j < 4; ++j) ss += (y[r][j].x * y[r][j].x + y[r][j].y * y[r][j].y) + (y[r][j].z * y[r][j].z + y[r][j].w * y[r][j].w);
                const float rstd = rsqrtf(wave_sum(ss) * (1.f / DM) + EPS);
                float s2 = 0.f;
#pragma unroll
                for (int j = 0; j < 4; ++j) { x[r][j] = x[r][j] + y[r][j] * (rstd * scl) * gp[j];
                    ((f32x4*)(X + (size_t)m * DM))[lane + 64 * j] = x[r][j]; s2 += (x[r][j].x * x[r][j].x + x[r][j].y * x[r][j].y) + (x[r][j].z * x[r][j].z + x[r][j].w * x[r][j].w); }
                if (gnext) {
                    const float r2 = rsqrtf(wave_sum(s2) * (1.f / DM) + EPS);
#pragma unroll
                    for (int j = 0; j < 4; ++j) { const f32x4 h = x[r][j] * r2 * gn[j];
                        u32x2 w; w.x = pk2(h.x, h.y); w.y = pk2(h.z, h.w); ((u32x2*)(xn + (size_t)m * DM))[lane + 64 * j] = w; }
                }
            }
        }
    }
}

DI void sgemm_sample(const bf16_t* A, int K, const bf16_t* Wt, float* P, int gw, int NGW, int lane) {
    const int r32 = lane & 31, hi = lane >> 5, nks = K >> 9, nunits = 16 * 16 * nks;
    for (int u = gw; u < nunits; u += NGW) {
        const int ks = u % nks, t = u / nks, cb = t & 15, rb = t >> 4;
        const bf16_t* ap = A + (size_t)(rb * 32 + r32) * K + ks * 512 + 8 * hi;
        const bf16_t* bp0 = Wt + (size_t)(cb * 64 + r32) * K + ks * 512 + 8 * hi; const bf16_t* bp1 = bp0 + (size_t)32 * K;
        f32x16 c0, c1;
#pragma unroll
        for (int i = 0; i < 16; ++i) { c0[i] = 0.f; c1[i] = 0.f; }
        bf16x8 a[4], b0[4], b1[4];
#pragma unroll
        for (int j = 0; j < 4; ++j) { a[j] = *(const bf16x8*)(ap + 16 * j); b0[j] = *(const bf16x8*)(bp0 + 16 * j); b1[j] = *(const bf16x8*)(bp1 + 16 * j); }
#pragma unroll
        for (int g = 0; g < 8; ++g) {
            bf16x8 na[4], nb0[4], nb1[4];
            if (g < 7) {
#pragma unroll
                for (int j = 0; j < 4; ++j) { na[j] = *(const bf16x8*)(ap + 64 * (g + 1) + 16 * j); nb0[j] = *(const bf16x8*)(bp0 + 64 * (g + 1) + 16 * j); nb1[j] = *(const bf16x8*)(bp1 + 64 * (g + 1) + 16 * j); }
            }
#pragma unroll
            for (int j = 0; j < 4; ++j) { c0 = __builtin_amdgcn_mfma_f32_32x32x16_bf16(a[j], b0[j], c0, 0, 0, 0); c1 = __builtin_amdgcn_mfma_f32_32x32x16_bf16(a[j], b1[j], c1, 0, 0, 0); }
            if (g < 7) {
#pragma unroll
                for (int j = 0; j < 4; ++j) { a[j] = na[j]; b0[j] = nb0[j]; b1[j] = nb1[j]; }
            }
        }
        float* pp = P + ((size_t)ks * MS + rb * 32 + 4 * hi) * DM + cb * 64 + r32;
#pragma unroll
        for (int i = 0; i < 16; ++i) { const int row = (i & 3) + 8 * (i >> 2); pp[(size_t)row * DM] = c0[i]; pp[(size_t)row * DM + 32] = c1[i]; }
    }
}

constexpr int CTL_QUEUE = 16384;
DI void attn_even_phase(LAS unsigned char* lds) {
    const int bx = launder((int)blockIdx.x), G = launder((int)gridDim.x);
    const bool grouped = (G & 15) == 0;
    const int g = grouped ? (bx & 15) : 0, per_q = grouped ? 68 : 16 * 68;
    ArgsP a = fresh_args();
    unsigned* cnt = (unsigned*)(a->ws + CTL_QUEUE + g * 256);
    volatile LAS int* slot_w = (volatile LAS int*)(lds + 131072 + 128);
    for (;;) {
        __syncthreads();
        if (threadIdx.x == 0) slot_w[0] = (int)__hip_atomic_fetch_add(cnt, 1u, __ATOMIC_RELAXED, __HIP_MEMORY_SCOPE_AGENT);
        __syncthreads();
        int i = slot_w[0];
        if (i >= per_q) break;
        const int gg = grouped ? g : i / 68; i = grouped ? i : i % 68;
        int mode, s;
        if (i < 4) { const int q = gg * 4 + i; mode = q >> 5; s = 512 + (q & 31); }
        else { const int k = i - 4, u = 31 - (k >> 1); mode = k & 1; s = u >= 16 ? (((31 - u) << 4) | gg) : 256 + ((u << 4) | gg); }
        if (mode == 0) att::attn_unit<0>(lds, s); else att::attn_unit<1>(lds, s);
    }
}
DI void attn_odd_phase(LAS unsigned char* lds) {
    const int bx = launder((int)blockIdx.x), G = launder((int)gridDim.x);
    if (G == 256) {
        for (int i = 0; i < 6; ++i) {
            const int s = i == 0 ? (bx < 64 ? 1024 + bx : -1) : i <= 3 ? bx + 256 * (i - 1) : i == 4 ? (bx >= 64 ? 704 + bx : -1) : (bx >= 64 && bx < 128 ? 896 + bx : -1);
            if (s >= 0) att::attn_unit<2>(lds, s);
        }
    } else
    for (int s = bx; s < 1088; s += G) att::attn_unit<2>(lds, s);
}

typedef unsigned short bf16;
#define XB_TMO      128
#define XB_XCNT(j)  (256  + 64 * (j))
#define XB_XSUB(j)  (1280 + 64 * (j))
#define XB_XGEN(j)  (2304 + 64 * (j))
#define XB_TOP      3328
#define XB_TOPGEN   3392
#define XCD_BAR_WORDS 3456
#define XB_SPIN_CAP (1u << 18)

__device__ __forceinline__ unsigned xb_ld(unsigned* p)              { return __hip_atomic_load(p, __ATOMIC_RELAXED, __HIP_MEMORY_SCOPE_AGENT); }
__device__ __forceinline__ unsigned xb_add(unsigned* p, unsigned v) { return __hip_atomic_fetch_add(p, v, __ATOMIC_RELAXED, __HIP_MEMORY_SCOPE_AGENT); }
__device__ __forceinline__ unsigned xb_xcc_id() { return (unsigned)__builtin_amdgcn_s_getreg((3 << 11) | 20) & 0xFu; }
#define XB_SPIN(cond, bar) do { unsigned _sp = 0; while (cond) { __builtin_amdgcn_s_sleep(1); \
    if ((++_sp & 255u) == 0u) { if (xb_ld(&(bar)[XB_TMO])) break; if (_sp > XB_SPIN_CAP) { atomicAdd(&(bar)[XB_TMO], 1u); break; } } } } while (0)

struct XcdBarrier {
    unsigned* bar; unsigned x;
    volatile LAS unsigned* st;
};

__device__ __forceinline__ XcdBarrier xcd_barrier_post(unsigned* bar, volatile LAS unsigned* st) {
    XcdBarrier b; b.bar = bar; b.x = xb_xcc_id(); b.st = st;
    if (threadIdx.x == 0) (void)xb_add(&bar[XB_XCNT(b.x)], 1u);
    return b;
}
__device__ __forceinline__ void xcd_barrier_complete(unsigned* bar, unsigned x, unsigned& nloc, unsigned& nx) {
    const unsigned G = gridDim.x * gridDim.y * gridDim.z;
    unsigned sum, cnt, mine, sp = 0u;
    for (;;) {
        sum = 0u; cnt = 0u; mine = 0u;
#pragma unroll
        for (unsigned j = 0; j < 16; ++j) { const unsigned c = xb_ld(&bar[XB_XCNT(j)]); sum += c; cnt += (c > 0u) ? 1u : 0u; mine = (j == x) ? c : mine; }
        if (sum == G) break;
        __builtin_amdgcn_s_sleep(1);
        if ((++sp & 255u) == 0u) { if (xb_ld(&bar[XB_TMO])) break; if (sp > XB_SPIN_CAP) { atomicAdd(&bar[XB_TMO], 1u); break; } }
    }
    nloc = mine > 0u ? mine : 1u; nx = cnt > 0u ? cnt : 1u;
}

__device__ __forceinline__ void xcd_barrier(const XcdBarrier& b) {
    asm volatile("s_waitcnt vmcnt(0)" ::: "memory");
    __syncthreads();
    if (threadIdx.x == 0) {
        unsigned* bar = b.bar;
        __builtin_amdgcn_s_waitcnt(0);
        unsigned nloc = b.st[0], nx = b.st[1];
        if (nloc == 0u) { xcd_barrier_complete(bar, b.x, nloc, nx); b.st[0] = nloc; b.st[1] = nx; }
        const unsigned old = xb_add(&bar[XB_XSUB(b.x)], 1u);
        const unsigned gen = old / nloc;
        if (old + 1u == (gen + 1u) * nloc) {
            __builtin_amdgcn_fence(__ATOMIC_RELEASE, "agent");
            asm volatile("s_waitcnt vmcnt(0)" ::: "memory");
            const unsigned og = xb_add(&bar[XB_TOP], 1u);
            const unsigned tg = og / nx;
            if (og + 1u == (tg + 1u) * nx) xb_add(&bar[XB_TOPGEN], 1u);
            else XB_SPIN(xb_ld(&bar[XB_TOPGEN]) == tg, bar);
            __builtin_amdgcn_fence(__ATOMIC_ACQUIRE, "agent");
            xb_add(&bar[XB_XGEN(b.x)], 1u);
            asm volatile("s_waitcnt vmcnt(0)" ::: "memory");
        } else {
            XB_SPIN(xb_ld(&bar[XB_XGEN(b.x)]) == gen, bar);
            __builtin_amdgcn_fence(__ATOMIC_ACQUIRE, "agent");
            asm volatile("s_waitcnt vmcnt(0)" ::: "memory");
        }
    }
    __syncthreads();
}

template <int PH_LO, int PH_HI>
__global__ void __launch_bounds__(NTHR, 2) fwd_kernel(Args a_unused) {
    extern __shared__ __attribute__((aligned(16))) unsigned char lds_raw[];
    LAS unsigned char* lds = (LAS unsigned char*)lds_raw;
    cg::grid_group grid = cg::this_grid();
    constexpr bool ONE = (PH_HI - PH_LO) > 1;
    if (ONE) {
        { int t0 = threadIdx.x; if (t0 < 64) ((LAS unsigned*)(lds + 131072))[t0] = 0u; }
        __syncthreads();
        ArgsP a0 = fresh_args();
        (void)xcd_barrier_post((unsigned*)a0->ws, (volatile LAS unsigned*)(lds + 131072 + 32));
    }
#define IN(k) (PH_LO <= (k) && (k) < PH_HI)
#ifndef T_DUP
#define T_DUP (-1)
#endif
#define REPS(k) for (int rep_ = 0; rep_ < ((k) == T_DUP ? 2 : 1); ++rep_)
#define SEAM(k) do { if (IN(k) && IN((k) + 1)) { if (ab_never()) grid.sync(); { ArgsP ab = fresh_args(); XcdBarrier bb; bb.bar = (unsigned*)ab->ws; bb.x = xb_xcc_id(); bb.st = (volatile LAS unsigned*)(lds + 131072 + 32); xcd_barrier(bb); } } } while (0)
#define PHASE_ARGS int tid = threadIdx.x; asm volatile("" : "+v"(tid)); const int lane = tid & 63, wave = __builtin_amdgcn_readfirstlane(tid >> 6); (void)lane; (void)wave; ArgsP a = fresh_args(); unsigned char* ws = a->ws; (void)ws; const int bx_ = launder((int)blockIdx.x), G_ = launder((int)gridDim.x); (void)bx_; (void)G_
    if (IN(0)) REPS(0) { PHASE_ARGS; prologue_phase(lds, a, tid, lane, wave); __syncthreads(); }
    SEAM(0);
#pragma unroll
    for (int l = 0; l < 2; ++l) {
        const int p = l * 7;
        if (IN(p + 1)) REPS(p + 1) {
            PHASE_ARGS;
            if (l == 0) {
                if (bx_ >= 64 && bx_ < 76) scan_seq(a, (bx_ - 64) * 8 + wave, lane);
                else if (G_ < 76 && bx_ == 0) { for (int q = wave; q < 96; q += NWAVES) scan_seq(a, q, lane); }
                __syncthreads();
                pg8::Gemm g{(const bf16_t*)(ws + WS_XN), (const bf16_t*)(ws + WS_WINE), MT, 3072, DM}; pg8::StaticOrder S; S.init(MT, 3072, G_, bx_);
                EpiX<2> E{(bf16_t*)(ws + WS_Z), ZP, a->out};
                pg8::gemm_phase<EpiX<2>, pg8::StaticOrder, true, true>(lds, g, S, E);
            } else {
                pg8::Gemm g{(const bf16_t*)(ws + WS_XN), (const bf16_t*)(ws + WS_WINO), MT, 3072, DM}; pg8::StaticOrder S; S.init(MT, 3072, G_, bx_);
                EpiX<3> E{(bf16_t*)(ws + WS_Z), ZP, a->out};
                pg8::gemm_phase<EpiX<3>, pg8::StaticOrder, true, true>(lds, g, S, E);
            }
        }
        SEAM(p + 1);
        if (IN(p + 2)) REPS(p + 2) {
#ifndef T_NO_EVEN
            if (l == 0) attn_even_phase(lds);
#endif
#ifndef T_NO_ODD
            if (l == 1) attn_odd_phase(lds);
#endif
            __syncthreads(); }
        SEAM(p + 2);
        if (IN(p + 3)) REPS(p + 3) {
            PHASE_ARGS;
            sgemm_sample((const bf16_t*)(ws + WS_ATT) + (size_t)MP * DM, DM, (const bf16_t*)(ws + (l == 0 ? WS_WOUTE : WS_WOUTO)), (float*)(ws + WS_PART_OUT), bx_ * NWAVES + wave, G_ * NWAVES, lane);
            __syncthreads();
            pg8::Gemm g{(const bf16_t*)(ws + WS_ATT), (const bf16_t*)(ws + (l == 0 ? WS_WOUTE : WS_WOUTO)), MP, DM, DM}; pg8::StaticOrder S; S.init(MP, DM, G_, bx_);
            EpiX<0> E{(bf16_t*)(ws + WS_Y), DM, nullptr};
            pg8::gemm_phase<EpiX<0>, pg8::StaticOrder, true, true>(lds, g, S, E);
        }
        SEAM(p + 3);
        if (IN(p + 4)) REPS(p + 4) { PHASE_ARGS; rows_phase(a, a->in[I_GQM] + l * DM, a->in[I_GPF] + l * DM, (const float*)(ws + WS_PART_OUT), 2, lane, wave, l == 0, 1.f); }
        SEAM(p + 4);
        if (IN(p + 5)) REPS(p + 5) {
            PHASE_ARGS;
            pg8::Gemm g{(const bf16_t*)(ws + WS_XN), (const bf16_t*)(ws + (l ? WS_WUP1 : WS_WUP0)), MT, FF, DM}; pg8::StaticOrder S; S.init(MT, FF, G_, bx_);
            EpiX<1> E{(bf16_t*)(ws + WS_H), FF, nullptr};
            pg8::gemm_phase<EpiX<1>, pg8::StaticOrder, true, true>(lds, g, S, E);
        }
        SEAM(p + 5);
        if (IN(p + 6)) REPS(p + 6) {
            PHASE_ARGS;
            sgemm_sample((const bf16_t*)(ws + WS_H) + (size_t)MP * FF, FF, (const bf16_t*)(ws + (l ? WS_WDN1 : WS_WDN0)), (float*)(ws + WS_PART_DN), bx_ * NWAVES + wave, G_ * NWAVES, lane);
            __syncthreads();
            pg8::Gemm g{(const bf16_t*)(ws + WS_H), (const bf16_t*)(ws + (l ? WS_WDN1 : WS_WDN0)), MP, DM, FF}; pg8::StaticOrder S; S.init(MP, DM, G_, bx_);
            EpiX<0> E{(bf16_t*)(ws + WS_Y), DM, nullptr};
            pg8::gemm_phase<EpiX<0>, pg8::StaticOrder, true, true>(lds, g, S, E);
        }
        SEAM(p + 6);
        if (IN(p + 7)) REPS(p + 7) { PHASE_ARGS; rows_phase(a, a->in[I_GQF] + l * DM, l == 0 ? a->in[I_GPM] + DM : nullptr, (const float*)(ws + WS_PART_DN), 8, lane, wave); }
        SEAM(p + 7);
    }
#undef IN
#undef SEAM
}

#if MK_ONE_LAUNCH
#define KFN (fwd_kernel<0, 15>)
#else
#define KFN (fwd_kernel<0, 1>)
typedef void (*kfn_t)(Args);
static kfn_t kfns[15] = {fwd_kernel<0, 1>, fwd_kernel<1, 2>, fwd_kernel<2, 3>, fwd_kernel<3, 4>, fwd_kernel<4, 5>, fwd_kernel<5, 6>, fwd_kernel<6, 7>, fwd_kernel<7, 8>,
                         fwd_kernel<8, 9>, fwd_kernel<9, 10>, fwd_kernel<10, 11>, fwd_kernel<11, 12>, fwd_kernel<12, 13>, fwd_kernel<13, 14>, fwd_kernel<14, 15>};
#endif
extern "C" void kernel_launch(void* const* d_in, const int* in_sizes, int n_in, void* d_out, int out_size, void* d_ws, size_t ws_size, hipStream_t stream) {
    static int grid = 0;
    if (grid == 0) {
        if (n_in != N_IN || (size_t)out_size != O_END || ws_size < WS_END) { fprintf(stderr, "kernel_launch: unexpected shapes (n_in %d out %d ws %zu)\n", n_in, out_size, ws_size); grid = -1; return; }
        int dev = 0, cus = 0, per_cu = 0;
        (void)hipGetDevice(&dev); (void)hipDeviceGetAttribute(&cus, hipDeviceAttributeMultiprocessorCount, dev);
        if (hipFuncSetAttribute((const void*)KFN, hipFuncAttributeMaxDynamicSharedMemorySize, LDS_BYTES) != hipSuccess) { fprintf(stderr, "kernel_launch: hipFuncSetAttribute failed\n"); grid = -1; return; }
#if !MK_ONE_LAUNCH
        for (int k = 1; k < 15; ++k) (void)hipFuncSetAttribute((const void*)kfns[k], hipFuncAttributeMaxDynamicSharedMemorySize, LDS_BYTES);
#endif
        (void)hipOccupancyMaxActiveBlocksPerMultiprocessor(&per_cu, (const void*)KFN, NTHR, LDS_BYTES);
        if (per_cu < 1) per_cu = 1;
        (void)hipGetLastError();
        grid = cus * per_cu;
        fprintf(stderr, "kernel_launch: grid %d (cus %d x %d)\n", grid, cus, per_cu);
    }
    if (grid < 0) return;
    Args a{};
    for (int i = 0; i < N_IN; ++i) a.in[i] = (const float*)d_in[i];
    a.out = (float*)d_out; a.ws = (unsigned char*)d_ws;
#if MK_ONE_LAUNCH
    if (hipMemsetAsync(d_ws, 0, 32768, stream) != hipSuccess) { fprintf(stderr, "kernel_launch: memset failed\n"); return; }
    a.ph_lo = 0; a.ph_hi = 15;
    void* args[] = {&a};
    hipError_t e = hipLaunchCooperativeKernel((const void*)KFN, dim3(grid), dim3(NTHR), args, LDS_BYTES, stream);
    if (e != hipSuccess) fprintf(stderr, "cooperative launch failed: %s (grid %d)\n", hipGetErrorString(e), grid);
#else
    for (int k = 0; k < 15; ++k) { a.ph_lo = k; a.ph_hi = k + 1; hipLaunchKernelGGL(kfns[k], dim3(grid), dim3(NTHR), LDS_BYTES, stream, a); }
#endif
}
```
